# Optimizing an MI355X kernel written in HIP

```python
import math
import jax, jax.numpy as jnp
from jax import lax
import numpy as np

D_MODEL = 2048
BATCH = 4
SEQ = 8192
DEPTH = 4
DEC_BATCH = 8
DEC_SEQ = 32
PAST_LEN = 1024

CHUNK = 64
D_MIX = D_MODEL
D_POOL = D_MIX // 4
POOL_WINDOWS = (2, 4, 8, 16)
N_POOL_GROUPS = len(POOL_WINDOWS)
POOL_GROUP = D_POOL // N_POOL_GROUPS
POOL_HIST = max(POOL_WINDOWS) - 1
HEAD_DIM = 64
D_ATTN = D_MIX // 2
N_Q_HEADS = D_ATTN // HEAD_DIM
N_KV_HEADS = 2
GQA_GROUP = N_Q_HEADS // N_KV_HEADS
WINDOW = 128
WIN_CHUNKS = WINDOW // CHUNK
BAND = (WIN_CHUNKS + 1) * CHUNK
NUM_BUCKETS = 32
MAX_DISTANCE = 128
NEG = -1e30
D_RWKV = D_MIX - D_POOL - D_ATTN
RWKV_HEAD = 64
N_RWKV_HEADS = D_RWKV // RWKV_HEAD
DECAY_LORA = 64
ICLR_LORA = 64
D_SHIFT = 3 * D_RWKV + DECAY_LORA + ICLR_LORA
NORM_EPS = 1e-5
LNX_EPS = 1e-5 * RWKV_HEAD
SPLITS = (D_POOL, D_POOL, N_Q_HEADS * HEAD_DIM, N_KV_HEADS * HEAD_DIM, N_KV_HEADS * HEAD_DIM, D_ATTN, D_SHIFT, D_RWKV)
D_IN = sum(SPLITS)
SPLIT_IDX = [int(s) for s in np.cumsum(SPLITS)[:-1]]
RWKV_SPLIT_IDX = [D_RWKV, 2 * D_RWKV, 3 * D_RWKV, 3 * D_RWKV + DECAY_LORA]

kernel_name = "hybrid_pool_swa_rwkv7_stream_step"


def rms_norm(x, w):
    xf = x.astype(jnp.float32)
    y = xf * lax.rsqrt(jnp.mean(xf * xf, axis=-1, keepdims=True) + NORM_EPS)
    return (y * w.astype(jnp.float32)).astype(x.dtype)


def t5_bucket(rel):
    nb = NUM_BUCKETS // 2
    max_exact = nb // 2
    ret = jnp.where(rel > 0, nb, 0)
    n = jnp.abs(rel)
    nf = jnp.maximum(n, 1).astype(jnp.float32)
    large = max_exact + (jnp.log(nf / max_exact) / math.log(MAX_DISTANCE / max_exact) * (nb - max_exact)).astype(jnp.int32)
    large = jnp.minimum(large, nb - 1)
    return ret + jnp.where(n < max_exact, n, large)


def rel_bias(rel, table):
    b = table.astype(jnp.float32)[t5_bucket(rel)]
    return jnp.transpose(b, (2, 0, 1)).reshape(N_KV_HEADS, GQA_GROUP, rel.shape[0], rel.shape[1])


def sink_softmax(logits, sinks):
    s = sinks[..., None, None]
    m = jnp.maximum(jnp.max(logits, axis=-1, keepdims=True), s)
    e = jnp.exp(logits - m)
    return e / (jnp.sum(e, axis=-1, keepdims=True) + jnp.exp(s - m))


def swa_prompt(q, k, v, sinks, table):
    B, T = q.shape[:2]
    nC = T // CHUNK
    qc = q.reshape(B, nC, CHUNK, N_KV_HEADS, GQA_GROUP, HEAD_DIM)

    def band(x):
        xc = x.reshape(B, nC, CHUNK, N_KV_HEADS, HEAD_DIM)
        xp = jnp.pad(xc, ((0, 0), (WIN_CHUNKS, 0), (0, 0), (0, 0), (0, 0)))
        return jnp.concatenate([xp[:, j:j + nC] for j in range(WIN_CHUNKS + 1)], axis=2)

    kb, vb = band(k), band(v)
    logits = jnp.einsum('bcqkgd,bcskd->bckgqs', qc, kb).astype(jnp.float32) * (HEAD_DIM ** -0.5)
    i = jnp.arange(CHUNK)
    j = jnp.arange(BAND)
    rel = j[None, :] - WIN_CHUNKS * CHUNK - i[:, None]
    logits = logits + rel_bias(rel, table)
    key_chunk = jnp.arange(nC)[:, None] - WIN_CHUNKS + j[None, :] // CHUNK
    valid = key_chunk >= 0
    logits = jnp.where(valid[None, :, None, None, None, :], logits, NEG)
    p = sink_softmax(logits, sinks).astype(v.dtype)
    o = jnp.einsum('bckgqs,bcskd->bcqkgd', p, vb)
    return o.reshape(B, T, D_ATTN)


def swa_sample(q, k, v, k_cache, v_cache, sinks, table):
    Bd, Ts = q.shape[:2]
    kf = jnp.concatenate([k_cache.astype(k.dtype), k], axis=1)
    vf = jnp.concatenate([v_cache.astype(v.dtype), v], axis=1)
    qg = q.reshape(Bd, Ts, N_KV_HEADS, GQA_GROUP, HEAD_DIM)
    logits = jnp.einsum('bqkgd,bskd->bkgqs', qg, kf).astype(jnp.float32) * (HEAD_DIM ** -0.5)
    q_pos = PAST_LEN + jnp.arange(Ts)
    k_pos = PAST_LEN - WINDOW + jnp.arange(WINDOW + Ts)
    rel = k_pos[None, :] - q_pos[:, None]
    logits = logits + rel_bias(rel, table)
    qcn = q_pos // CHUNK
    kcn = k_pos // CHUNK
    valid = (kcn[None, :] <= qcn[:, None]) & (kcn[None, :] >= qcn[:, None] - WIN_CHUNKS)
    logits = jnp.where(valid, logits, NEG)
    p = sink_softmax(logits, sinks).astype(vf.dtype)
    o = jnp.einsum('bkgqs,bskd->bqkgd', p, vf).reshape(Bd, Ts, D_ATTN)
    return o, kf[:, -WINDOW:], vf[:, -WINDOW:]


def pool_mixer(p_hist, p, pos0, pool_w, pool_scale):
    B, T = p.shape[:2]
    ext = jnp.concatenate([p_hist.astype(p.dtype), p], axis=1).astype(jnp.float32)
    S = jnp.concatenate([jnp.zeros_like(ext[:, :1]), jnp.cumsum(ext, axis=1)], axis=1)
    end = S[:, POOL_HIST + 1:]
    pos = pos0 + jnp.arange(T)
    outs = []
    for g, w in enumerate(POOL_WINDOWS):
        sl = slice(g * POOL_GROUP, (g + 1) * POOL_GROUP)
        start = S[:, POOL_HIST + 1 - w:POOL_HIST + 1 - w + T, sl]
        cnt = jnp.minimum(pos + 1, w).astype(jnp.float32)[:, None]
        outs.append((end[..., sl] - start) / cnt - ext[:, POOL_HIST:, sl])
    d = jnp.stack(outs, axis=2).astype(p.dtype)
    y = jnp.einsum('btgc,gcd->btgd', d, pool_w).reshape(B, T, D_POOL) * pool_scale
    return y, ext[:, -POOL_HIST:].astype(p.dtype)


def wkv_scan(S0, r, w, k, v, a_vec, b_vec):
    def step(S, inp):
        r_t, w_t, k_t, v_t, a_t, b_t = inp
        sa = jnp.einsum('bhij,bhj->bhi', S, a_t)
        S = S * w_t[:, :, None, :] + sa[..., None] * b_t[:, :, None, :] + v_t[..., None] * k_t[:, :, None, :]
        o = jnp.einsum('bhij,bhj->bhi', S, r_t)
        return S, o
    xs = tuple(jnp.moveaxis(t, 1, 0) for t in (r, w, k, v, a_vec, b_vec))
    S, o = lax.scan(step, S0, xs)
    return S, jnp.moveaxis(o, 0, 1)


def rwkv_mixer(xc, shift_prev, S0, mu, w0, w_up, a0, a_up, k_k, k_a, r_k, lnx_w, lnx_b):
    B, T = xc.shape[:2]
    prev = jnp.concatenate([shift_prev[:, None].astype(xc.dtype), xc[:, :-1]], axis=1)
    xs = xc + (prev - xc) * mu
    r, k, v, wl, al = jnp.split(xs.astype(jnp.float32), RWKV_SPLIT_IDX, axis=-1)
    w_raw = -jax.nn.softplus(-(w0 + jnp.tanh(wl) @ w_up)) - 0.5
    decay = jnp.exp(-jnp.exp(w_raw))
    a = jax.nn.sigmoid(a0 + al @ a_up)
    heads = lambda t: t.reshape(B, T, N_RWKV_HEADS, RWKV_HEAD)
    kk = heads(k * k_k)
    kk = kk / jnp.maximum(jnp.linalg.norm(kk, axis=-1, keepdims=True), 1e-12)
    k = k * (1.0 + (a - 1.0) * k_a)
    rh, kh, vh, wh, ah = heads(r), heads(k), heads(v), heads(decay), heads(a)
    S, o = wkv_scan(S0.astype(jnp.float32), rh, wh, kh, vh, -kk, kk * ah)
    mean = jnp.mean(o, axis=-1, keepdims=True)
    var = jnp.mean(jnp.square(o - mean), axis=-1, keepdims=True)
    o = ((o - mean) * lax.rsqrt(var + LNX_EPS)).reshape(B, T, D_RWKV) * lnx_w + lnx_b
    bonus = jnp.sum(rh * kh * r_k, axis=-1, keepdims=True) * vh
    o = o + bonus.reshape(B, T, D_RWKV)
    return o.astype(xc.dtype), xc[:, -1], S.astype(S0.dtype)


def mixer_layer(h, lp, table, pool_hist, shift_prev, wkv0, kv_cache, pos0):
    B, T = h.shape[:2]
    xn = rms_norm(h, lp['norm_w'])
    u = xn @ lp['w_in']
    p, g_pool, q, k, v, g_attn, xc, g_rwkv = jnp.split(u, SPLIT_IDX, axis=-1)
    y_pool, new_pool = pool_mixer(pool_hist, p, pos0, lp['pool_w'], lp['pool_scale'])
    q = q.reshape(B, T, N_Q_HEADS, HEAD_DIM)
    k = k.reshape(B, T, N_KV_HEADS, HEAD_DIM)
    v = v.reshape(B, T, N_KV_HEADS, HEAD_DIM)
    if kv_cache is None:
        y_attn = swa_prompt(q, k, v, lp['sinks'], table)
        new_k, new_v = k[:, -WINDOW:], v[:, -WINDOW:]
    else:
        y_attn, new_k, new_v = swa_sample(q, k, v, kv_cache[0], kv_cache[1], lp['sinks'], table)
    y_rwkv, new_shift, new_wkv = rwkv_mixer(xc, shift_prev, wkv0, lp['mu'], lp['w0'], lp['w_up'], lp['a0'], lp['a_up'],
                                            lp['k_k'], lp['k_a'], lp['r_k'], lp['lnx_w'], lp['lnx_b'])
    mixed = jnp.concatenate([y_pool * jax.nn.silu(g_pool), y_attn * jax.nn.silu(g_attn), y_rwkv * jax.nn.silu(g_rwkv)], axis=-1)
    return h + mixed @ lp['w_out'], (new_pool, new_k, new_v, new_shift, new_wkv)


def setup_inputs(seed: int = 0) -> dict:
    key = jax.random.key(seed)
    ks = jax.random.split(key, 26)
    nrm = lambda kk, shape, s: jax.random.normal(kk, shape, jnp.float32) * s
    return {
        "x_prompt": nrm(ks[0], (BATCH, SEQ, D_MODEL), 1.0),
        "x_sample": nrm(ks[1], (DEC_BATCH, DEC_SEQ, D_MODEL), 1.0),
        "state_pool": nrm(ks[2], (DEPTH, DEC_BATCH, POOL_HIST, D_POOL), 1.0),
        "cache_swa_k": nrm(ks[3], (DEPTH, DEC_BATCH, WINDOW, N_KV_HEADS, HEAD_DIM), 1.0),
        "cache_swa_v": nrm(ks[4], (DEPTH, DEC_BATCH, WINDOW, N_KV_HEADS, HEAD_DIM), 1.0),
        "state_rwkv_shift": nrm(ks[5], (DEPTH, DEC_BATCH, D_SHIFT), 1.0),
        "state_rwkv_wkv": nrm(ks[6], (DEPTH, DEC_BATCH, N_RWKV_HEADS, RWKV_HEAD, RWKV_HEAD), 0.1),
        "norm_w": 1.0 + nrm(ks[7], (DEPTH, D_MODEL), 0.02),
        "w_in": nrm(ks[8], (DEPTH, D_MODEL, D_IN), D_MODEL ** -0.5),
        "w_out": nrm(ks[9], (DEPTH, D_MIX, D_MODEL), 0.5 * D_MIX ** -0.5),
        "pool_w": nrm(ks[10], (DEPTH, N_POOL_GROUPS, POOL_GROUP, POOL_GROUP), POOL_GROUP ** -0.5),
        "pool_scale": 1.0 + nrm(ks[11], (DEPTH, D_POOL), 0.02),
        "attn_sinks": nrm(ks[12], (DEPTH, N_Q_HEADS), 0.5),
        "rel_bias_table": nrm(ks[13], (NUM_BUCKETS, N_Q_HEADS), 0.5),
        "rwkv_mu": jax.random.uniform(ks[14], (DEPTH, D_SHIFT), jnp.float32),
        "rwkv_w0": jax.random.uniform(ks[15], (DEPTH, D_RWKV), jnp.float32, -4.0, -1.0),
        "rwkv_w_up": nrm(ks[16], (DEPTH, DECAY_LORA, D_RWKV), 0.5 * DECAY_LORA ** -0.5),
        "rwkv_a0": nrm(ks[17], (DEPTH, D_RWKV), 0.1),
        "rwkv_a_up": nrm(ks[18], (DEPTH, ICLR_LORA, D_RWKV), 0.5 * ICLR_LORA ** -0.5),
        "rwkv_k_k": 0.85 + nrm(ks[19], (DEPTH, D_RWKV), 0.02),
        "rwkv_k_a": 1.0 + nrm(ks[20], (DEPTH, D_RWKV), 0.02),
        "rwkv_r_k": nrm(ks[21], (DEPTH, N_RWKV_HEADS, RWKV_HEAD), 0.1),
        "rwkv_lnx_w": 1.0 + nrm(ks[22], (DEPTH, D_RWKV), 0.02),
        "rwkv_lnx_b": nrm(ks[23], (DEPTH, D_RWKV), 0.02),
        "final_norm_w": 1.0 + nrm(ks[24], (D_MODEL,), 0.02),
    }


def reference(x_prompt, x_sample, state_pool, cache_swa_k, cache_swa_v, state_rwkv_shift, state_rwkv_wkv,
              norm_w, w_in, w_out, pool_w, pool_scale, attn_sinks, rel_bias_table,
              rwkv_mu, rwkv_w0, rwkv_w_up, rwkv_a0, rwkv_a_up, rwkv_k_k, rwkv_k_a, rwkv_r_k,
              rwkv_lnx_w, rwkv_lnx_b, final_norm_w):
    hp, hs = x_prompt, x_sample
    prompt_states, sample_states = [], []
    for l in range(DEPTH):
        lp = {
            'norm_w': norm_w[l], 'w_in': w_in[l], 'w_out': w_out[l],
            'pool_w': pool_w[l], 'pool_scale': pool_scale[l],
            'sinks': attn_sinks[l].astype(jnp.float32).reshape(N_KV_HEADS, GQA_GROUP),
            'mu': rwkv_mu[l], 'w0': rwkv_w0[l].astype(jnp.float32), 'w_up': rwkv_w_up[l].astype(jnp.float32),
            'a0': rwkv_a0[l].astype(jnp.float32), 'a_up': rwkv_a_up[l].astype(jnp.float32),
            'k_k': rwkv_k_k[l].astype(jnp.float32), 'k_a': rwkv_k_a[l].astype(jnp.float32),
            'r_k': rwkv_r_k[l].astype(jnp.float32),
            'lnx_w': rwkv_lnx_w[l].astype(jnp.float32), 'lnx_b': rwkv_lnx_b[l].astype(jnp.float32),
        }
        Bp = hp.shape[0]
        pool0 = jnp.zeros((Bp, POOL_HIST, D_POOL), hp.dtype)
        shift0 = jnp.zeros((Bp, D_SHIFT), hp.dtype)
        wkv_init = jnp.zeros((Bp, N_RWKV_HEADS, RWKV_HEAD, RWKV_HEAD), state_rwkv_wkv.dtype)
        hp, sp = mixer_layer(hp, lp, rel_bias_table, pool0, shift0, wkv_init, None, 0)
        hs, ss = mixer_layer(hs, lp, rel_bias_table, state_pool[l], state_rwkv_shift[l], state_rwkv_wkv[l],
                             (cache_swa_k[l], cache_swa_v[l]), PAST_LEN)
        prompt_states.append(sp)
        sample_states.append(ss)
    new_pool_p, new_k_p, new_v_p, new_shift_p, new_wkv_p = [jnp.stack(t) for t in zip(*prompt_states)]
    new_pool_s, new_k_s, new_v_s, new_shift_s, new_wkv_s = [jnp.stack(t) for t in zip(*sample_states)]
    y_prompt = rms_norm(hp, final_norm_w)
    y_sample = rms_norm(hs, final_norm_w)
    return (y_prompt, y_sample, new_pool_p, new_k_p, new_v_p, new_shift_p, new_wkv_p,
            new_pool_s, new_k_s, new_v_s, new_shift_s, new_wkv_s)
```

```cpp
#include <hip/hip_runtime.h>
#include <hip/hip_cooperative_groups.h>
#include <cstdio>
#include <cstdint>
namespace cg = cooperative_groups;
#define MK_MULTI 1
namespace pg8 {
#define PG8_LAS __attribute__((address_space(3)))
typedef unsigned short bf16_t;
typedef short bf16x8 __attribute__((ext_vector_type(8)));
typedef float f32x4 __attribute__((ext_vector_type(4)));
typedef unsigned u32x4 __attribute__((ext_vector_type(4)));
constexpr int BM = 256, BK = 64, HALF = 128, HTB = HALF * BK * 2  , STAGE_BYTES = 8 * HTB, NXCD = 8, WGM = 8;

__host__ __device__ __forceinline__ int lds_byte(int r, int c) { const int st = (r >> 4) * 2 + (c >> 5), rr = r & 15, cc = c & 31, ob = rr * 64 + cc * 2; return st * 1024 + (ob ^ (((ob >> 9) & 1) << 5)); }
__host__ __device__ __forceinline__ void stage_rc(int b, int& R, int& C) { const int st = b / 1024, sb = b % 1024, swz = sb ^ (((sb >> 9) & 1) << 5); R = (st >> 1) * 16 + swz / 64; C = (st & 1) * 32 + (swz % 64) / 2; }
__host__ __device__ __forceinline__ int perm32(int rho) { const int n = rho >> 4, i = rho & 15; return 8 * (i >> 2) + 4 * n + (i & 3); }

struct Unit { int pm, pn; };
struct Gemm { const bf16_t* A; const bf16_t* Bt; int M, N, K; };

struct StaticOrder {
    int nM, nN, nwg, G, c;
    __host__ __device__ void init(int M, int N, int G_, int c_) { nM = M / BM; nN = N / BM; nwg = nM * nN; G = G_; c = c_; }
    __host__ __device__ bool next(int i, Unit& u) const {
        const long L = (long)i * G + c; if (L >= nwg) return false;
        int wgid = (int)L; { const int q = nwg / NXCD, r = nwg % NXCD, xcd = wgid % NXCD, off = wgid / NXCD; wgid = (xcd < r ? xcd * (q + 1) : r * (q + 1) + (xcd - r) * q) + off; }
        const int nig = WGM * nN, gid = wgid / nig, fm = gid * WGM, gsz = (nM - fm) < WGM ? (nM - fm) : WGM;
        u.pm = fm + ((wgid % nig) % gsz); u.pn = (wgid % nig) / gsz; return true;
    }
    __device__ __forceinline__ void a_ready(const Unit&) const {}
    __device__ __forceinline__ void done(const Unit&) const {}
};
__device__ __forceinline__ unsigned cvt_pk_bf16(float lo, float hi) { unsigned r; asm volatile("v_cvt_pk_bf16_f32 %0, %1, %2" : "=v"(r) : "v"(lo), "v"(hi)); return r; }
typedef float f32x2 __attribute__((ext_vector_type(2)));
struct EpiU {
    static constexpr bool PERM = true, AFTER_DRAIN = false;
    bf16_t* O;
    __device__ __forceinline__ void operator()(const f32x4 (&acc)[2][2][4][2], const Unit& u, int wr, int wc, int fr, int fq) const {
        const int row0 = u.pm * BM + wr * 64 + fr; const int col0 = u.pn * BM + wc * 32 + 8 * fq;
#pragma unroll
        for (int ai = 0; ai < 2; ++ai)
#pragma unroll
            for (int m = 0; m < 4; ++m) { bf16_t* rowp = O + (size_t)(row0 + ai * HALF + m * 16) * 5504 + col0;
#pragma unroll
                for (int bj = 0; bj < 2; ++bj) { if (u.pn * BM + bj * HALF < 5504) { const f32x4 v0 = acc[ai][bj][m][0], v1 = acc[ai][bj][m][1];
                    u32x4 w; w.x = cvt_pk_bf16(v0[0], v0[1]); w.y = cvt_pk_bf16(v0[2], v0[3]); w.z = cvt_pk_bf16(v1[0], v1[1]); w.w = cvt_pk_bf16(v1[2], v1[3]);
                    *(u32x4*)(rowp + bj * HALF) = w; } } }
    }
};
struct EpiRes {
    static constexpr bool PERM = false, AFTER_DRAIN = false;
    float* H;
    __device__ __forceinline__ void operator()(const f32x4 (&acc)[2][2][4][2], const Unit& u, int wr, int wc, int fr, int fq) const {
        const int col0 = u.pn * BM + wc * 32 + 4 * fq;
#pragma unroll
        for (int ai = 0; ai < 2; ++ai)
#pragma unroll
            for (int m = 0; m < 4; ++m) { float* rowp = H + (size_t)(u.pm * BM + ai * HALF + wr * 64 + m * 16 + fr) * 2048 + col0;
#pragma unroll
                for (int bj = 0; bj < 2; ++bj)
#pragma unroll
                    for (int n = 0; n < 2; ++n) { f32x4* p = (f32x4*)(rowp + bj * HALF + n * 16); *p = *p + acc[ai][bj][m][n]; } }
    }
};
template <class Epi, class Sched, bool ALIGN_EPI = false, bool SP2 = false>
__device__ __forceinline__ void gemm_phase(PG8_LAS unsigned char* lds, const Gemm g, const Sched& S, const Epi& E) {
    int tid_l = threadIdx.x; asm volatile("" : "+v"(tid_l));
    const int tid = tid_l, wid = __builtin_amdgcn_readfirstlane(tid >> 6), lane = tid & 63, wr = wid >> 2, wc = wid & 3, fr = lane & 15, fq = lane >> 4;
    const int K = g.K, nt = K / BK;
    unsigned voffA[2], voffB[2];
#pragma unroll
    for (int i = 0; i < 2; ++i) { int R, C; stage_rc(tid * 16 + i * 8192, R, C); const int Rb = Epi::PERM ? ((R & ~31) + perm32(R & 31)) : R;
        voffA[i] = (unsigned)(R * K + C) * 2u; voffB[i] = (unsigned)(Rb * K + C) * 2u; }
    const size_t kstep = (size_t)(BK * 2);
    const size_t hstep = (size_t)HALF * K * 2;
    const size_t tstep = 2 * hstep;
    const unsigned ldsw = (unsigned)wid * 1024u;
    const int aoff = lds_byte(wr * 64 + fr, fq * 8), boff = lds_byte(wc * 32 + fr, fq * 8);
#define PG8_SA(b, h) (((b) * 2 + (h)) * HTB)
#define PG8_SB(b, h) ((4 + (b) * 2 + (h)) * HTB)
#define PG8_STAGE(bufoff, gbase, voff) do { _Pragma("unroll") for (int _i = 0; _i < 2; ++_i) \
        __builtin_amdgcn_global_load_lds((const unsigned*)((const char*)(gbase) + (voff)[_i]), (PG8_LAS unsigned*)(lds + (bufoff) + ldsw + _i * 8192), 16, 0, 0); } while (0)
#define PG8_LDA(dst, b, h) do { _Pragma("unroll") for (int m = 0; m < 4; ++m) _Pragma("unroll") for (int k = 0; k < 2; ++k) dst[m][k] = *(const PG8_LAS bf16x8*)(lds + PG8_SA(b, h) + aoff + m * 2048 + k * 1024); } while (0)
#define PG8_LDB(dst, b, h) do { _Pragma("unroll") for (int n = 0; n < 2; ++n) _Pragma("unroll") for (int k = 0; k < 2; ++k) dst[n][k] = *(const PG8_LAS bf16x8*)(lds + PG8_SB(b, h) + boff + n * 2048 + k * 1024); } while (0)
#define PG8_MMA(ai, bj, At, Bt) do { __builtin_amdgcn_s_setprio(1); _Pragma("unroll") for (int m = 0; m < 4; ++m) _Pragma("unroll") for (int n = 0; n < 2; ++n) _Pragma("unroll") for (int k = 0; k < 2; ++k) \
        acc[ai][bj][m][n] = __builtin_amdgcn_mfma_f32_16x16x32_bf16(Bt[n][k], At[m][k], acc[ai][bj][m][n], 0, 0, 0); __builtin_amdgcn_s_setprio(0); } while (0)
#define PG8_WAIT_V(n) asm volatile("s_waitcnt vmcnt(" #n ")" ::: "memory")
#define PG8_WAIT_L(n) asm volatile("s_waitcnt lgkmcnt(" #n ")" ::: "memory")
#define PG8_BAR __builtin_amdgcn_s_barrier()
#define PG8_SCHED __builtin_amdgcn_sched_barrier(0)
    Unit cur, nxt; int ui = 0;
    if (!S.next(0, cur)) return;
    f32x4 acc[2][2][4][2];
#pragma unroll
    for (int a = 0; a < 2; ++a)
#pragma unroll
        for (int b = 0; b < 2; ++b)
#pragma unroll
            for (int m = 0; m < 4; ++m)
#pragma unroll
                for (int n = 0; n < 2; ++n) acc[a][b][m][n] = (f32x4){0.f, 0.f, 0.f, 0.f};
    bf16x8 At[4][2], B0[2][2], B1[2][2];
    const char* cA = (const char*)g.A + (size_t)cur.pm * tstep; const char* cB = (const char*)g.Bt + (size_t)cur.pn * tstep;
    S.a_ready(cur);
    if constexpr (SP2) {
        PG8_STAGE(PG8_SB(0, 0), cB, voffB); PG8_STAGE(PG8_SB(0, 1), cB + hstep, voffB); PG8_STAGE(PG8_SA(0, 0), cA, voffA); PG8_STAGE(PG8_SA(0, 1), cA + hstep, voffA);
        if (wr == 1) PG8_BAR;
        PG8_WAIT_V(2); PG8_BAR;
        PG8_STAGE(PG8_SB(1, 0), cB + kstep, voffB); PG8_STAGE(PG8_SA(1, 0), cA + kstep, voffA); PG8_STAGE(PG8_SB(1, 1), cB + hstep + kstep, voffB);
        PG8_WAIT_V(6); PG8_BAR;
    } else {
        PG8_STAGE(PG8_SB(0, 0), cB, voffB); PG8_STAGE(PG8_SA(0, 0), cA, voffA); PG8_STAGE(PG8_SB(0, 1), cB + hstep, voffB); PG8_STAGE(PG8_SA(0, 1), cA + hstep, voffA);
        if (wr == 1) PG8_BAR;
        PG8_WAIT_V(4); PG8_BAR;
        PG8_STAGE(PG8_SB(1, 0), cB + kstep, voffB); PG8_STAGE(PG8_SA(1, 0), cA + kstep, voffA); PG8_STAGE(PG8_SB(1, 1), cB + hstep + kstep, voffB);
        PG8_WAIT_V(6); PG8_BAR;
    }
    for (;;) {
        const bool has_next = S.next(ui + 1, nxt);
        const char* nA = has_next ? (const char*)g.A + (size_t)nxt.pm * tstep : cA; const char* nB = has_next ? (const char*)g.Bt + (size_t)nxt.pn * tstep : cB;
        for (int t = 0; t < nt; t += 2) {
            const bool last = (t == nt - 2);
            const char* a1 = cA + (size_t)(t + 1) * kstep;
            const char* a2 = last ? nA : cA + (size_t)(t + 2) * kstep; const char* b2 = last ? nB : cB + (size_t)(t + 2) * kstep;
            const char* a3 = a2 + kstep; const char* b3 = b2 + kstep;
            if (last && has_next) S.a_ready(nxt);
            if constexpr (SP2) {
            PG8_LDB(B0, 0, 0); PG8_LDB(B1, 0, 1); PG8_SCHED; PG8_LDA(At, 0, 0); PG8_STAGE(PG8_SA(1, 1), a1 + hstep, voffA);
            PG8_WAIT_V(8); PG8_WAIT_L(0); PG8_BAR; PG8_MMA(0, 0, At, B0); PG8_MMA(0, 1, At, B1); PG8_BAR; PG8_SCHED;
            PG8_LDA(At, 0, 1); PG8_STAGE(PG8_SB(0, 0), b2, voffB); PG8_STAGE(PG8_SB(0, 1), b2 + hstep, voffB); PG8_STAGE(PG8_SA(0, 0), a2, voffA);
            PG8_WAIT_V(8); PG8_WAIT_L(0); PG8_BAR; PG8_MMA(1, 0, At, B0); PG8_MMA(1, 1, At, B1); PG8_BAR; PG8_SCHED;
            PG8_LDB(B0, 1, 0); PG8_LDB(B1, 1, 1); PG8_SCHED; PG8_LDA(At, 1, 0); PG8_STAGE(PG8_SA(0, 1), a2 + hstep, voffA);
            PG8_WAIT_V(8); PG8_WAIT_L(0); PG8_BAR; PG8_MMA(0, 0, At, B0); PG8_MMA(0, 1, At, B1); PG8_BAR; PG8_SCHED;
            PG8_LDA(At, 1, 1); PG8_STAGE(PG8_SB(1, 0), b3, voffB); PG8_STAGE(PG8_SB(1, 1), b3 + hstep, voffB); PG8_STAGE(PG8_SA(1, 0), a3, voffA);
            PG8_WAIT_V(8); PG8_WAIT_L(0); PG8_BAR; PG8_MMA(1, 0, At, B0); PG8_MMA(1, 1, At, B1); PG8_BAR; PG8_SCHED;
            } else {
            PG8_LDB(B0, 0, 0); PG8_SCHED; PG8_LDA(At, 0, 0); PG8_STAGE(PG8_SA(1, 1), a1 + hstep, voffA);
            PG8_WAIT_L(8); PG8_BAR; PG8_WAIT_L(0); PG8_MMA(0, 0, At, B0); PG8_BAR; PG8_SCHED;
            PG8_LDB(B1, 0, 1); PG8_STAGE(PG8_SB(0, 0), b2, voffB);
            PG8_BAR; PG8_WAIT_L(0); PG8_MMA(0, 1, At, B1); PG8_BAR;
            PG8_LDA(At, 0, 1); PG8_STAGE(PG8_SA(0, 0), a2, voffA);
            PG8_BAR; PG8_WAIT_L(0); PG8_MMA(1, 0, At, B0); PG8_BAR; PG8_SCHED;
            PG8_STAGE(PG8_SB(0, 1), b2 + hstep, voffB);
            PG8_WAIT_V(6); PG8_BAR; PG8_MMA(1, 1, At, B1); PG8_BAR;
            PG8_LDB(B0, 1, 0); PG8_SCHED; PG8_LDA(At, 1, 0); PG8_STAGE(PG8_SA(0, 1), a2 + hstep, voffA);
            PG8_WAIT_L(8); PG8_BAR; PG8_WAIT_L(0); PG8_MMA(0, 0, At, B0); PG8_BAR; PG8_SCHED;
            PG8_LDB(B1, 1, 1); PG8_STAGE(PG8_SB(1, 0), b3, voffB);
            PG8_BAR; PG8_WAIT_L(0); PG8_MMA(0, 1, At, B1); PG8_BAR;
            PG8_LDA(At, 1, 1); PG8_STAGE(PG8_SA(1, 0), a3, voffA);
            PG8_BAR; PG8_WAIT_L(0); PG8_MMA(1, 0, At, B0); PG8_BAR; PG8_SCHED;
            PG8_STAGE(PG8_SB(1, 1), b3 + hstep, voffB);
            PG8_WAIT_V(6); PG8_BAR; PG8_MMA(1, 1, At, B1); PG8_BAR;
            }
        }
        if constexpr (ALIGN_EPI) { if (wr == 0) PG8_BAR; }
        if constexpr (!Epi::AFTER_DRAIN) { E(acc, cur, wr, wc, fr, fq); S.done(cur); }
        if (!has_next) break;
#pragma unroll
        for (int a = 0; a < 2; ++a)
#pragma unroll
            for (int b = 0; b < 2; ++b)
#pragma unroll
                for (int m = 0; m < 4; ++m)
#pragma unroll
                    for (int n = 0; n < 2; ++n) acc[a][b][m][n] = (f32x4){0.f, 0.f, 0.f, 0.f};
        cur = nxt; cA = nA; cB = nB; ++ui;
        if constexpr (ALIGN_EPI) { if (wr == 1) PG8_BAR; }
    }
    PG8_WAIT_V(0);
    if constexpr (!ALIGN_EPI) { if (wr == 0) PG8_BAR; }
    PG8_BAR;
    if constexpr (Epi::AFTER_DRAIN) { E.fused(acc, cur, wr, wc, fr, fq, lds, wid, lane); S.done(cur); }
#undef PG8_SA
#undef PG8_SB
#undef PG8_STAGE
#undef PG8_LDA
#undef PG8_LDB
#undef PG8_MMA
#undef PG8_WAIT_V
#undef PG8_WAIT_L
#undef PG8_BAR
#undef PG8_SCHED
}
}

constexpr int NWAVES = 8;
constexpr int D = 2048, BATCH = 4, SEQ = 8192, DEPTH = 4, DECB = 8, DECS = 32;
constexpr int MP = BATCH * SEQ, MS = DECB * DECS, M = MP + MS;
constexpr int DIN = 5504, DINP = 5632;
constexpr int C_P = 0, C_GP = 512, C_Q = 1024, C_K = 2048, C_V = 2176, C_GA = 2304, C_XC = 3328, C_GR = 4992;
constexpr int DSH = 1664;
constexpr float NORM_EPS = 1e-5f, LNX_EPS = 1e-5f * 64.f;
constexpr size_t UPITCH_B = (size_t)DIN * 2;
constexpr size_t UXC_B = (size_t)C_XC * 2;
constexpr size_t O_YP = 0, O_YS = (size_t)MP * D, O_POOLP = O_YS + (size_t)MS * D;
constexpr size_t O_KP = O_POOLP + (size_t)DEPTH * BATCH * 15 * 512, O_VP = O_KP + (size_t)DEPTH * BATCH * 128 * 128;
constexpr size_t O_SHP = O_VP + (size_t)DEPTH * BATCH * 128 * 128, O_WKVP = O_SHP + (size_t)DEPTH * BATCH * DSH;
constexpr size_t O_POOLS = O_WKVP + (size_t)DEPTH * BATCH * 8 * 4096, O_KS = O_POOLS + (size_t)DEPTH * DECB * 15 * 512;
constexpr size_t O_VS = O_KS + (size_t)DEPTH * DECB * 128 * 128, O_SHS = O_VS + (size_t)DEPTH * DECB * 128 * 128;
constexpr size_t O_WKVS = O_SHS + (size_t)DEPTH * DECB * DSH, O_END = O_WKVS + (size_t)DEPTH * DECB * 8 * 4096;
constexpr size_t MiB = 1u << 20;
constexpr size_t WS_CTL = 0, CTL_ZERO_BYTES = 1 * MiB;
constexpr size_t WS_WINT = 1 * MiB;
constexpr size_t WS_WOUTT = WS_WINT + (size_t)DEPTH * DINP * D * 2;
constexpr size_t WS_PWT = WS_WOUTT + (size_t)DEPTH * D * D * 2;
constexpr size_t WS_BIAS = WS_PWT + (size_t)DEPTH * 4 * 128 * 128 * 2;
constexpr size_t WS_RK = WS_BIAS + 256 * 16 * 4;
constexpr size_t WS_XN = WS_RK + (size_t)M * 8 * 4;
constexpr size_t WS_U = WS_XN + (size_t)M * D * 2;
constexpr size_t WS_SCN = WS_U + (size_t)M * DIN * 2;
constexpr size_t WS_END = WS_SCN + (size_t)M * 3072 * 4;
static_assert(WS_END <= (size_t)1024 * MiB, "workspace map exceeds 1 GiB");
static_assert(WS_XN % 256 == 0 && WS_U % 256 == 0 && WS_SCN % 256 == 0 && WS_RK % 256 == 0, "alignment");
constexpr int CW_BAR = 4096;
constexpr int RING_BYTES = 131072, LDSCTL_OFF = RING_BYTES, MISC_OFF = LDSCTL_OFF + 320, LDS_BYTES = 147456;

#define GAS __attribute__((address_space(1)))
#define LAS __attribute__((address_space(3)))
typedef unsigned short bf16;
typedef unsigned v4u __attribute__((ext_vector_type(4)));
typedef unsigned v2u __attribute__((ext_vector_type(2)));
typedef float f32x4 __attribute__((ext_vector_type(4)));
typedef float f32x16 __attribute__((ext_vector_type(16)));
typedef short bf16x8 __attribute__((ext_vector_type(8)));
typedef GAS unsigned gu32;
#define RLX_AGENT __ATOMIC_RELAXED, __HIP_MEMORY_SCOPE_AGENT
#define LDS_WAIT() asm volatile("s_waitcnt lgkmcnt(0)" ::: "memory")
#define VM_WAIT() asm volatile("s_waitcnt vmcnt(0)" ::: "memory")
__device__ __forceinline__ unsigned f2bf(float f) { unsigned u = __builtin_bit_cast(unsigned, f); return (u + 0x7fffu + ((u >> 16) & 1u)) >> 16; }
__device__ __forceinline__ unsigned pk2(float lo, float hi) { return f2bf(lo) | (f2bf(hi) << 16); }
__device__ __forceinline__ float bflo(unsigned w) { return __uint_as_float(w << 16); }
__device__ __forceinline__ float bfhi(unsigned w) { return __uint_as_float(w & 0xffff0000u); }
__device__ __forceinline__ float bf1(bf16 h) { return __uint_as_float(((unsigned)h) << 16); }
__device__ __forceinline__ float silu(float x) { return x / (1.f + __expf(-x)); }
__device__ __forceinline__ float wave_sum(float v) {
#pragma unroll
    for (int o = 1; o < 64; o <<= 1) v += __shfl_xor(v, o);
    return v;
}
template <int CTRL> __device__ __forceinline__ float dpp_add(float x) {
    const int y = __builtin_amdgcn_update_dpp(0, __float_as_int(x), CTRL, 0xf, 0xf, true);
    return x + __int_as_float(y);
}
__device__ __forceinline__ float row16_sum(float x) {
    x = dpp_add<0xB1>(x);
    x = dpp_add<0x4E>(x);
    x = dpp_add<0x141>(x);
    x = dpp_add<0x140>(x);
    return x;
}
#define XB_TMO      128
#define XB_XCNT(j)  (256  + 64 * (j))
#define XB_XSUB(j)  (1280 + 64 * (j))
#define XB_XGEN(j)  (2304 + 64 * (j))
#define XB_TOP      3328
#define XB_TOPGEN   3392
#define XCD_BAR_WORDS 3456
#define XB_SPIN_CAP (1u << 18)

__device__ __forceinline__ unsigned xb_ld(unsigned* p)              { return __hip_atomic_load(p, __ATOMIC_RELAXED, __HIP_MEMORY_SCOPE_AGENT); }
__device__ __forceinline__ unsigned xb_add(unsigned* p, unsigned v) { return __hip_atomic_fetch_add(p, v, __ATOMIC_RELAXED, __HIP_MEMORY_SCOPE_AGENT); }
__device__ __forceinline__ unsigned xb_xcc_id() { return (unsigned)__builtin_amdgcn_s_getreg((3 << 11) | 20) & 0xFu; }
#define XB_SPIN(cond, bar) do { unsigned _sp = 0; while (cond) { __builtin_amdgcn_s_sleep(1); \
    if ((++_sp & 255u) == 0u) { if (xb_ld(&(bar)[XB_TMO])) break; if (_sp > XB_SPIN_CAP) { atomicAdd(&(bar)[XB_TMO], 1u); break; } } } } while (0)

struct XcdBarrier {
    unsigned* bar; unsigned x;
    volatile LAS unsigned* st;
};

__device__ __forceinline__ XcdBarrier xcd_barrier_post(unsigned* bar, volatile LAS unsigned* st) {
    XcdBarrier b; b.bar = bar; b.x = xb_xcc_id(); b.st = st;
    if (threadIdx.x == 0) (void)xb_add(&bar[XB_XCNT(b.x)], 1u);
    return b;
}
__device__ __forceinline__ void xcd_barrier_complete(unsigned* bar, unsigned x, unsigned& nloc, unsigned& nx) {
    const unsigned G = gridDim.x * gridDim.y * gridDim.z;
    unsigned sum, cnt, mine, sp = 0u;
    for (;;) {
        sum = 0u; cnt = 0u; mine = 0u;
#pragma unroll
        for (unsigned j = 0; j < 16; ++j) { const unsigned c = xb_ld(&bar[XB_XCNT(j)]); sum += c; cnt += (c > 0u) ? 1u : 0u; mine = (j == x) ? c : mine; }
        if (sum == G) break;
        __builtin_amdgcn_s_sleep(1);
        if ((++sp & 255u) == 0u) { if (xb_ld(&bar[XB_TMO])) break; if (sp > XB_SPIN_CAP) { atomicAdd(&bar[XB_TMO], 1u); break; } }
    }
    nloc = mine > 0u ? mine : 1u; nx = cnt > 0u ? cnt : 1u;
}

__device__ __forceinline__ void xcd_barrier(const XcdBarrier& b) {
    asm volatile("s_waitcnt vmcnt(0)" ::: "memory");
    __syncthreads();
    if (threadIdx.x == 0) {
        unsigned* bar = b.bar;
        __builtin_amdgcn_s_waitcnt(0);
        unsigned nloc = b.st[0], nx = b.st[1];
        if (nloc == 0u) { xcd_barrier_complete(bar, b.x, nloc, nx); b.st[0] = nloc; b.st[1] = nx; }
        const unsigned old = xb_add(&bar[XB_XSUB(b.x)], 1u);
        const unsigned gen = old / nloc;
        if (old + 1u == (gen + 1u) * nloc) {
            __builtin_amdgcn_fence(__ATOMIC_RELEASE, "agent");
            asm volatile("s_waitcnt vmcnt(0)" ::: "memory");
            const unsigned og = xb_add(&bar[XB_TOP], 1u);
            const unsigned tg = og / nx;
            if (og + 1u == (tg + 1u) * nx) xb_add(&bar[XB_TOPGEN], 1u);
            else XB_SPIN(xb_ld(&bar[XB_TOPGEN]) == tg, bar);
            __builtin_amdgcn_fence(__ATOMIC_ACQUIRE, "agent");
            xb_add(&bar[XB_XGEN(b.x)], 1u);
            asm volatile("s_waitcnt vmcnt(0)" ::: "memory");
        } else {
            XB_SPIN(xb_ld(&bar[XB_XGEN(b.x)]) == gen, bar);
            __builtin_amdgcn_fence(__ATOMIC_ACQUIRE, "agent");
            asm volatile("s_waitcnt vmcnt(0)" ::: "memory");
        }
    }
    __syncthreads();
}

struct Args { const float* in[25]; float* out; unsigned char* ws; int ph_lo, ph_hi, coop, pad; };
struct Ctx { LAS unsigned char* lds; int tid, lane, wave, G, bid; };
enum { I_XP = 0, I_XS, I_SPOOL, I_CK, I_CV, I_SSHIFT, I_SWKV, I_NORMW, I_WIN, I_WOUT, I_POOLW, I_POOLS, I_SINKS, I_RELB, I_MU, I_W0, I_WUP, I_A0, I_AUP, I_KK, I_KA, I_RK, I_LNXW, I_LNXB, I_FNW };

#define WS_PTR(T, off) ((T*)(A.ws + (off)))

__device__ __forceinline__ void transpose_item(const float* W, int K, int N, bf16* WT, LAS float* scr, int item, int lane) {
    const int nblk = N / 32, kb = item / nblk, nb = item % nblk, k0 = 64 * kb, n0 = 32 * nb;
#pragma unroll 8
    for (int i = 0; i < 32; ++i) { const int kk = 2 * i + (lane >> 5); scr[kk * 33 + (lane & 31)] = W[(size_t)(k0 + kk) * N + n0 + (lane & 31)]; }
    LDS_WAIT(); asm volatile("" ::: "memory");
    const int c = lane & 7;
#pragma unroll
    for (int j = 0; j < 4; ++j) { const int n = (lane >> 3) + 8 * j; const LAS float* s = scr + (8 * c) * 33 + n;
        v4u o; o.x = pk2(s[0 * 33], s[1 * 33]); o.y = pk2(s[2 * 33], s[3 * 33]); o.z = pk2(s[4 * 33], s[5 * 33]); o.w = pk2(s[6 * 33], s[7 * 33]);
        *(v4u*)(WT + (size_t)(n0 + n) * K + k0 + 8 * c) = o; }
    LDS_WAIT(); asm volatile("" ::: "memory");
}
__device__ __forceinline__ void norm_row(const float* src, const float* w, bf16* xn, float* hcopy, float* y, int lane) {
    const f32x4* xr = (const f32x4*)src + lane;
    f32x4 v[8]; float s = 0.f;
#pragma unroll
    for (int j = 0; j < 8; ++j) { v[j] = xr[64 * j]; s += (v[j].x * v[j].x + v[j].y * v[j].y) + (v[j].z * v[j].z + v[j].w * v[j].w); }
    const float rstd = 1.f / sqrtf(wave_sum(s) * (1.f / D) + NORM_EPS);
    if (hcopy) {
#pragma unroll
        for (int j = 0; j < 8; ++j) ((f32x4*)hcopy + lane)[64 * j] = v[j];
    }
    const f32x4* wr = (const f32x4*)w + lane;
#pragma unroll
    for (int j = 0; j < 8; ++j) { const f32x4 ww = wr[64 * j]; const f32x4 o = v[j] * rstd * ww;
        if (xn) { v2u p; p.x = pk2(o.x, o.y); p.y = pk2(o.z, o.w); ((v2u*)xn + lane)[64 * j] = p; }
        if (y) ((f32x4*)y + lane)[64 * j] = o; }
}
__device__ __forceinline__ int t5_bucket(int rel) {
    const int n = rel < 0 ? -rel : rel; int v;
    if (n < 8) v = n; else v = 8 + (n >= 12) + (n >= 16) + (n >= 23) + (n >= 32) + (n >= 46) + (n >= 64) + (n >= 91);
    return (rel > 0 ? 16 : 0) + v;
}

__device__ __forceinline__ void phase_prologue(const Args& A, const Ctx& C0) {
    Ctx C = C0; asm volatile("" : "+v"(C.tid)); C.lane = C.tid & 63; C.wave = __builtin_amdgcn_readfirstlane(C.tid >> 6);
    LAS float* scr = (LAS float*)(C.lds + C.wave * 16384);
    const int gw = C.bid * NWAVES + C.wave, NGW = C.G * NWAVES;
    constexpr int I_IN = (D / 64) * (DIN / 32), I_OUT = (D / 64) * (D / 32), I_PW = 4 * 8, PER_L = I_IN + I_OUT + I_PW;
    for (int it = gw; it < DEPTH * PER_L; it += NGW) {
        const int l = it / PER_L; int r = it % PER_L;
        if (r < I_IN) { transpose_item(A.in[I_WIN] + (size_t)l * D * DIN, D, DIN, WS_PTR(bf16, WS_WINT) + (size_t)l * DINP * D, scr, r, C.lane); continue; } r -= I_IN;
        if (r < I_OUT) { transpose_item(A.in[I_WOUT] + (size_t)l * D * D, D, D, WS_PTR(bf16, WS_WOUTT) + (size_t)l * D * D, scr, r, C.lane); continue; } r -= I_OUT;
        { const int g = r >> 3; transpose_item(A.in[I_POOLW] + (size_t)(l * 4 + g) * 128 * 128, 128, 128, WS_PTR(bf16, WS_PWT) + (size_t)(l * 4 + g) * 128 * 128, scr, r & 7, C.lane); }
    }
    { const int gt = C.bid * 512 + C.tid, NGT = C.G * 512; constexpr int PER = (DINP - DIN) * D * 2 / 16;
      for (int i = gt; i < DEPTH * PER; i += NGT) { const int l = i / PER, r = i % PER; ((v4u*)(WS_PTR(bf16, WS_WINT) + (size_t)l * DINP * D + (size_t)DIN * D))[r] = (v4u){0u, 0u, 0u, 0u}; } }
    if (C.bid == 0) { float* B = WS_PTR(float, WS_BIAS);
        for (int i = C.tid; i < 256 * 16; i += 512) { const int ri = i >> 4, h = i & 15; const int rel = ri - 191; B[i] = (ri < 255) ? A.in[I_RELB][t5_bucket(rel) * 16 + h] : 0.f; } }
    for (int m = gw; m < M; m += NGW) { const float* src = m < MP ? A.in[I_XP] + (size_t)m * D : A.in[I_XS] + (size_t)(m - MP) * D;
        norm_row(src, A.in[I_NORMW], WS_PTR(bf16, WS_XN) + (size_t)m * D, A.out + (size_t)m * D, nullptr, C.lane); }
}

__device__ __forceinline__ void phase_prep(const Args& A, const Ctx& C0, int l) {
    Ctx C = C0; asm volatile("" : "+v"(C.tid)); C.lane = C.tid & 63; C.wave = __builtin_amdgcn_readfirstlane(C.tid >> 6);
    LAS float* raw = (LAS float*)C.lds;
    LAS float* lo = (LAS float*)(C.lds + 9 * DSH * 4);
    const bf16* U = WS_PTR(const bf16, WS_U);
    float* SCN = WS_PTR(float, WS_SCN); float* RKB = WS_PTR(float, WS_RK);
    const int c = C.tid, head = C.wave;
    float wup[64], aup[64];
    { const float* WU = A.in[I_WUP] + (size_t)l * 64 * 512 + c; const float* AU = A.in[I_AUP] + (size_t)l * 64 * 512 + c;
#pragma unroll
      for (int j = 0; j < 64; ++j) { wup[j] = WU[j * 512]; aup[j] = AU[j * 512]; } }
    const float w0 = A.in[I_W0][l * 512 + c], a0 = A.in[I_A0][l * 512 + c], kkc = A.in[I_KK][l * 512 + c], kac = A.in[I_KA][l * 512 + c], rkc = A.in[I_RK][l * 512 + c];
    const float* mul = A.in[I_MU] + (size_t)l * DSH;
    const float mu_r = mul[c], mu_k = mul[512 + c], mu_v = mul[1024 + c];
    for (int tile = C.bid; tile < M / 8; tile += C.G) {
        const int row0 = tile * 8;
        bool seq_start; const float* shiftp = nullptr;
        if (row0 < MP) seq_start = (row0 % SEQ) == 0; else { const int rs = row0 - MP; seq_start = (rs % DECS) == 0; shiftp = A.in[I_SSHIFT] + (size_t)(l * DECB + rs / DECS) * DSH; }
        for (int idx = C.tid; idx < 9 * 208; idx += 512) { const int rr = idx / 208, v = idx % 208;
            f32x4 f0, f1;
            if (rr == 0 && seq_start) { if (shiftp) { f0 = *(const f32x4*)(shiftp + v * 8); f1 = *(const f32x4*)(shiftp + v * 8 + 4); } else { f0 = (f32x4){0.f, 0.f, 0.f, 0.f}; f1 = f0; } }
            else { const v4u x = *(const v4u*)(U + (size_t)(row0 - 1 + rr) * DIN + C_XC + v * 8);
                f0 = (f32x4){bflo(x.x), bfhi(x.x), bflo(x.y), bfhi(x.y)}; f1 = (f32x4){bflo(x.z), bfhi(x.z), bflo(x.w), bfhi(x.w)}; }
            *(LAS f32x4*)(raw + rr * DSH + v * 8) = f0; *(LAS f32x4*)(raw + rr * DSH + v * 8 + 4) = f1; }
        __syncthreads();
#pragma unroll
        for (int k = 0; k < 2; ++k) { const int idx = C.tid + 512 * k, tt = idx >> 7, j = idx & 127, i = 1536 + j;
            const float cur = raw[(tt + 1) * DSH + i], prev = raw[tt * DSH + i]; const float xs = cur + (prev - cur) * mul[i];
            float o = xs; if (j < 64) { const float e = __expf(2.f * xs); o = 1.f - 2.f / (e + 1.f); }
            lo[tt * 128 + j] = o; }
        __syncthreads();
#pragma unroll 1
        for (int tt = 0; tt < 8; ++tt) {
            float aw = 0.f, aa = 0.f;
            const LAS float* lt = lo + tt * 128;
#pragma unroll
            for (int j4 = 0; j4 < 16; ++j4) { const f32x4 x = *(const LAS f32x4*)(lt + 4 * j4), y = *(const LAS f32x4*)(lt + 64 + 4 * j4);
                aw += x.x * wup[4 * j4] + x.y * wup[4 * j4 + 1] + x.z * wup[4 * j4 + 2] + x.w * wup[4 * j4 + 3];
                aa += y.x * aup[4 * j4] + y.y * aup[4 * j4 + 1] + y.z * aup[4 * j4 + 2] + y.w * aup[4 * j4 + 3]; }
            const int row = row0 + tt;
            const LAS float* cu = raw + (tt + 1) * DSH; const LAS float* pv = raw + tt * DSH;
            const float r = cu[c] + (pv[c] - cu[c]) * mu_r, k = cu[512 + c] + (pv[512 + c] - cu[512 + c]) * mu_k, v = cu[1024 + c] + (pv[1024 + c] - cu[1024 + c]) * mu_v;
            const float lw = w0 + aw; const float z = -lw;
            const float sp = fmaxf(z, 0.f) + logf(1.f + expf(-fabsf(z)));
            const float wraw = -sp - 0.5f; const float decay = expf(-expf(wraw));
            const float ai = 1.f / (1.f + expf(-(a0 + aa)));
            const float kkr = k * kkc; const float ss = wave_sum(kkr * kkr);
            const float kk = kkr / fmaxf(sqrtf(ss), 1e-12f);
            const float k2 = k * (1.f + (ai - 1.f) * kac); const float b = kk * ai;
            const float rk = wave_sum(r * k2 * rkc);
            float* s = SCN + (size_t)row * 3072 + head * 384 + C.lane;
            s[0] = kk; s[64] = b; s[128] = decay; s[192] = k2; s[256] = r; s[320] = v;
            if (C.lane == 0) RKB[row * 8 + head] = rk;
        }
        { const int lastrow = row0 + 7; bool is_last; float* dst;
          if (lastrow < MP) { is_last = (lastrow % SEQ) == SEQ - 1; dst = A.out + O_SHP + (size_t)(l * BATCH + lastrow / SEQ) * DSH; }
          else { const int rs = lastrow - MP; is_last = (rs % DECS) == DECS - 1; dst = A.out + O_SHS + (size_t)(l * DECB + rs / DECS) * DSH; }
          if (is_last) for (int i = C.tid; i < DSH; i += 512) dst[i] = raw[8 * DSH + i]; }
        __syncthreads();
    }
    { const int gt = C.bid * 512 + C.tid, NGT = C.G * 512;
      constexpr int NP = BATCH * 128 * 2 * 32, NS = DECB * 128 * 2 * 32;
      for (int i = gt; i < NP + NS; i += NGT) {
          if (i < NP) { const int q4 = i & 31, kv = (i >> 5) & 1, j = (i >> 6) & 127, b = i >> 13;
              const v2u x = *(const v2u*)(U + (size_t)(b * SEQ + SEQ - 128 + j) * DIN + (kv ? C_V : C_K) + q4 * 4);
              float* dst = A.out + (kv ? O_VP : O_KP) + ((size_t)(l * BATCH + b) * 128 + j) * 128 + q4 * 4;
              *(f32x4*)dst = (f32x4){bflo(x.x), bfhi(x.x), bflo(x.y), bfhi(x.y)}; }
          else { const int ii = i - NP; const int q4 = ii & 31, kv = (ii >> 5) & 1, j = (ii >> 6) & 127, b = ii >> 13;
              float* dst = A.out + (kv ? O_VS : O_KS) + ((size_t)(l * DECB + b) * 128 + j) * 128 + q4 * 4;
              if (j < 96) *(f32x4*)dst = *(const f32x4*)(A.in[kv ? I_CV : I_CK] + ((size_t)(l * DECB + b) * 128 + j + 32) * 128 + q4 * 4);
              else { const v2u x = *(const v2u*)(U + (size_t)(MP + b * DECS + j - 96) * DIN + (kv ? C_V : C_K) + q4 * 4);
                  *(f32x4*)dst = (f32x4){bflo(x.x), bfhi(x.x), bflo(x.y), bfhi(x.y)}; } }
      } }
}

__device__ __forceinline__ void scan_unit(const Ctx& C0, const float* scn, int T, int half, const float* S0, float* Sout, unsigned char* obase) {
    Ctx C = C0; asm volatile("" : "+v"(C.tid)); C.lane = C.tid & 63; C.wave = __builtin_amdgcn_readfirstlane(C.tid >> 6);
    LAS float* buf = (LAS float*)C.lds;
    LAS float* obuf = (LAS float*)(C.lds + 2 * 49152);
    const int q = C.lane & 15, rr = C.lane >> 4, rl = C.wave * 4 + rr, irow = half * 32 + rl;
    f32x4 S = (f32x4){0.f, 0.f, 0.f, 0.f};
    if (S0) S = *(const f32x4*)(S0 + irow * 64 + 4 * q);
    const int nch = T / 32;
    f32x4 pre[6];
#pragma unroll
    for (int m = 0; m < 6; ++m) { const int idx = C.tid + 512 * m; pre[m] = *(const f32x4*)(scn + (size_t)(idx / 96) * 3072 + (idx % 96) * 4); }
#pragma unroll
    for (int m = 0; m < 6; ++m) *(LAS f32x4*)(buf + (C.tid + 512 * m) * 4) = pre[m];
    __syncthreads();
    for (int k = 0; k < nch; ++k) {
        const bool more = (k + 1 < nch);
        if (more) {
#pragma unroll
            for (int m = 0; m < 6; ++m) { const int idx = C.tid + 512 * m; pre[m] = *(const f32x4*)(scn + (size_t)((k + 1) * 32 + idx / 96) * 3072 + (idx % 96) * 4); }
        }
        const LAS float* bb = buf + (k & 1) * 12288; LAS float* ob = obuf + (k & 1) * 1024;
#pragma unroll 4
        for (int s = 0; s < 32; ++s) {
            const LAS float* p = bb + s * 384 + 4 * q;
            const f32x4 kk = *(const LAS f32x4*)(p), b = *(const LAS f32x4*)(p + 64), w = *(const LAS f32x4*)(p + 128), k2 = *(const LAS f32x4*)(p + 192), r = *(const LAS f32x4*)(p + 256);
            const float v = bb[s * 384 + 320 + irow];
            float d = S.x * kk.x + S.y * kk.y + S.z * kk.z + S.w * kk.w;
            const float sa = -row16_sum(d);
            S = S * w + (sa * b + v * k2);
            float o = S.x * r.x + S.y * r.y + S.z * r.z + S.w * r.w;
            o = row16_sum(o);
            if (q == 0) ob[s * 32 + rl] = o;
        }
        if (more) {
#pragma unroll
            for (int m = 0; m < 6; ++m) *(LAS f32x4*)(buf + ((k + 1) & 1) * 12288 + (C.tid + 512 * m) * 4) = pre[m];
        }
        __syncthreads();
        if (C.tid < 256) { const int s = C.tid >> 3, c4 = C.tid & 7;
            *(f32x4*)(obase + (size_t)(k * 32 + s) * UPITCH_B + c4 * 16) = *(const LAS f32x4*)(ob + s * 32 + c4 * 4); }
    }
    *(f32x4*)(Sout + irow * 64 + 4 * q) = S;
    __syncthreads();
}

struct AttnU { int qrow0, nq, krow0, krow1, krow2, g; const float* ck; const float* cv; unsigned vmask; };
__device__ __forceinline__ void attn_unit(const Args& A, const Ctx& C0, int l, int u_qrow0, int u_nq, int u_krow0, int u_krow1, int u_krow2, int u_g, const float* u_ck, const float* u_cv, unsigned u_vmask) {
    Ctx C = C0; asm volatile("" : "+v"(C.tid)); C.lane = C.tid & 63; C.wave = __builtin_amdgcn_readfirstlane(C.tid >> 6);
    AttnU u; u.qrow0 = u_qrow0; u.nq = u_nq; u.krow0 = u_krow0; u.krow1 = u_krow1; u.krow2 = u_krow2; u.g = u_g; u.ck = u_ck; u.cv = u_cv; u.vmask = u_vmask;
    constexpr int KP = 72, VP = 196;
    LAS bf16* Ks = (LAS bf16*)C.lds;
    LAS bf16* Vt = (LAS bf16*)(C.lds + 192 * KP * 2);
    LAS float* biasL = (LAS float*)(C.lds + 192 * KP * 2 + 64 * VP * 2);
    const bf16* U = WS_PTR(const bf16, WS_U); bf16* MIX = WS_PTR(bf16, WS_XN);
    const int hq = u.g * 8 + C.wave;
    for (int idx = C.lane; idx < 255; idx += 64) biasL[C.wave * 256 + idx] = WS_PTR(const float, WS_BIAS)[idx * 16 + hq];
    for (int idx = C.tid; idx < 192 * 8; idx += 512) { const int j = idx >> 3, part = idx & 7;
        v4u kx = (v4u){0u, 0u, 0u, 0u}, vx = kx;
        if ((u.vmask >> (j >> 5)) & 1u) {
            if (u.ck && j < 128) { const float* pk = u.ck + (size_t)j * 128 + part * 8; const float* pv = u.cv + (size_t)j * 128 + part * 8;
                const f32x4 a0 = *(const f32x4*)pk, a1 = *(const f32x4*)(pk + 4), b0 = *(const f32x4*)pv, b1 = *(const f32x4*)(pv + 4);
                kx = (v4u){pk2(a0.x, a0.y), pk2(a0.z, a0.w), pk2(a1.x, a1.y), pk2(a1.z, a1.w)}; vx = (v4u){pk2(b0.x, b0.y), pk2(b0.z, b0.w), pk2(b1.x, b1.y), pk2(b1.z, b1.w)}; }
            else { const int ch = j >> 6; const int kr = (ch == 0 ? u.krow0 : (ch == 1 ? u.krow1 : u.krow2)) + (j & 63);
                kx = *(const v4u*)(U + (size_t)kr * DIN + C_K + u.g * 64 + part * 8); vx = *(const v4u*)(U + (size_t)kr * DIN + C_V + u.g * 64 + part * 8); }
        }
        *(LAS v4u*)(Ks + j * KP + part * 8) = kx;
        LAS bf16* vd = Vt + (part * 8) * VP + j;
        vd[0 * VP] = (bf16)(vx.x & 0xffffu); vd[1 * VP] = (bf16)(vx.x >> 16); vd[2 * VP] = (bf16)(vx.y & 0xffffu); vd[3 * VP] = (bf16)(vx.y >> 16);
        vd[4 * VP] = (bf16)(vx.z & 0xffffu); vd[5 * VP] = (bf16)(vx.z >> 16); vd[6 * VP] = (bf16)(vx.w & 0xffffu); vd[7 * VP] = (bf16)(vx.w >> 16);
    }
    __syncthreads();
    const int li = C.lane & 31, h = C.lane >> 5;
    const float sink = A.in[I_SINKS][l * 16 + hq];
    const LAS float* bL = biasL + C.wave * 256;
    for (int qt = 0; qt < u.nq / 32; ++qt) {
        const int qi = qt * 32 + li;
        bf16x8 qf[4];
#pragma unroll
        for (int ks = 0; ks < 4; ++ks) qf[ks] = *(const bf16x8*)(U + (size_t)(u.qrow0 + qi) * DIN + C_Q + hq * 64 + ks * 16 + 8 * h);
        f32x16 sacc[6];
#pragma unroll
        for (int kt = 0; kt < 6; ++kt) {
#pragma unroll
            for (int r = 0; r < 16; ++r) sacc[kt][r] = 0.f;
#pragma unroll
            for (int ks = 0; ks < 4; ++ks) { const bf16x8 kf = *(const LAS bf16x8*)(Ks + (kt * 32 + li) * KP + ks * 16 + 8 * h);
                sacc[kt] = __builtin_amdgcn_mfma_f32_32x32x16_bf16(kf, qf[ks], sacc[kt], 0, 0, 0); }
            asm volatile("" ::: "memory");
        }
        float mx = sink;
#pragma unroll
        for (int kt = 0; kt < 6; ++kt) { const bool valid = (u.vmask >> kt) & 1u;
#pragma unroll
            for (int r = 0; r < 16; ++r) { const int j = kt * 32 + (r & 3) + 8 * (r >> 2) + 4 * h;
                const float lg = valid ? sacc[kt][r] * 0.125f + bL[j - qi + 63] : -1e30f; sacc[kt][r] = lg; mx = fmaxf(mx, lg); }
            asm volatile("" ::: "memory"); }
        mx = fmaxf(mx, __shfl_xor(mx, 32));
        float sum = 0.f;
#pragma unroll
        for (int kt = 0; kt < 6; ++kt)
#pragma unroll
            for (int r = 0; r < 16; ++r) { const float e = __expf(sacc[kt][r] - mx); sacc[kt][r] = e; sum += e; }
        sum += __shfl_xor(sum, 32); sum += __expf(sink - mx);
        const float inv = 1.f / sum;
        f32x16 oacc[2];
#pragma unroll
        for (int dt = 0; dt < 2; ++dt)
#pragma unroll
            for (int r = 0; r < 16; ++r) oacc[dt][r] = 0.f;
#pragma unroll
        for (int kt = 0; kt < 6; ++kt) {
            if ((u.vmask >> kt) & 1u) {
#pragma unroll
                for (int s = 0; s < 2; ++s) {
                    union { bf16x8 v; unsigned w[4]; } pf;
#pragma unroll
                    for (int e = 0; e < 4; ++e) pf.w[e] = pk2(sacc[kt][8 * s + 2 * e] * inv, sacc[kt][8 * s + 2 * e + 1] * inv);
#pragma unroll
                    for (int dt = 0; dt < 2; ++dt) { const LAS bf16* vp = Vt + (dt * 32 + li) * VP + kt * 32 + 16 * s + 4 * h;
                        union { bf16x8 v; v2u w[2]; } vf; vf.w[0] = *(const LAS v2u*)vp; vf.w[1] = *(const LAS v2u*)(vp + 8);
                        oacc[dt] = __builtin_amdgcn_mfma_f32_32x32x16_bf16(vf.v, pf.v, oacc[dt], 0, 0, 0); }
                }
            }
            asm volatile("" ::: "memory");
        }
        const size_t row = (size_t)(u.qrow0 + qi);
#pragma unroll
        for (int dt = 0; dt < 2; ++dt)
#pragma unroll
            for (int rq = 0; rq < 4; ++rq) { const int d = dt * 32 + 8 * rq + 4 * h;
                const v2u gx = *(const v2u*)(U + row * DIN + C_GA + hq * 64 + d);
                const float o0 = oacc[dt][4 * rq] * silu(bflo(gx.x)), o1 = oacc[dt][4 * rq + 1] * silu(bfhi(gx.x)), o2 = oacc[dt][4 * rq + 2] * silu(bflo(gx.y)), o3 = oacc[dt][4 * rq + 3] * silu(bfhi(gx.y));
                v2u o; o.x = pk2(o0, o1); o.y = pk2(o2, o3);
                *(v2u*)(MIX + row * D + 512 + hq * 64 + d) = o; }
    }
    __syncthreads();
}

__device__ __forceinline__ void pool_item(const Args& A, const Ctx& C0, int l, int row0, int t0, int pos0, const float* hist, float* outpool) {
    Ctx C = C0; asm volatile("" : "+v"(C.tid)); C.lane = C.tid & 63; C.wave = __builtin_amdgcn_readfirstlane(C.tid >> 6);
    constexpr int PP = 520;
    LAS bf16* P = (LAS bf16*)C.lds;
    const bf16* U = WS_PTR(const bf16, WS_U); bf16* MIX = WS_PTR(bf16, WS_XN);
    for (int idx = C.tid; idx < 47 * 64; idx += 512) { const int rr = idx >> 6, v = idx & 63;
        v4u x = (v4u){0u, 0u, 0u, 0u};
        if (rr < 15 && t0 == 0) { if (hist) { const f32x4 a0 = *(const f32x4*)(hist + rr * 512 + v * 8), a1 = *(const f32x4*)(hist + rr * 512 + v * 8 + 4);
                x = (v4u){pk2(a0.x, a0.y), pk2(a0.z, a0.w), pk2(a1.x, a1.y), pk2(a1.z, a1.w)}; } }
        else x = *(const v4u*)(U + (size_t)(row0 - 15 + rr) * DIN + C_P + v * 8);
        *(LAS v4u*)(P + rr * PP + v * 8) = x; }
    __syncthreads();
    const int g = C.wave & 3, ddh = C.wave >> 2, wd = 2 << g, tk = C.lane & 31, h = C.lane >> 5;
    const int pos = pos0 + tk; const float inv = 1.f / (float)((pos + 1) < wd ? (pos + 1) : wd);
    const bf16* PW = WS_PTR(const bf16, WS_PWT) + (size_t)(l * 4 + g) * 128 * 128;
    f32x16 acc[2];
#pragma unroll
    for (int dt = 0; dt < 2; ++dt)
#pragma unroll
        for (int r = 0; r < 16; ++r) acc[dt][r] = 0.f;
#pragma unroll
    for (int ks = 0; ks < 8; ++ks) { const int cb = g * 128 + ks * 16 + 8 * h;
        float s[8];
#pragma unroll
        for (int e = 0; e < 8; ++e) s[e] = 0.f;
        for (int i = 0; i < wd; ++i) { const v4u x = *(const LAS v4u*)(P + (15 + tk - i) * PP + cb);
            s[0] += bflo(x.x); s[1] += bfhi(x.x); s[2] += bflo(x.y); s[3] += bfhi(x.y); s[4] += bflo(x.z); s[5] += bfhi(x.z); s[6] += bflo(x.w); s[7] += bfhi(x.w); }
        const v4u cx = *(const LAS v4u*)(P + (15 + tk) * PP + cb);
        union { bf16x8 v; unsigned w[4]; } df;
        df.w[0] = pk2(s[0] * inv - bflo(cx.x), s[1] * inv - bfhi(cx.x)); df.w[1] = pk2(s[2] * inv - bflo(cx.y), s[3] * inv - bfhi(cx.y));
        df.w[2] = pk2(s[4] * inv - bflo(cx.z), s[5] * inv - bfhi(cx.z)); df.w[3] = pk2(s[6] * inv - bflo(cx.w), s[7] * inv - bfhi(cx.w));
#pragma unroll
        for (int dt = 0; dt < 2; ++dt) { const bf16x8 af = *(const bf16x8*)(PW + (size_t)(ddh * 64 + dt * 32 + tk) * 128 + ks * 16 + 8 * h);
            acc[dt] = __builtin_amdgcn_mfma_f32_32x32x16_bf16(af, df.v, acc[dt], 0, 0, 0); }
    }
    const size_t row = (size_t)(row0 + tk);
    const float* psc = A.in[I_POOLS] + l * 512;
#pragma unroll
    for (int dt = 0; dt < 2; ++dt)
#pragma unroll
        for (int rq = 0; rq < 4; ++rq) { const int cc = g * 128 + ddh * 64 + dt * 32 + 8 * rq + 4 * h;
            const v2u gx = *(const v2u*)(U + row * DIN + C_GP + cc); const f32x4 sc = *(const f32x4*)(psc + cc);
            const float o0 = acc[dt][4 * rq] * sc.x * silu(bflo(gx.x)), o1 = acc[dt][4 * rq + 1] * sc.y * silu(bfhi(gx.x)), o2 = acc[dt][4 * rq + 2] * sc.z * silu(bflo(gx.y)), o3 = acc[dt][4 * rq + 3] * sc.w * silu(bfhi(gx.y));
            v2u o; o.x = pk2(o0, o1); o.y = pk2(o2, o3);
            *(v2u*)(MIX + row * D + cc) = o; }
    if (outpool) for (int idx = C.tid; idx < 15 * 512; idx += 512) { const int rr = idx >> 9, cc = idx & 511; outpool[idx] = bf1(P[(32 + rr) * PP + cc]); }
    __syncthreads();
}

#ifndef UN_MASK
#define UN_MASK 7
#endif
__device__ __forceinline__ void mixer_item(const Args& A, const Ctx& C, int l, int it) {
    const float* SCN = WS_PTR(const float, WS_SCN); unsigned char* Ub = A.ws + WS_U;
    constexpr int N_PSCAN = BATCH * 8 * 2, N_SSCAN = DECB * 8 * 2, N_PATT = BATCH * (SEQ / 64) * 2, N_SATT = DECB * 2, N_PPOOL = MP / 32, N_SPOOL = DECB;
    if (it < N_PSCAN + N_SSCAN) {
        const bool smp = it >= N_PSCAN; const int i2 = smp ? it - N_PSCAN : it;
        const int b = i2 >> 4, hd = (i2 >> 1) & 7, half = i2 & 1; const size_t row0 = smp ? (size_t)MP + b * DECS : (size_t)b * SEQ;
        const float* S0 = smp ? A.in[I_SWKV] + ((size_t)(l * DECB + b) * 8 + hd) * 4096 : nullptr;
        float* So = smp ? A.out + O_WKVS + ((size_t)(l * DECB + b) * 8 + hd) * 4096 : A.out + O_WKVP + ((size_t)(l * BATCH + b) * 8 + hd) * 4096;
        if (UN_MASK & 1) scan_unit(C, SCN + row0 * 3072 + hd * 384, smp ? DECS : SEQ, half, S0, So, Ub + row0 * UPITCH_B + UXC_B + (hd * 64 + half * 32) * 4);
        return; }
    it -= N_PSCAN + N_SSCAN;
    if (it < N_PATT + N_SATT) { int qrow0, nq, krow0, krow1, g; const float* ck; const float* cv; unsigned vmask;
        if (it < N_PATT) { const int c = (it >> 1) & 127, b = it >> 8; g = it & 1; nq = 64; qrow0 = b * SEQ + c * 64; ck = nullptr; cv = nullptr;
            krow0 = b * SEQ + (c - 2) * 64; krow1 = b * SEQ + (c - 1) * 64; vmask = (c >= 2 ? 3u : 0u) | (c >= 1 ? 12u : 0u) | 48u; }
        else { const int i2 = it - N_PATT; const int b = i2 >> 1; g = i2 & 1; nq = 32; qrow0 = MP + b * DECS; krow0 = 0; krow1 = 0; vmask = 31u;
            ck = A.in[I_CK] + ((size_t)(l * DECB + b) * 128) * 128 + g * 64; cv = A.in[I_CV] + ((size_t)(l * DECB + b) * 128) * 128 + g * 64; }
        if (UN_MASK & 2) attn_unit(A, C, l, qrow0, nq, krow0, krow1, qrow0, g, ck, cv, vmask);
        return; }
    it -= N_PATT + N_SATT;
    { int row0, t0, pos0; const float* hist; float* outp;
      if (it < N_PPOOL) { row0 = it * 32; t0 = row0 % SEQ; pos0 = t0; hist = nullptr; outp = (t0 == SEQ - 32) ? A.out + O_POOLP + (size_t)(l * BATCH + row0 / SEQ) * 15 * 512 : nullptr; }
      else { const int b = it - N_PPOOL; row0 = MP + b * DECS; t0 = 0; pos0 = 1024; hist = A.in[I_SPOOL] + (size_t)(l * DECB + b) * 15 * 512; outp = A.out + O_POOLS + (size_t)(l * DECB + b) * 15 * 512; }
      if (UN_MASK & 4) pool_item(A, C, l, row0, t0, pos0, hist, outp); }
}
__device__ __forceinline__ void phase_mixers(const Args& A, const Ctx& C0, int l) {
    Ctx C = C0; asm volatile("" : "+v"(C.tid)); C.lane = C.tid & 63; C.wave = __builtin_amdgcn_readfirstlane(C.tid >> 6);
    constexpr int N_PSCAN = BATCH * 8 * 2;
    constexpr int NI = N_PSCAN + DECB * 8 * 2 + BATCH * (SEQ / 64) * 2 + DECB * 2 + MP / 32 + DECB;
    if (C.G >= 2 * N_PSCAN) {
        if (C.bid < N_PSCAN) mixer_item(A, C, l, C.bid);
        else for (int it = N_PSCAN + (C.bid - N_PSCAN); it < NI; it += C.G - N_PSCAN) mixer_item(A, C, l, it);
    } else for (int it = C.bid; it < NI; it += C.G) mixer_item(A, C, l, it);
}

__device__ __forceinline__ void phase_post(const Args& A, const Ctx& C0, int l) {
    Ctx C = C0; asm volatile("" : "+v"(C.tid)); C.lane = C.tid & 63; C.wave = __builtin_amdgcn_readfirstlane(C.tid >> 6);
    const bf16* U = WS_PTR(const bf16, WS_U); bf16* MIX = WS_PTR(bf16, WS_XN); const unsigned char* Ub = A.ws + WS_U;
    const float* SCN = WS_PTR(const float, WS_SCN); const float* RKB = WS_PTR(const float, WS_RK);
    const int hd = C.wave, c = hd * 64 + C.lane;
    const float lw = A.in[I_LNXW][l * 512 + c], lb = A.in[I_LNXB][l * 512 + c];
    for (int row0 = C.bid * 4; row0 < M; row0 += C.G * 4) {
        float o[4], v[4], gr[4], rk[4];
#pragma unroll
        for (int i = 0; i < 4; ++i) { const size_t row = (size_t)(row0 + i);
            o[i] = ((const float*)(Ub + row * UPITCH_B + UXC_B))[c]; v[i] = SCN[row * 3072 + hd * 384 + 320 + C.lane];
            gr[i] = bf1(U[row * DIN + C_GR + c]); rk[i] = RKB[row * 8 + hd]; }
#pragma unroll
        for (int i = 0; i < 4; ++i) { const size_t row = (size_t)(row0 + i);
            const float mean = wave_sum(o[i]) * (1.f / 64.f); const float dd = o[i] - mean; const float var = wave_sum(dd * dd) * (1.f / 64.f);
            const float y = dd * (1.f / sqrtf(var + LNX_EPS)) * lw + lb + rk[i] * v[i];
            MIX[row * D + 1536 + c] = (bf16)f2bf(y * silu(gr[i])); }
    }
}
__device__ __forceinline__ void phase_norm(const Args& A, const Ctx& C0, int l) {
    Ctx C = C0; asm volatile("" : "+v"(C.tid)); C.lane = C.tid & 63; C.wave = __builtin_amdgcn_readfirstlane(C.tid >> 6);
    const int gw = C.bid * NWAVES + C.wave, NGW = C.G * NWAVES;
    if (l + 1 < DEPTH) { for (int m = gw; m < M; m += NGW) norm_row(A.out + (size_t)m * D, A.in[I_NORMW] + (size_t)(l + 1) * D, WS_PTR(bf16, WS_XN) + (size_t)m * D, nullptr, nullptr, C.lane); }
    else { for (int m = gw; m < M; m += NGW) norm_row(A.out + (size_t)m * D, A.in[I_FNW], nullptr, nullptr, A.out + (size_t)m * D, C.lane); }
}

constexpr int N_PHASES = 1 + 6 * DEPTH;
#ifndef EN_MASK
#define EN_MASK 0x7f
#endif
#define EN(k) ((EN_MASK >> (k)) & 1)
__global__ void __launch_bounds__(NWAVES * 64, 2) hybrid_fwd(Args A) {
    extern __shared__ __attribute__((aligned(16))) unsigned char lds_raw[];
    Ctx C; C.lds = (LAS unsigned char*)lds_raw; C.tid = threadIdx.x; C.lane = C.tid & 63; C.wave = __builtin_amdgcn_readfirstlane(C.tid >> 6); C.G = gridDim.x; C.bid = blockIdx.x;
    for (int u = C.tid; u < (LDS_BYTES - LDSCTL_OFF) / 4; u += NWAVES * 64) ((LAS unsigned*)(C.lds + LDSCTL_OFF))[u] = 0u;
    __syncthreads();
    gu32* ctl = (gu32*)(A.ws + WS_CTL);
    XcdBarrier bar; bar.bar = (unsigned*)(ctl + CW_BAR); bar.x = 0; bar.st = nullptr;
    if (A.coop) bar = xcd_barrier_post((unsigned*)(ctl + CW_BAR), (volatile LAS unsigned*)(C.lds + MISC_OFF) + 8);
    const int lo = A.ph_lo, hi = A.ph_hi;
    for (int ph = lo; ph < hi; ++ph) {
        if (ph == 0) { if (EN(0)) phase_prologue(A, C); }
        else {
            const int l = (ph - 1) / 6, s = (ph - 1) % 6;
            if (s == 0 && EN(1)) { pg8::Gemm g{WS_PTR(const bf16, WS_XN), WS_PTR(const bf16, WS_WINT) + (size_t)l * DINP * D, M, DINP, D}; pg8::StaticOrder S; S.init(M, DINP, C.G, C.bid);
                pg8::EpiU E{WS_PTR(bf16, WS_U)};
                pg8::gemm_phase<pg8::EpiU, pg8::StaticOrder, true, true>(C.lds, g, S, E); }
            else if (s == 1 && EN(2)) phase_prep(A, C, l);
            else if (s == 2 && EN(3)) phase_mixers(A, C, l);
            else if (s == 3 && EN(4)) phase_post(A, C, l);
            else if (s == 4 && EN(5)) { pg8::Gemm g{WS_PTR(const bf16, WS_XN), WS_PTR(const bf16, WS_WOUTT) + (size_t)l * D * D, M, D, D}; pg8::StaticOrder S; S.init(M, D, C.G, C.bid);
                pg8::EpiRes E{A.out};
                pg8::gemm_phase<pg8::EpiRes, pg8::StaticOrder, true, true>(C.lds, g, S, E); }
            else if (s == 5 && EN(6)) phase_norm(A, C, l);
        }
        if (ph + 1 < hi) {
            if (ph == 0) cg::this_grid().sync();
            else xcd_barrier(bar);
        }
    }
}

#ifndef MK_MULTI
#define MK_MULTI 0
#endif
extern "C" void kernel_launch(void* const* d_in, const int* in_sizes, int n_in, void* d_out, int out_size, void* d_ws, size_t ws_size, hipStream_t stream) {
    static int grid = 0;
    if (grid == 0) {
        if (n_in != 25 || (size_t)out_size != O_END || ws_size < WS_END) { fprintf(stderr, "kernel_launch: unexpected sizes: n_in %d out %d ws %zu (need %zu)\n", n_in, out_size, ws_size, (size_t)WS_END); grid = -1; return; }
        int dev = 0, cus = 0, per_cu = 0;
        if (hipGetDevice(&dev) != hipSuccess || hipDeviceGetAttribute(&cus, hipDeviceAttributeMultiprocessorCount, dev) != hipSuccess) { grid = -1; return; }
        if (hipFuncSetAttribute((const void*)hybrid_fwd, hipFuncAttributeMaxDynamicSharedMemorySize, LDS_BYTES) != hipSuccess) { fprintf(stderr, "kernel_launch: hipFuncSetAttribute failed\n"); grid = -1; return; }
        if (hipOccupancyMaxActiveBlocksPerMultiprocessor(&per_cu, (const void*)hybrid_fwd, NWAVES * 64, LDS_BYTES) != hipSuccess || per_cu < 1) { fprintf(stderr, "kernel_launch: occupancy query gives %d\n", per_cu); per_cu = 1; }
        (void)hipGetLastError();
        grid = cus;
    }
    if (grid < 0) return;
    (void)hipMemsetAsync((char*)d_ws + WS_CTL, 0, CTL_ZERO_BYTES, stream);
    Args a{};
    for (int i = 0; i < 25; ++i) a.in[i] = (const float*)d_in[i];
    a.out = (float*)d_out; a.ws = (unsigned char*)d_ws;
#if MK_MULTI
    for (int ph = 0; ph < N_PHASES; ++ph) { a.ph_lo = ph; a.ph_hi = ph + 1; a.coop = 0;
        hipLaunchKernelGGL(hybrid_fwd, dim3(grid), dim3(NWAVES * 64), LDS_BYTES, stream, a); }
#else
    a.ph_lo = 0; a.ph_hi = N_PHASES; a.coop = 1;
    void* args[] = {&a};
    hipError_t e = hipLaunchCooperativeKernel((const void*)hybrid_fwd, dim3(grid), dim3(NWAVES * 64), args, LDS_BYTES, stream);
    if (e != hipSuccess) fprintf(stderr, "kernel_launch: cooperative launch failed: %s (grid %d)\n", hipGetErrorString(e), grid);
#endif
}
```

```cpp
#include <hip/hip_runtime.h>
#include <hip/hip_cooperative_groups.h>
#include <cstdio>
#include <cstdint>
namespace cg = cooperative_groups;
namespace pg8 {
#define PG8_LAS __attribute__((address_space(3)))
typedef unsigned short bf16_t;
typedef short bf16x8 __attribute__((ext_vector_type(8)));
typedef float f32x4 __attribute__((ext_vector_type(4)));
typedef unsigned u32x4 __attribute__((ext_vector_type(4)));
constexpr int BM = 256, BK = 64, HALF = 128, HTB = HALF * BK * 2  , STAGE_BYTES = 8 * HTB, NXCD = 8, WGM = 8;

__host__ __device__ __forceinline__ int lds_byte(int r, int c) { const int st = (r >> 4) * 2 + (c >> 5), rr = r & 15, cc = c & 31, ob = rr * 64 + cc * 2; return st * 1024 + (ob ^ (((ob >> 9) & 1) << 5)); }
__host__ __device__ __forceinline__ void stage_rc(int b, int& R, int& C) { const int st = b / 1024, sb = b % 1024, swz = sb ^ (((sb >> 9) & 1) << 5); R = (st >> 1) * 16 + swz / 64; C = (st & 1) * 32 + (swz % 64) / 2; }
__host__ __device__ __forceinline__ int perm32(int rho) { const int n = rho >> 4, i = rho & 15; return 8 * (i >> 2) + 4 * n + (i & 3); }

struct Unit { int pm, pn; };
struct Gemm { const bf16_t* A; const bf16_t* Bt; int M, N, K; };

struct StaticOrder {
    int nM, nN, nwg, G, c;
    __host__ __device__ void init(int M, int N, int G_, int c_) { nM = M / BM; nN = N / BM; nwg = nM * nN; G = G_; c = c_; }
    __host__ __device__ bool next(int i, Unit& u) const {
        const long L = (long)i * G + c; if (L >= nwg) return false;
        int wgid = (int)L; { const int q = nwg / NXCD, r = nwg % NXCD, xcd = wgid % NXCD, off = wgid / NXCD; wgid = (xcd < r ? xcd * (q + 1) : r * (q + 1) + (xcd - r) * q) + off; }
        const int nig = WGM * nN, gid = wgid / nig, fm = gid * WGM, gsz = (nM - fm) < WGM ? (nM - fm) : WGM;
        u.pm = fm + ((wgid % nig) % gsz); u.pn = (wgid % nig) / gsz; return true;
    }
    __device__ __forceinline__ void a_ready(const Unit&) const {}
    __device__ __forceinline__ void done(const Unit&) const {}
};
__device__ __forceinline__ unsigned cvt_pk_bf16(float lo, float hi) { unsigned r; asm volatile("v_cvt_pk_bf16_f32 %0, %1, %2" : "=v"(r) : "v"(lo), "v"(hi)); return r; }
typedef float f32x2 __attribute__((ext_vector_type(2)));
struct EpiU {
    static constexpr bool PERM = true, AFTER_DRAIN = false;
    bf16_t* O;
    __device__ __forceinline__ void operator()(const f32x4 (&acc)[2][2][4][2], const Unit& u, int wr, int wc, int fr, int fq) const {
        const int row0 = u.pm * BM + wr * 64 + fr; const int col0 = u.pn * BM + wc * 32 + 8 * fq;
#pragma unroll
        for (int ai = 0; ai < 2; ++ai)
#pragma unroll
            for (int m = 0; m < 4; ++m) { bf16_t* rowp = O + (size_t)(row0 + ai * HALF + m * 16) * 5504 + col0;
#pragma unroll
                for (int bj = 0; bj < 2; ++bj) { if (u.pn * BM + bj * HALF < 5504) { const f32x4 v0 = acc[ai][bj][m][0], v1 = acc[ai][bj][m][1];
                    u32x4 w; w.x = cvt_pk_bf16(v0[0], v0[1]); w.y = cvt_pk_bf16(v0[2], v0[3]); w.z = cvt_pk_bf16(v1[0], v1[1]); w.w = cvt_pk_bf16(v1[2], v1[3]);
                    *(u32x4*)(rowp + bj * HALF) = w; } } }
    }
};
struct EpiRes {
    static constexpr bool PERM = false, AFTER_DRAIN = false;
    float* H;
    __device__ __forceinline__ void operator()(const f32x4 (&acc)[2][2][4][2], const Unit& u, int wr, int wc, int fr, int fq) const {
        const int col0 = u.pn * BM + wc * 32 + 4 * fq;
#pragma unroll
        for (int ai = 0; ai < 2; ++ai)
#pragma unroll
            for (int m = 0; m < 4; ++m) { float* rowp = H + (size_t)(u.pm * BM + ai * HALF + wr * 64 + m * 16 + fr) * 2048 + col0;
#pragma unroll
                for (int bj = 0; bj < 2; ++bj)
#pragma unroll
                    for (int n = 0; n < 2; ++n) { f32x4* p = (f32x4*)(rowp + bj * HALF + n * 16); *p = *p + acc[ai][bj][m][n]; } }
    }
};
template <class Epi, class Sched, bool ALIGN_EPI = false, bool SP2 = false>
__device__ __forceinline__ void gemm_phase(PG8_LAS unsigned char* lds, const Gemm g, const Sched& S, const Epi& E) {
    int tid_l = threadIdx.x; asm volatile("" : "+v"(tid_l));
    const int tid = tid_l, wid = __builtin_amdgcn_readfirstlane(tid >> 6), lane = tid & 63, wr = wid >> 2, wc = wid & 3, fr = lane & 15, fq = lane >> 4;
    const int K = g.K, nt = K / BK;
    unsigned voffA[2], voffB[2];
#pragma unroll
    for (int i = 0; i < 2; ++i) { int R, C; stage_rc(tid * 16 + i * 8192, R, C); const int Rb = Epi::PERM ? ((R & ~31) + perm32(R & 31)) : R;
        voffA[i] = (unsigned)(R * K + C) * 2u; voffB[i] = (unsigned)(Rb * K + C) * 2u; }
    const size_t kstep = (size_t)(BK * 2);
    const size_t hstep = (size_t)HALF * K * 2;
    const size_t tstep = 2 * hstep;
    const unsigned ldsw = (unsigned)wid * 1024u;
    const int aoff = lds_byte(wr * 64 + fr, fq * 8), boff = lds_byte(wc * 32 + fr, fq * 8);
#define PG8_SA(b, h) (((b) * 2 + (h)) * HTB)
#define PG8_SB(b, h) ((4 + (b) * 2 + (h)) * HTB)
#define PG8_STAGE(bufoff, gbase, voff) do { _Pragma("unroll") for (int _i = 0; _i < 2; ++_i) \
        __builtin_amdgcn_global_load_lds((const unsigned*)((const char*)(gbase) + (voff)[_i]), (PG8_LAS unsigned*)(lds + (bufoff) + ldsw + _i * 8192), 16, 0, 0); } while (0)
#define PG8_LDA(dst, b, h) do { _Pragma("unroll") for (int m = 0; m < 4; ++m) _Pragma("unroll") for (int k = 0; k < 2; ++k) dst[m][k] = *(const PG8_LAS bf16x8*)(lds + PG8_SA(b, h) + aoff + m * 2048 + k * 1024); } while (0)
#define PG8_LDB(dst, b, h) do { _Pragma("unroll") for (int n = 0; n < 2; ++n) _Pragma("unroll") for (int k = 0; k < 2; ++k) dst[n][k] = *(const PG8_LAS bf16x8*)(lds + PG8_SB(b, h) + boff + n * 2048 + k * 1024); } while (0)
#define PG8_MMA(ai, bj, At, Bt) do { __builtin_amdgcn_s_setprio(1); _Pragma("unroll") for (int m = 0; m < 4; ++m) _Pragma("unroll") for (int n = 0; n < 2; ++n) _Pragma("unroll") for (int k = 0; k < 2; ++k) \
        acc[ai][bj][m][n] = __builtin_amdgcn_mfma_f32_16x16x32_bf16(Bt[n][k], At[m][k], acc[ai][bj][m][n], 0, 0, 0); __builtin_amdgcn_s_setprio(0); } while (0)
#define PG8_WAIT_V(n) asm volatile("s_waitcnt vmcnt(" #n ")" ::: "memory")
#define PG8_WAIT_L(n) asm volatile("s_waitcnt lgkmcnt(" #n ")" ::: "memory")
#define PG8_BAR __builtin_amdgcn_s_barrier()
#define PG8_SCHED __builtin_amdgcn_sched_barrier(0)
    Unit cur, nxt; int ui = 0;
    if (!S.next(0, cur)) return;
    f32x4 acc[2][2][4][2];
#pragma unroll
    for (int a = 0; a < 2; ++a)
#pragma unroll
        for (int b = 0; b < 2; ++b)
#pragma unroll
            for (int m = 0; m < 4; ++m)
#pragma unroll
                for (int n = 0; n < 2; ++n) acc[a][b][m][n] = (f32x4){0.f, 0.f, 0.f, 0.f};
    bf16x8 At[4][2], B0[2][2], B1[2][2];
    const char* cA = (const char*)g.A + (size_t)cur.pm * tstep; const char* cB = (const char*)g.Bt + (size_t)cur.pn * tstep;
    S.a_ready(cur);
    if constexpr (SP2) {
        PG8_STAGE(PG8_SB(0, 0), cB, voffB); PG8_STAGE(PG8_SB(0, 1), cB + hstep, voffB); PG8_STAGE(PG8_SA(0, 0), cA, voffA); PG8_STAGE(PG8_SA(0, 1), cA + hstep, voffA);
        if (wr == 1) PG8_BAR;
        PG8_WAIT_V(2); PG8_BAR;
        PG8_STAGE(PG8_SB(1, 0), cB + kstep, voffB); PG8_STAGE(PG8_SA(1, 0), cA + kstep, voffA); PG8_STAGE(PG8_SB(1, 1), cB + hstep + kstep, voffB);
        PG8_WAIT_V(6); PG8_BAR;
    } else {
        PG8_STAGE(PG8_SB(0, 0), cB, voffB); PG8_STAGE(PG8_SA(0, 0), cA, voffA); PG8_STAGE(PG8_SB(0, 1), cB + hstep, voffB); PG8_STAGE(PG8_SA(0, 1), cA + hstep, voffA);
        if (wr == 1) PG8_BAR;
        PG8_WAIT_V(4); PG8_BAR;
        PG8_STAGE(PG8_SB(1, 0), cB + kstep, voffB); PG8_STAGE(PG8_SA(1, 0), cA + kstep, voffA); PG8_STAGE(PG8_SB(1, 1), cB + hstep + kstep, voffB);
        PG8_WAIT_V(6); PG8_BAR;
    }
    for (;;) {
        const bool has_next = S.next(ui + 1, nxt);
        const char* nA = has_next ? (const char*)g.A + (size_t)nxt.pm * tstep : cA; const char* nB = has_next ? (const char*)g.Bt + (size_t)nxt.pn * tstep : cB;
        for (int t = 0; t < nt; t += 2) {
            const bool last = (t == nt - 2);
            const char* a1 = cA + (size_t)(t + 1) * kstep;
            const char* a2 = last ? nA : cA + (size_t)(t + 2) * kstep; const char* b2 = last ? nB : cB + (size_t)(t + 2) * kstep;
            const char* a3 = a2 + kstep; const char* b3 = b2 + kstep;
            if (last && has_next) S.a_ready(nxt);
            if constexpr (SP2) {
            PG8_LDB(B0, 0, 0); PG8_LDB(B1, 0, 1); PG8_SCHED; PG8_LDA(At, 0, 0); PG8_STAGE(PG8_SA(1, 1), a1 + hstep, voffA);
            PG8_WAIT_V(8); PG8_WAIT_L(0); PG8_BAR; PG8_MMA(0, 0, At, B0); PG8_MMA(0, 1, At, B1); PG8_BAR; PG8_SCHED;
            PG8_LDA(At, 0, 1); PG8_STAGE(PG8_SB(0, 0), b2, voffB); PG8_STAGE(PG8_SB(0, 1), b2 + hstep, voffB); PG8_STAGE(PG8_SA(0, 0), a2, voffA);
            PG8_WAIT_V(8); PG8_WAIT_L(0); PG8_BAR; PG8_MMA(1, 0, At, B0); PG8_MMA(1, 1, At, B1); PG8_BAR; PG8_SCHED;
            PG8_LDB(B0, 1, 0); PG8_LDB(B1, 1, 1); PG8_SCHED; PG8_LDA(At, 1, 0); PG8_STAGE(PG8_SA(0, 1), a2 + hstep, voffA);
            PG8_WAIT_V(8); PG8_WAIT_L(0); PG8_BAR; PG8_MMA(0, 0, At, B0); PG8_MMA(0, 1, At, B1); PG8_BAR; PG8_SCHED;
            PG8_LDA(At, 1, 1); PG8_STAGE(PG8_SB(1, 0), b3, voffB); PG8_STAGE(PG8_SB(1, 1), b3 + hstep, voffB); PG8_STAGE(PG8_SA(1, 0), a3, voffA);
            PG8_WAIT_V(8); PG8_WAIT_L(0); PG8_BAR; PG8_MMA(1, 0, At, B0); PG8_MMA(1, 1, At, B1); PG8_BAR; PG8_SCHED;
            } else {
            PG8_LDB(B0, 0, 0); PG8_SCHED; PG8_LDA(At, 0, 0); PG8_STAGE(PG8_SA(1, 1), a1 + hstep, voffA);
            PG8_WAIT_L(8); PG8_BAR; PG8_WAIT_L(0); PG8_MMA(0, 0, At, B0); PG8_BAR; PG8_SCHED;
            PG8_LDB(B1, 0, 1); PG8_STAGE(PG8_SB(0, 0), b2, voffB);
            PG8_BAR; PG8_WAIT_L(0); PG8_MMA(0, 1, At, B1); PG8_BAR;
            PG8_LDA(At, 0, 1); PG8_STAGE(PG8_SA(0, 0), a2, voffA);
            PG8_BAR; PG8_WAIT_L(0); PG8_MMA(1, 0, At, B0); PG8_BAR; PG8_SCHED;
            PG8_STAGE(PG8_SB(0, 1), b2 + hstep, voffB);
            PG8_WAIT_V(6); PG8_BAR; PG8_MMA(1, 1, At, B1); PG8_BAR;
            PG8_LDB(B0, 1, 0); PG8_SCHED; PG8_LDA(At, 1, 0); PG8_STAGE(PG8_SA(0, 1), a2 + hstep, voffA);
            PG8_WAIT_L(8); PG8_BAR; PG8_WAIT_L(0); PG8_MMA(0, 0, At, B0); PG8_BAR; PG8_SCHED;
            PG8_LDB(B1, 1, 1); PG8_STAGE(PG8_SB(1, 0), b3, voffB);
            PG8_BAR; PG8_WAIT_L(0); PG8_MMA(0, 1, At, B1); PG8_BAR;
            PG8_LDA(At, 1, 1); PG8_STAGE(PG8_SA(1, 0), a3, voffA);
            PG8_BAR; PG8_WAIT_L(0); PG8_MMA(1, 0, At, B0); PG8_BAR; PG8_SCHED;
            PG8_STAGE(PG8_SB(1, 1), b3 + hstep, voffB);
            PG8_WAIT_V(6); PG8_BAR; PG8_MMA(1, 1, At, B1); PG8_BAR;
            }
        }
        if constexpr (ALIGN_EPI) { if (wr == 0) PG8_BAR; }
        if constexpr (!Epi::AFTER_DRAIN) { E(acc, cur, wr, wc, fr, fq); S.done(cur); }
        if (!has_next) break;
#pragma unroll
        for (int a = 0; a < 2; ++a)
#pragma unroll
            for (int b = 0; b < 2; ++b)
#pragma unroll
                for (int m = 0; m < 4; ++m)
#pragma unroll
                    for (int n = 0; n < 2; ++n) acc[a][b][m][n] = (f32x4){0.f, 0.f, 0.f, 0.f};
        cur = nxt; cA = nA; cB = nB; ++ui;
        if constexpr (ALIGN_EPI) { if (wr == 1) PG8_BAR; }
    }
    PG8_WAIT_V(0);
    if constexpr (!ALIGN_EPI) { if (wr == 0) PG8_BAR; }
    PG8_BAR;
    if constexpr (Epi::AFTER_DRAIN) { E.fused(acc, cur, wr, wc, fr, fq, lds, wid, lane); S.done(cur); }
#undef PG8_SA
#undef PG8_SB
#undef PG8_STAGE
#undef PG8_LDA
#undef PG8_LDB
#undef PG8_MMA
#undef PG8_WAIT_V
#undef PG8_WAIT_L
#undef PG8_BAR
#undef PG8_SCHED
}
}

constexpr int NWAVES = 8;
constexpr int D = 2048, BATCH = 4, SEQ = 8192, DEPTH = 4, DECB = 8, DECS = 32;
constexpr int MP = BATCH * SEQ, MS = DECB * DECS, M = MP + MS;
constexpr int DIN = 5504, DINP = 5632;
constexpr int C_P = 0, C_GP = 512, C_Q = 1024, C_K = 2048, C_V = 2176, C_GA = 2304, C_XC = 3328, C_GR = 4992;
constexpr int DSH = 1664;
constexpr float NORM_EPS = 1e-5f, LNX_EPS = 1e-5f * 64.f;
constexpr size_t UPITCH_B = (size_t)DIN * 2;
constexpr size_t UXC_B = (size_t)C_XC * 2;
constexpr size_t O_YP = 0, O_YS = (size_t)MP * D, O_POOLP = O_YS + (size_t)MS * D;
constexpr size_t O_KP = O_POOLP + (size_t)DEPTH * BATCH * 15 * 512, O_VP = O_KP + (size_t)DEPTH * BATCH * 128 * 128;
constexpr size_t O_SHP = O_VP + (size_t)DEPTH * BATCH * 128 * 128, O_WKVP = O_SHP + (size_t)DEPTH * BATCH * DSH;
constexpr size_t O_POOLS = O_WKVP + (size_t)DEPTH * BATCH * 8 * 4096, O_KS = O_POOLS + (size_t)DEPTH * DECB * 15 * 512;
constexpr size_t O_VS = O_KS + (size_t)DEPTH * DECB * 128 * 128, O_SHS = O_VS + (size_t)DEPTH * DECB * 128 * 128;
constexpr size_t O_WKVS = O_SHS + (size_t)DEPTH * DECB * DSH, O_END = O_WKVS + (size_t)DEPTH * DECB * 8 * 4096;
constexpr size_t MiB = 1u << 20;
constexpr size_t WS_CTL = 0, CTL_ZERO_BYTES = 1 * MiB;
constexpr size_t WS_WINT = 1 * MiB;
constexpr size_t WS_WOUTT = WS_WINT + (size_t)DEPTH * DINP * D * 2;
constexpr size_t WS_PWT = WS_WOUTT + (size_t)DEPTH * D * D * 2;
constexpr size_t WS_BIAS = WS_PWT + (size_t)DEPTH * 4 * 128 * 128 * 2;
constexpr size_t WS_RK = WS_BIAS + 256 * 16 * 4;
constexpr size_t WS_XN = WS_RK + (size_t)M * 8 * 4;
constexpr size_t WS_U = WS_XN + (size_t)M * D * 2;
constexpr size_t WS_SCN = WS_U + (size_t)M * DIN * 2;
constexpr size_t WS_END = WS_SCN + (size_t)M * 3072 * 4;
static_assert(WS_END <= (size_t)1024 * MiB, "workspace map exceeds 1 GiB");
static_assert(WS_XN % 256 == 0 && WS_U % 256 == 0 && WS_SCN % 256 == 0 && WS_RK % 256 == 0, "alignment");
constexpr int CW_BAR = 4096;
constexpr int RING_BYTES = 131072, LDSCTL_OFF = RING_BYTES, MISC_OFF = LDSCTL_OFF + 320, LDS_BYTES = 147456;

#define GAS __attribute__((address_space(1)))
#define LAS __attribute__((address_space(3)))
typedef unsigned short bf16;
typedef unsigned v4u __attribute__((ext_vector_type(4)));
typedef unsigned v2u __attribute__((ext_vector_type(2)));
typedef float f32x4 __attribute__((ext_vector_type(4)));
typedef float f32x16 __attribute__((ext_vector_type(16)));
typedef short bf16x8 __attribute__((ext_vector_type(8)));
typedef GAS unsigned gu32;
#define RLX_AGENT __ATOMIC_RELAXED, __HIP_MEMORY_SCOPE_AGENT
#define LDS_WAIT() asm volatile("s_waitcnt lgkmcnt(0)" ::: "memory")
#define VM_WAIT() asm volatile("s_waitcnt vmcnt(0)" ::: "memory")
__device__ __forceinline__ unsigned f2bf(float f) { unsigned u = __builtin_bit_cast(unsigned, f); return (u + 0x7fffu + ((u >> 16) & 1u)) >> 16; }
__device__ __forceinline__ unsigned pk2(float lo, float hi) { return f2bf(lo) | (f2bf(hi) << 16); }
__device__ __forceinline__ float bflo(unsigned w) { return __uint_as_float(w << 16); }
__device__ __forceinline__ float bfhi(unsigned w) { return __uint_as_float(w & 0xffff0000u); }
__device__ __forceinline__ float bf1(bf16 h) { return __uint_as_float(((unsigned)h) << 16); }
__device__ __forceinline__ float silu(float x) { return x / (1.f + __expf(-x)); }
__device__ __forceinline__ float wave_sum(float v) {
#pragma unroll
    for (int o = 1; o < 64; o <<= 1) v += __shfl_xor(v, o);
    return v;
}
template <int CTRL> __device__ __forceinline__ float dpp_add(float x) {
    const int y = __builtin_amdgcn_update_dpp(0, __float_as_int(x), CTRL, 0xf, 0xf, true);
    return x + __int_as_float(y);
}
__device__ __forceinline__ float row16_sum(float x) {
    x = dpp_add<0xB1>(x);
    x = dpp_add<0x4E>(x);
    x = dpp_add<0x141>(x);
    x = dpp_add<0x140>(x);
    return x;
}
#define XB_TMO      128
#define XB_XCNT(j)  (256  + 64 * (j))
#define XB_XSUB(j)  (1280 + 64 * (j))
#define XB_XGEN(j)  (2304 + 64 * (j))
#define XB_TOP      3328
#define XB_TOPGEN   3392
#define XCD_BAR_WORDS 3456
#define XB_SPIN_CAP (1u << 18)

__device__ __forceinline__ unsigned xb_ld(unsigned* p)              { return __hip_atomic_load(p, __ATOMIC_RELAXED, __HIP_MEMORY_SCOPE_AGENT); }
__device__ __forceinline__ unsigned xb_add(unsigned* p, unsigned v) { return __hip_atomic_fetch_add(p, v, __ATOMIC_RELAXED, __HIP_MEMORY_SCOPE_AGENT); }
__device__ __forceinline__ unsigned xb_xcc_id() { return (unsigned)__builtin_amdgcn_s_getreg((3 << 11) | 20) & 0xFu; }
#define XB_SPIN(cond, bar) do { unsigned _sp = 0; while (cond) { __builtin_amdgcn_s_sleep(1); \
    if ((++_sp & 255u) == 0u) { if (xb_ld(&(bar)[XB_TMO])) break; if (_sp > XB_SPIN_CAP) { atomicAdd(&(bar)[XB_TMO], 1u); break; } } } } while (0)

struct XcdBarrier {
    unsigned* bar; unsigned x;
    volatile LAS unsigned* st;
};

__device__ __forceinline__ XcdBarrier xcd_barrier_post(unsigned* bar, volatile LAS unsigned* st) {
    XcdBarrier b; b.bar = bar; b.x = xb_xcc_id(); b.st = st;
    if (threadIdx.x == 0) (void)xb_add(&bar[XB_XCNT(b.x)], 1u);
    return b;
}
__device__ __forceinline__ void xcd_barrier_complete(unsigned* bar, unsigned x, unsigned& nloc, unsigned& nx) {
    const unsigned G = gridDim.x * gridDim.y * gridDim.z;
    unsigned sum, cnt, mine, sp = 0u;
    for (;;) {
        sum = 0u; cnt = 0u; mine = 0u;
#pragma unroll
        for (unsigned j = 0; j < 16; ++j) { const unsigned c = xb_ld(&bar[XB_XCNT(j)]); sum += c; cnt += (c > 0u) ? 1u : 0u; mine = (j == x) ? c : mine; }
        if (sum == G) break;
        __builtin_amdgcn_s_sleep(1);
        if ((++sp & 255u) == 0u) { if (xb_ld(&bar[XB_TMO])) break; if (sp > XB_SPIN_CAP) { atomicAdd(&bar[XB_TMO], 1u); break; } }
    }
    nloc = mine > 0u ? mine : 1u; nx = cnt > 0u ? cnt : 1u;
}

__device__ __forceinline__ void xcd_barrier(const XcdBarrier& b) {
    asm volatile("s_waitcnt vmcnt(0)" ::: "memory");
    __syncthreads();
    if (threadIdx.x == 0) {
        unsigned* bar = b.bar;
        __builtin_amdgcn_s_waitcnt(0);
        unsigned nloc = b.st[0], nx = b.st[1];
        if (nloc == 0u) { xcd_barrier_complete(bar, b.x, nloc, nx); b.st[0] = nloc; b.st[1] = nx; }
        const unsigned old = xb_add(&bar[XB_XSUB(b.x)], 1u);
        const unsigned gen = old / nloc;
        if (old + 1u == (gen + 1u) * nloc) {
            __builtin_amdgcn_fence(__ATOMIC_RELEASE, "agent");
            asm volatile("s_waitcnt vmcnt(0)" ::: "memory");
            const unsigned og = xb_add(&bar[XB_TOP], 1u);
            const unsigned tg = og / nx;
            if (og + 1u == (tg + 1u) * nx) xb_add(&bar[XB_TOPGEN], 1u);
            else XB_SPIN(xb_ld(&bar[XB_TOPGEN]) == tg, bar);
            __builtin_amdgcn_fence(__ATOMIC_ACQUIRE, "agent");
            xb_add(&bar[XB_XGEN(b.x)], 1u);
            asm volatile("s_waitcnt vmcnt(0)" ::: "memory");
        } else {
            XB_SPIN(xb_ld(&bar[XB_XGEN(b.x)]) == gen, bar);
            __builtin_amdgcn_fence(__ATOMIC_ACQUIRE, "agent");
            asm volatile("s_waitcnt vmcnt(0)" ::: "memory");
        }
    }
    __syncthreads();
}

struct Args { const float* in[25]; float* out; unsigned char* ws; int ph_lo, ph_hi, coop, pad; };
struct Ctx { LAS unsigned char* lds; int tid, lane, wave, G, bid; };
enum { I_XP = 0, I_XS, I_SPOOL, I_CK, I_CV, I_SSHIFT, I_SWKV, I_NORMW, I_WIN, I_WOUT, I_POOLW, I_POOLS, I_SINKS, I_RELB, I_MU, I_W0, I_WUP, I_A0, I_AUP, I_KK, I_KA, I_RK, I_LNXW, I_LNXB, I_FNW };

#define WS_PTR(T, off) ((T*)(A.ws + (off)))

__device__ __forceinline__ void transpose_item(const float* W, int K, int N, bf16* WT, LAS float* scr, int item, int lane) {
    const int nblk = N / 32, kb = item / nblk, nb = item % nblk, k0 = 64 * kb, n0 = 32 * nb;
#pragma unroll 8
    for (int i = 0; i < 32; ++i) { const int kk = 2 * i + (lane >> 5); scr[kk * 33 + (lane & 31)] = W[(size_t)(k0 + kk) * N + n0 + (lane & 31)]; }
    LDS_WAIT(); asm volatile("" ::: "memory");
    const int c = lane & 7;
#pragma unroll
    for (int j = 0; j < 4; ++j) { const int n = (lane >> 3) + 8 * j; const LAS float* s = scr + (8 * c) * 33 + n;
        v4u o; o.x = pk2(s[0 * 33], s[1 * 33]); o.y = pk2(s[2 * 33], s[3 * 33]); o.z = pk2(s[4 * 33], s[5 * 33]); o.w = pk2(s[6 * 33], s[7 * 33]);
        *(v4u*)(WT + (size_t)(n0 + n) * K + k0 + 8 * c) = o; }
    LDS_WAIT(); asm volatile("" ::: "memory");
}
__device__ __forceinline__ void norm_row(const float* src, const float* w, bf16* xn, float* hcopy, float* y, int lane) {
    const f32x4* xr = (const f32x4*)src + lane;
    f32x4 v[8]; float s = 0.f;
#pragma unroll
    for (int j = 0; j < 8; ++j) { v[j] = xr[64 * j]; s += (v[j].x * v[j].x + v[j].y * v[j].y) + (v[j].z * v[j].z + v[j].w * v[j].w); }
    const float rstd = 1.f / sqrtf(wave_sum(s) * (1.f / D) + NORM_EPS);
    if (hcopy) {
#pragma unroll
        for (int j = 0; j < 8; ++j) ((f32x4*)hcopy + lane)[64 * j] = v[j];
    }
    const f32x4* wr = (const f32x4*)w + lane;
#pragma unroll
    for (int j = 0; j < 8; ++j) { const f32x4 ww = wr[64 * j]; const f32x4 o = v[j] * rstd * ww;
        if (xn) { v2u p; p.x = pk2(o.x, o.y); p.y = pk2(o.z, o.w); ((v2u*)xn + lane)[64 * j] = p; }
        if (y) ((f32x4*)y + lane)[64 * j] = o; }
}
__device__ __forceinline__ int t5_bucket(int rel) {
    const int n = rel < 0 ? -rel : rel; int v;
    if (n < 8) v = n; else v = 8 + (n >= 12) + (n >= 16) + (n >= 23) + (n >= 32) + (n >= 46) + (n >= 64) + (n >= 91);
    return (rel > 0 ? 16 : 0) + v;
}

__device__ __forceinline__ void phase_prologue(const Args& A, const Ctx& C0) {
    Ctx C = C0; asm volatile("" : "+v"(C.tid)); C.lane = C.tid & 63; C.wave = __builtin_amdgcn_readfirstlane(C.tid >> 6);
    LAS float* scr = (LAS float*)(C.lds + C.wave * 16384);
    const int gw = C.bid * NWAVES + C.wave, NGW = C.G * NWAVES;
    constexpr int I_IN = (D / 64) * (DIN / 32), I_OUT = (D / 64) * (D / 32), I_PW = 4 * 8, PER_L = I_IN + I_OUT + I_PW;
    for (int it = gw; it < DEPTH * PER_L; it += NGW) {
        const int l = it / PER_L; int r = it % PER_L;
        if (r < I_IN) { transpose_item(A.in[I_WIN] + (size_t)l * D * DIN, D, DIN, WS_PTR(bf16, WS_WINT) + (size_t)l * DINP * D, scr, r, C.lane); continue; } r -= I_IN;
        if (r < I_OUT) { transpose_item(A.in[I_WOUT] + (size_t)l * D * D, D, D, WS_PTR(bf16, WS_WOUTT) + (size_t)l * D * D, scr, r, C.lane); continue; } r -= I_OUT;
        { const int g = r >> 3; transpose_item(A.in[I_POOLW] + (size_t)(l * 4 + g) * 128 * 128, 128, 128, WS_PTR(bf16, WS_PWT) + (size_t)(l * 4 + g) * 128 * 128, scr, r & 7, C.lane); }
    }
    { const int gt = C.bid * 512 + C.tid, NGT = C.G * 512; constexpr int PER = (DINP - DIN) * D * 2 / 16;
      for (int i = gt; i < DEPTH * PER; i += NGT) { const int l = i / PER, r = i % PER; ((v4u*)(WS_PTR(bf16, WS_WINT) + (size_t)l * DINP * D + (size_t)DIN * D))[r] = (v4u){0u, 0u, 0u, 0u}; } }
    if (C.bid == 0) { float* B = WS_PTR(float, WS_BIAS);
        for (int i = C.tid; i < 256 * 16; i += 512) { const int ri = i >> 4, h = i & 15; const int rel = ri - 191; B[i] = (ri < 255) ? A.in[I_RELB][t5_bucket(rel) * 16 + h] : 0.f; } }
    for (int m = gw; m < M; m += NGW) { const float* src = m < MP ? A.in[I_XP] + (size_t)m * D : A.in[I_XS] + (size_t)(m - MP) * D;
        norm_row(src, A.in[I_NORMW], WS_PTR(bf16, WS_XN) + (size_t)m * D, A.out + (size_t)m * D, nullptr, C.lane); }
}

__device__ __forceinline__ void phase_prep(const Args& A, const Ctx& C0, int l) {
    Ctx C = C0; asm volatile("" : "+v"(C.tid)); C.lane = C.tid & 63; C.wave = __builtin_amdgcn_readfirstlane(C.tid >> 6);
    LAS float* raw = (LAS float*)C.lds;
    LAS float* lo = (LAS float*)(C.lds + 9 * DSH * 4);
    const bf16* U = WS_PTR(const bf16, WS_U);
    float* SCN = WS_PTR(float, WS_SCN); float* RKB = WS_PTR(float, WS_RK);
    const int c = C.tid, head = C.wave;
    float wup[64], aup[64];
    { const float* WU = A.in[I_WUP] + (size_t)l * 64 * 512 + c; const float* AU = A.in[I_AUP] + (size_t)l * 64 * 512 + c;
#pragma unroll
      for (int j = 0; j < 64; ++j) { wup[j] = WU[j * 512]; aup[j] = AU[j * 512]; } }
    const float w0 = A.in[I_W0][l * 512 + c], a0 = A.in[I_A0][l * 512 + c], kkc = A.in[I_KK][l * 512 + c], kac = A.in[I_KA][l * 512 + c], rkc = A.in[I_RK][l * 512 + c];
    const float* mul = A.in[I_MU] + (size_t)l * DSH;
    const float mu_r = mul[c], mu_k = mul[512 + c], mu_v = mul[1024 + c];
    for (int tile = C.bid; tile < M / 8; tile += C.G) {
        const int row0 = tile * 8;
        bool seq_start; const float* shiftp = nullptr;
        if (row0 < MP) seq_start = (row0 % SEQ) == 0; else { const int rs = row0 - MP; seq_start = (rs % DECS) == 0; shiftp = A.in[I_SSHIFT] + (size_t)(l * DECB + rs / DECS) * DSH; }
        for (int idx = C.tid; idx < 9 * 208; idx += 512) { const int rr = idx / 208, v = idx % 208;
            f32x4 f0, f1;
            if (rr == 0 && seq_start) { if (shiftp) { f0 = *(const f32x4*)(shiftp + v * 8); f1 = *(const f32x4*)(shiftp + v * 8 + 4); } else { f0 = (f32x4){0.f, 0.f, 0.f, 0.f}; f1 = f0; } }
            else { const v4u x = *(const v4u*)(U + (size_t)(row0 - 1 + rr) * DIN + C_XC + v * 8);
                f0 = (f32x4){bflo(x.x), bfhi(x.x), bflo(x.y), bfhi(x.y)}; f1 = (f32x4){bflo(x.z), bfhi(x.z), bflo(x.w), bfhi(x.w)}; }
            *(LAS f32x4*)(raw + rr * DSH + v * 8) = f0; *(LAS f32x4*)(raw + rr * DSH + v * 8 + 4) = f1; }
        __syncthreads();
#pragma unroll
        for (int k = 0; k < 2; ++k) { const int idx = C.tid + 512 * k, tt = idx >> 7, j = idx & 127, i = 1536 + j;
            const float cur = raw[(tt + 1) * DSH + i], prev = raw[tt * DSH + i]; const float xs = cur + (prev - cur) * mul[i];
            float o = xs; if (j < 64) { const float e = __expf(2.f * xs); o = 1.f - 2.f / (e + 1.f); }
            lo[tt * 128 + j] = o; }
        __syncthreads();
#pragma unroll 1
        for (int tt = 0; tt < 8; ++tt) {
            float aw = 0.f, aa = 0.f;
            const LAS float* lt = lo + tt * 128;
#pragma unroll
            for (int j4 = 0; j4 < 16; ++j4) { const f32x4 x = *(const LAS f32x4*)(lt + 4 * j4), y = *(const LAS f32x4*)(lt + 64 + 4 * j4);
                aw += x.x * wup[4 * j4] + x.y * wup[4 * j4 + 1] + x.z * wup[4 * j4 + 2] + x.w * wup[4 * j4 + 3];
                aa += y.x * aup[4 * j4] + y.y * aup[4 * j4 + 1] + y.z * aup[4 * j4 + 2] + y.w * aup[4 * j4 + 3]; }
            const int row = row0 + tt;
            const LAS float* cu = raw + (tt + 1) * DSH; const LAS float* pv = raw + tt * DSH;
            const float r = cu[c] + (pv[c] - cu[c]) * mu_r, k = cu[512 + c] + (pv[512 + c] - cu[512 + c]) * mu_k, v = cu[1024 + c] + (pv[1024 + c] - cu[1024 + c]) * mu_v;
            const float lw = w0 + aw; const float z = -lw;
            const float sp = fmaxf(z, 0.f) + logf(1.f + expf(-fabsf(z)));
            const float wraw = -sp - 0.5f; const float decay = expf(-expf(wraw));
            const float ai = 1.f / (1.f + expf(-(a0 + aa)));
            const float kkr = k * kkc; const float ss = wave_sum(kkr * kkr);
            const float kk = kkr / fmaxf(sqrtf(ss), 1e-12f);
            const float k2 = k * (1.f + (ai - 1.f) * kac); const float b = kk * ai;
            const float rk = wave_sum(r * k2 * rkc);
            float* s = SCN + (size_t)row * 3072 + head * 384 + C.lane;
            s[0] = kk; s[64] = b; s[128] = decay; s[192] = k2; s[256] = r; s[320] = v;
            if (C.lane == 0) RKB[row * 8 + head] = rk;
        }
        { const int lastrow = row0 + 7; bool is_last; float* dst;
          if (lastrow < MP) { is_last = (lastrow % SEQ) == SEQ - 1; dst = A.out + O_SHP + (size_t)(l * BATCH + lastrow / SEQ) * DSH; }
          else { const int rs = lastrow - MP; is_last = (rs % DECS) == DECS - 1; dst = A.out + O_SHS + (size_t)(l * DECB + rs / DECS) * DSH; }
          if (is_last) for (int i = C.tid; i < DSH; i += 512) dst[i] = raw[8 * DSH + i]; }
        __syncthreads();
    }
    { const int gt = C.bid * 512 + C.tid, NGT = C.G * 512;
      constexpr int NP = BATCH * 128 * 2 * 32, NS = DECB * 128 * 2 * 32;
      for (int i = gt; i < NP + NS; i += NGT) {
          if (i < NP) { const int q4 = i & 31, kv = (i >> 5) & 1, j = (i >> 6) & 127, b = i >> 13;
              const v2u x = *(const v2u*)(U + (size_t)(b * SEQ + SEQ - 128 + j) * DIN + (kv ? C_V : C_K) + q4 * 4);
              float* dst = A.out + (kv ? O_VP : O_KP) + ((size_t)(l * BATCH + b) * 128 + j) * 128 + q4 * 4;
              *(f32x4*)dst = (f32x4){bflo(x.x), bfhi(x.x), bflo(x.y), bfhi(x.y)}; }
          else { const int ii = i - NP; const int q4 = ii & 31, kv = (ii >> 5) & 1, j = (ii >> 6) & 127, b = ii >> 13;
              float* dst = A.out + (kv ? O_VS : O_KS) + ((size_t)(l * DECB + b) * 128 + j) * 128 + q4 * 4;
              if (j < 96) *(f32x4*)dst = *(const f32x4*)(A.in[kv ? I_CV : I_CK] + ((size_t)(l * DECB + b) * 128 + j + 32) * 128 + q4 * 4);
              else { const v2u x = *(const v2u*)(U + (size_t)(MP + b * DECS + j - 96) * DIN + (kv ? C_V : C_K) + q4 * 4);
                  *(f32x4*)dst = (f32x4){bflo(x.x), bfhi(x.x), bflo(x.y), bfhi(x.y)}; } }
      } }
}

__device__ __forceinline__ void scan_unit(const Ctx& C0, const float* scn, int T, int half, const float* S0, float* Sout, unsigned char* obase) {
    Ctx C = C0; asm volatile("" : "+v"(C.tid)); C.lane = C.tid & 63; C.wave = __builtin_amdgcn_readfirstlane(C.tid >> 6);
    LAS float* buf = (LAS float*)C.lds;
    LAS float* obuf = (LAS float*)(C.lds + 2 * 49152);
    const int q = C.lane & 15, rr = C.lane >> 4, rl = C.wave * 4 + rr, irow = half * 32 + rl;
    f32x4 S = (f32x4){0.f, 0.f, 0.f, 0.f};
    if (S0) S = *(const f32x4*)(S0 + irow * 64 + 4 * q);
    const int nch = T / 32;
    f32x4 pre[6];
#pragma unroll
    for (int m = 0; m < 6; ++m) { const int idx = C.tid + 512 * m; pre[m] = *(const f32x4*)(scn + (size_t)(idx / 96) * 3072 + (idx % 96) * 4); }
#pragma unroll
    for (int m = 0; m < 6; ++m) *(LAS f32x4*)(buf + (C.tid + 512 * m) * 4) = pre[m];
    __syncthreads();
    for (int k = 0; k < nch; ++k) {
        const bool more = (k + 1 < nch);
        if (more) {
#pragma unroll
            for (int m = 0; m < 6; ++m) { const int idx = C.tid + 512 * m; pre[m] = *(const f32x4*)(scn + (size_t)((k + 1) * 32 + idx / 96) * 3072 + (idx % 96) * 4); }
        }
        const LAS float* bb = buf + (k & 1) * 12288; LAS float* ob = obuf + (k & 1) * 1024;
#pragma unroll 4
        for (int s = 0; s < 32; ++s) {
            const LAS float* p = bb + s * 384 + 4 * q;
            const f32x4 kk = *(const LAS f32x4*)(p), b = *(const LAS f32x4*)(p + 64), w = *(const LAS f32x4*)(p + 128), k2 = *(const LAS f32x4*)(p + 192), r = *(const LAS f32x4*)(p + 256);
            const float v = bb[s * 384 + 320 + irow];
            float d = S.x * kk.x + S.y * kk.y + S.z * kk.z + S.w * kk.w;
            const float sa = -row16_sum(d);
            S = S * w + (sa * b + v * k2);
            float o = S.x * r.x + S.y * r.y + S.z * r.z + S.w * r.w;
            o = row16_sum(o);
            if (q == 0) ob[s * 32 + rl] = o;
        }
        if (more) {
#pragma unroll
            for (int m = 0; m < 6; ++m) *(LAS f32x4*)(buf + ((k + 1) & 1) * 12288 + (C.tid + 512 * m) * 4) = pre[m];
        }
        __syncthreads();
        if (C.tid < 256) { const int s = C.tid >> 3, c4 = C.tid & 7;
            *(f32x4*)(obase + (size_t)(k * 32 + s) * UPITCH_B + c4 * 16) = *(const LAS f32x4*)(ob + s * 32 + c4 * 4); }
    }
    *(f32x4*)(Sout + irow * 64 + 4 * q) = S;
    __syncthreads();
}

struct AttnU { int qrow0, nq, krow0, krow1, krow2, g; const float* ck; const float* cv; unsigned vmask; };
__device__ __forceinline__ void attn_unit(const Args& A, const Ctx& C0, int l, int u_qrow0, int u_nq, int u_krow0, int u_krow1, int u_krow2, int u_g, const float* u_ck, const float* u_cv, unsigned u_vmask) {
    Ctx C = C0; asm volatile("" : "+v"(C.tid)); C.lane = C.tid & 63; C.wave = __builtin_amdgcn_readfirstlane(C.tid >> 6);
    AttnU u; u.qrow0 = u_qrow0; u.nq = u_nq; u.krow0 = u_krow0; u.krow1 = u_krow1; u.krow2 = u_krow2; u.g = u_g; u.ck = u_ck; u.cv = u_cv; u.vmask = u_vmask;
    constexpr int KP = 72, VP = 196;
    LAS bf16* Ks = (LAS bf16*)C.lds;
    LAS bf16* Vt = (LAS bf16*)(C.lds + 192 * KP * 2);
    LAS float* biasL = (LAS float*)(C.lds + 192 * KP * 2 + 64 * VP * 2);
    const bf16* U = WS_PTR(const bf16, WS_U); bf16* MIX = WS_PTR(bf16, WS_XN);
    const int hq = u.g * 8 + C.wave;
    for (int idx = C.lane; idx < 255; idx += 64) biasL[C.wave * 256 + idx] = WS_PTR(const float, WS_BIAS)[idx * 16 + hq];
    for (int idx = C.tid; idx < 192 * 8; idx += 512) { const int j = idx >> 3, part = idx & 7;
        v4u kx = (v4u){0u, 0u, 0u, 0u}, vx = kx;
        if ((u.vmask >> (j >> 5)) & 1u) {
            if (u.ck && j < 128) { const float* pk = u.ck + (size_t)j * 128 + part * 8; const float* pv = u.cv + (size_t)j * 128 + part * 8;
                const f32x4 a0 = *(const f32x4*)pk, a1 = *(const f32x4*)(pk + 4), b0 = *(const f32x4*)pv, b1 = *(const f32x4*)(pv + 4);
                kx = (v4u){pk2(a0.x, a0.y), pk2(a0.z, a0.w), pk2(a1.x, a1.y), pk2(a1.z, a1.w)}; vx = (v4u){pk2(b0.x, b0.y), pk2(b0.z, b0.w), pk2(b1.x, b1.y), pk2(b1.z, b1.w)}; }
            else { const int ch = j >> 6; const int kr = (ch == 0 ? u.krow0 : (ch == 1 ? u.krow1 : u.krow2)) + (j & 63);
                kx = *(const v4u*)(U + (size_t)kr * DIN + C_K + u.g * 64 + part * 8); vx = *(const v4u*)(U + (size_t)kr * DIN + C_V + u.g * 64 + part * 8); }
        }
        *(LAS v4u*)(Ks + j * KP + part * 8) = kx;
        LAS bf16* vd = Vt + (part * 8) * VP + j;
        vd[0 * VP] = (bf16)(vx.x & 0xffffu); vd[1 * VP] = (bf16)(vx.x >> 16); vd[2 * VP] = (bf16)(vx.y & 0xffffu); vd[3 * VP] = (bf16)(vx.y >> 16);
        vd[4 * VP] = (bf16)(vx.z & 0xffffu); vd[5 * VP] = (bf16)(vx.z >> 16); vd[6 * VP] = (bf16)(vx.w & 0xffffu); vd[7 * VP] = (bf16)(vx.w >> 16);
    }
    __syncthreads();
    const int li = C.lane & 31, h = C.lane >> 5;
    const float sink = A.in[I_SINKS][l * 16 + hq];
    const LAS float* bL = biasL + C.wave * 256;
    for (int qt = 0; qt < u.nq / 32; ++qt) {
        const int qi = qt * 32 + li;
        bf16x8 qf[4];
#pragma unroll
        for (int ks = 0; ks < 4; ++ks) qf[ks] = *(const bf16x8*)(U + (size_t)(u.qrow0 + qi) * DIN + C_Q + hq * 64 + ks * 16 + 8 * h);
        f32x16 sacc[6];
#pragma unroll
        for (int kt = 0; kt < 6; ++kt) {
#pragma unroll
            for (int r = 0; r < 16; ++r) sacc[kt][r] = 0.f;
#pragma unroll
            for (int ks = 0; ks < 4; ++ks) { const bf16x8 kf = *(const LAS bf16x8*)(Ks + (kt * 32 + li) * KP + ks * 16 + 8 * h);
                sacc[kt] = __builtin_amdgcn_mfma_f32_32x32x16_bf16(kf, qf[ks], sacc[kt], 0, 0, 0); }
            asm volatile("" ::: "memory");
        }
        float mx = sink;
#pragma unroll
        for (int kt = 0; kt < 6; ++kt) { const bool valid = (u.vmask >> kt) & 1u;
#pragma unroll
            for (int r = 0; r < 16; ++r) { const int j = kt * 32 + (r & 3) + 8 * (r >> 2) + 4 * h;
                const float lg = valid ? sacc[kt][r] * 0.125f + bL[j - qi + 63] : -1e30f; sacc[kt][r] = lg; mx = fmaxf(mx, lg); }
            asm volatile("" ::: "memory"); }
        mx = fmaxf(mx, __shfl_xor(mx, 32));
        float sum = 0.f;
#pragma unroll
        for (int kt = 0; kt < 6; ++kt)
#pragma unroll
            for (int r = 0; r < 16; ++r) { const float e = __expf(sacc[kt][r] - mx); sacc[kt][r] = e; sum += e; }
        sum += __shfl_xor(sum, 32); sum += __expf(sink - mx);
        const float inv = 1.f / sum;
        f32x16 oacc[2];
#pragma unroll
        for (int dt = 0; dt < 2; ++dt)
#pragma unroll
            for (int r = 0; r < 16; ++r) oacc[dt][r] = 0.f;
#pragma unroll
        for (int kt = 0; kt < 6; ++kt) {
            if ((u.vmask >> kt) & 1u) {
#pragma unroll
                for (int s = 0; s < 2; ++s) {
                    union { bf16x8 v; unsigned w[4]; } pf;
#pragma unroll
                    for (int e = 0; e < 4; ++e) pf.w[e] = pk2(sacc[kt][8 * s + 2 * e] * inv, sacc[kt][8 * s + 2 * e + 1] * inv);
#pragma unroll
                    for (int dt = 0; dt < 2; ++dt) { const LAS bf16* vp = Vt + (dt * 32 + li) * VP + kt * 32 + 16 * s + 4 * h;
                        union { bf16x8 v; v2u w[2]; } vf; vf.w[0] = *(const LAS v2u*)vp; vf.w[1] = *(const LAS v2u*)(vp + 8);
                        oacc[dt] = __builtin_amdgcn_mfma_f32_32x32x16_bf16(vf.v, pf.v, oacc[dt], 0, 0, 0); }
                }
            }
            asm volatile("" ::: "memory");
        }
        const size_t row = (size_t)(u.qrow0 + qi);
#pragma unroll
        for (int dt = 0; dt < 2; ++dt)
#pragma unroll
            for (int rq = 0; rq < 4; ++rq) { const int d = dt * 32 + 8 * rq + 4 * h;
                const v2u gx = *(const v2u*)(U + row * DIN + C_GA + hq * 64 + d);
                const float o0 = oacc[dt][4 * rq] * silu(bflo(gx.x)), o1 = oacc[dt][4 * rq + 1] * silu(bfhi(gx.x)), o2 = oacc[dt][4 * rq + 2] * silu(bflo(gx.y)), o3 = oacc[dt][4 * rq + 3] * silu(bfhi(gx.y));
                v2u o; o.x = pk2(o0, o1); o.y = pk2(o2, o3);
                *(v2u*)(MIX + row * D + 512 + hq * 64 + d) = o; }
    }
    __syncthreads();
}

__device__ __forceinline__ void pool_item(const Args& A, const Ctx& C0, int l, int row0, int t0, int pos0, const float* hist, float* outpool) {
    Ctx C = C0; asm volatile("" : "+v"(C.tid)); C.lane = C.tid & 63; C.wave = __builtin_amdgcn_readfirstlane(C.tid >> 6);
    constexpr int PP = 520;
    LAS bf16* P = (LAS bf16*)C.lds;
    const bf16* U = WS_PTR(const bf16, WS_U); bf16* MIX = WS_PTR(bf16, WS_XN);
    for (int idx = C.tid; idx < 47 * 64; idx += 512) { const int rr = idx >> 6, v = idx & 63;
        v4u x = (v4u){0u, 0u, 0u, 0u};
        if (rr < 15 && t0 == 0) { if (hist) { const f32x4 a0 = *(const f32x4*)(hist + rr * 512 + v * 8), a1 = *(const f32x4*)(hist + rr * 512 + v * 8 + 4);
                x = (v4u){pk2(a0.x, a0.y), pk2(a0.z, a0.w), pk2(a1.x, a1.y), pk2(a1.z, a1.w)}; } }
        else x = *(const v4u*)(U + (size_t)(row0 - 15 + rr) * DIN + C_P + v * 8);
        *(LAS v4u*)(P + rr * PP + v * 8) = x; }
    __syncthreads();
    const int g = C.wave & 3, ddh = C.wave >> 2, wd = 2 << g, tk = C.lane & 31, h = C.lane >> 5;
    const int pos = pos0 + tk; const float inv = 1.f / (float)((pos + 1) < wd ? (pos + 1) : wd);
    const bf16* PW = WS_PTR(const bf16, WS_PWT) + (size_t)(l * 4 + g) * 128 * 128;
    f32x16 acc[2];
#pragma unroll
    for (int dt = 0; dt < 2; ++dt)
#pragma unroll
        for (int r = 0; r < 16; ++r) acc[dt][r] = 0.f;
#pragma unroll
    for (int ks = 0; ks < 8; ++ks) { const int cb = g * 128 + ks * 16 + 8 * h;
        float s[8];
#pragma unroll
        for (int e = 0; e < 8; ++e) s[e] = 0.f;
        for (int i = 0; i < wd; ++i) { const v4u x = *(const LAS v4u*)(P + (15 + tk - i) * PP + cb);
            s[0] += bflo(x.x); s[1] += bfhi(x.x); s[2] += bflo(x.y); s[3] += bfhi(x.y); s[4] += bflo(x.z); s[5] += bfhi(x.z); s[6] += bflo(x.w); s[7] += bfhi(x.w); }
        const v4u cx = *(const LAS v4u*)(P + (15 + tk) * PP + cb);
        union { bf16x8 v; unsigned w[4]; } df;
        df.w[0] = pk2(s[0] * inv - bflo(cx.x), s[1] * inv - bfhi(cx.x)); df.w[1] = pk2(s[2] * inv - bflo(cx.y), s[3] * inv - bfhi(cx.y));
        df.w[2] = pk2(s[4] * inv - bflo(cx.z), s[5] * inv - bfhi(cx.z)); df.w[3] = pk2(s[6] * inv - bflo(cx.w), s[7] * inv - bfhi(cx.w));
#pragma unroll
        for (int dt = 0; dt < 2; ++dt) { const bf16x8 af = *(const bf16x8*)(PW + (size_t)(ddh * 64 + dt * 32 + tk) * 128 + ks * 16 + 8 * h);
            acc[dt] = __builtin_amdgcn_mfma_f32_32x32x16_bf16(af, df.v, acc[dt], 0, 0, 0); }
    }
    const size_t row = (size_t)(row0 + tk);
    const float* psc = A.in[I_POOLS] + l * 512;
#pragma unroll
    for (int dt = 0; dt < 2; ++dt)
#pragma unroll
        for (int rq = 0; rq < 4; ++rq) { const int cc = g * 128 + ddh * 64 + dt * 32 + 8 * rq + 4 * h;
            const v2u gx = *(const v2u*)(U + row * DIN + C_GP + cc); const f32x4 sc = *(const f32x4*)(psc + cc);
            const float o0 = acc[dt][4 * rq] * sc.x * silu(bflo(gx.x)), o1 = acc[dt][4 * rq + 1] * sc.y * silu(bfhi(gx.x)), o2 = acc[dt][4 * rq + 2] * sc.z * silu(bflo(gx.y)), o3 = acc[dt][4 * rq + 3] * sc.w * silu(bfhi(gx.y));
            v2u o; o.x = pk2(o0, o1); o.y = pk2(o2, o3);
            *(v2u*)(MIX + row * D + cc) = o; }
    if (outpool) for (int idx = C.tid; idx < 15 * 512; idx += 512) { const int rr = idx >> 9, cc = idx & 511; outpool[idx] = bf1(P[(32 + rr) * PP + cc]); }
    __syncthreads();
}

#ifndef UN_MASK
#define UN_MASK 7
#endif
__device__ __forceinline__ void mixer_item(const Args& A, const Ctx& C, int l, int it) {
    const float* SCN = WS_PTR(const float, WS_SCN); unsigned char* Ub = A.ws + WS_U;
    constexpr int N_PSCAN = BATCH * 8 * 2, N_SSCAN = DECB * 8 * 2, N_PATT = BATCH * (SEQ / 64) * 2, N_SATT = DECB * 2, N_PPOOL = MP / 32, N_SPOOL = DECB;
    if (it < N_PSCAN + N_SSCAN) {
        const bool smp = it >= N_PSCAN; const int i2 = smp ? it - N_PSCAN : it;
        const int b = i2 >> 4, hd = (i2 >> 1) & 7, half = i2 & 1; const size_t row0 = smp ? (size_t)MP + b * DECS : (size_t)b * SEQ;
        const float* S0 = smp ? A.in[I_SWKV] + ((size_t)(l * DECB + b) * 8 + hd) * 4096 : nullptr;
        float* So = smp ? A.out + O_WKVS + ((size_t)(l * DECB + b) * 8 + hd) * 4096 : A.out + O_WKVP + ((size_t)(l * BATCH + b) * 8 + hd) * 4096;
        if (UN_MASK & 1) scan_unit(C, SCN + row0 * 3072 + hd * 384, smp ? DECS : SEQ, half, S0, So, Ub + row0 * UPITCH_B + UXC_B + (hd * 64 + half * 32) * 4);
        return; }
    it -= N_PSCAN + N_SSCAN;
    if (it < N_PATT + N_SATT) { int qrow0, nq, krow0, krow1, g; const float* ck; const float* cv; unsigned vmask;
        if (it < N_PATT) { const int c = (it >> 1) & 127, b = it >> 8; g = it & 1; nq = 64; qrow0 = b * SEQ + c * 64; ck = nullptr; cv = nullptr;
            krow0 = b * SEQ + (c - 2) * 64; krow1 = b * SEQ + (c - 1) * 64; vmask = (c >= 2 ? 3u : 0u) | (c >= 1 ? 12u : 0u) | 48u; }
        else { const int i2 = it - N_PATT; const int b = i2 >> 1; g = i2 & 1; nq = 32; qrow0 = MP + b * DECS; krow0 = 0; krow1 = 0; vmask = 31u;
            ck = A.in[I_CK] + ((size_t)(l * DECB + b) * 128) * 128 + g * 64; cv = A.in[I_CV] + ((size_t)(l * DECB + b) * 128) * 128 + g * 64; }
        if (UN_MASK & 2) attn_unit(A, C, l, qrow0, nq, krow0, krow1, qrow0, g, ck, cv, vmask);
        return; }
    it -= N_PATT + N_SATT;
    { int row0, t0, pos0; const float* hist; float* outp;
      if (it < N_PPOOL) { row0 = it * 32; t0 = row0 % SEQ; pos0 = t0; hist = nullptr; outp = (t0 == SEQ - 32) ? A.out + O_POOLP + (size_t)(l * BATCH + row0 / SEQ) * 15 * 512 : nullptr; }
      else { const int b = it - N_PPOOL; row0 = MP + b * DECS; t0 = 0; pos0 = 1024; hist = A.in[I_SPOOL] + (size_t)(l * DECB + b) * 15 * 512; outp = A.out + O_POOLS + (size_t)(l * DECB + b) * 15 * 512; }
      if (UN_MASK & 4) pool_item(A, C, l, row0, t0, pos0, hist, outp); }
}
__device__ __forceinline__ void phase_mixers(const Args& A, const Ctx& C0, int l) {
    Ctx C = C0; asm volatile("" : "+v"(C.tid)); C.lane = C.tid & 63; C.wave = __builtin_amdgcn_readfirstlane(C.tid >> 6);
    constexpr int N_PSCAN = BATCH * 8 * 2;
    constexpr int NI = N_PSCAN + DECB * 8 * 2 + BATCH * (SEQ / 64) * 2 + DECB * 2 + MP / 32 + DECB;
    if (C.G >= 2 * N_PSCAN) {
        if (C.bid < N_PSCAN) mixer_item(A, C, l, C.bid);
        else for (int it = N_PSCAN + (C.bid - N_PSCAN); it < NI; it += C.G - N_PSCAN) mixer_item(A, C, l, it);
    } else for (int it = C.bid; it < NI; it += C.G) mixer_item(A, C, l, it);
}

__device__ __forceinline__ void phase_post(const Args& A, const Ctx& C0, int l) {
    Ctx C = C0; asm volatile("" : "+v"(C.tid)); C.lane = C.tid & 63; C.wave = __builtin_amdgcn_readfirstlane(C.tid >> 6);
    const bf16* U = WS_PTR(const bf16, WS_U); bf16* MIX = WS_PTR(bf16, WS_XN); const unsigned char* Ub = A.ws + WS_U;
    const float* SCN = WS_PTR(const float, WS_SCN); const float* RKB = WS_PTR(const float, WS_RK);
    const int hd = C.wave, c = hd * 64 + C.lane;
    const float lw = A.in[I_LNXW][l * 512 + c], lb = A.in[I_LNXB][l * 512 + c];
    for (int row0 = C.bid * 4; row0 < M; row0 += C.G * 4) {
        float o[4], v[4], gr[4], rk[4];
#pragma unroll
        for (int i = 0; i < 4; ++i) { const size_t row = (size_t)(row0 + i);
            o[i] = ((const float*)(Ub + row * UPITCH_B + UXC_B))[c]; v[i] = SCN[row * 3072 + hd * 384 + 320 + C.lane];
            gr[i] = bf1(U[row * DIN + C_GR + c]); rk[i] = RKB[row * 8 + hd]; }
#pragma unroll
        for (int i = 0; i < 4; ++i) { const size_t row = (size_t)(row0 + i);
            const float mean = wave_sum(o[i]) * (1.f / 64.f); const float dd = o[i] - mean; const float var = wave_sum(dd * dd) * (1.f / 64.f);
            const float y = dd * (1.f / sqrtf(var + LNX_EPS)) * lw + lb + rk[i] * v[i];
            MIX[row * D + 1536 + c] = (bf16)f2bf(y * silu(gr[i])); }
    }
}
__device__ __forceinline__ void phase_norm(const Args& A, const Ctx& C0, int l) {
    Ctx C = C0; asm volatile("" : "+v"(C.tid)); C.lane = C.tid & 63; C.wave = __builtin_amdgcn_readfirstlane(C.tid >> 6);
    const int gw = C.bid * NWAVES + C.wave, NGW = C.G * NWAVES;
    if (l + 1 < DEPTH) { for (int m = gw; m < M; m += NGW) norm_row(A.out + (size_t)m * D, A.in[I_NORMW] + (size_t)(l + 1) * D, WS_PTR(bf16, WS_XN) + (size_t)m * D, nullptr, nullptr, C.lane); }
    else { for (int m = gw; m < M; m += NGW) norm_row(A.out + (size_t)m * D, A.in[I_FNW], nullptr, nullptr, A.out + (size_t)m * D, C.lane); }
}

constexpr int N_PHASES = 1 + 6 * DEPTH;
#ifndef EN_MASK
#define EN_MASK 0x7f
#endif
#define EN(k) ((EN_MASK >> (k)) & 1)
__global__ void __launch_bounds__(NWAVES * 64, 2) hybrid_fwd(Args A) {
    extern __shared__ __attribute__((aligned(16))) unsigned char lds_raw[];
    Ctx C; C.lds = (LAS unsigned char*)lds_raw; C.tid = threadIdx.x; C.lane = C.tid & 63; C.wave = __builtin_amdgcn_readfirstlane(C.tid >> 6); C.G = gridDim.x; C.bid = blockIdx.x;
    for (int u = C.tid; u < (LDS_BYTES - LDSCTL_OFF) / 4; u += NWAVES * 64) ((LAS unsigned*)(C.lds + LDSCTL_OFF))[u] = 0u;
    __syncthreads();
    gu32* ctl = (gu32*)(A.ws + WS_CTL);
    XcdBarrier bar; bar.bar = (unsigned*)(ctl + CW_BAR); bar.x = 0; bar.st = nullptr;
    if (A.coop) bar = xcd_barrier_post((unsigned*)(ctl + CW_BAR), (volatile LAS unsigned*)(C.lds + MISC_OFF) + 8);
    const int lo = A.ph_lo, hi = A.ph_hi;
    for (int ph = lo; ph < hi; ++ph) {
        if (ph == 0) { if (EN(0)) phase_prologue(A, C); }
        else {
            const int l = (ph - 1) / 6, s = (ph - 1) % 6;
            if (s == 0 && EN(1)) { pg8::Gemm g{WS_PTR(const bf16, WS_XN), WS_PTR(const bf16, WS_WINT) + (size_t)l * DINP * D, M, DINP, D}; pg8::StaticOrder S; S.init(M, DINP, C.G, C.bid);
                pg8::EpiU E{WS_PTR(bf16, WS_U)};
                pg8::gemm_phase<pg8::EpiU, pg8::StaticOrder, true, true>(C.lds, g, S, E); }
            else if (s == 1 && EN(2)) phase_prep(A, C, l);
            else if (s == 2 && EN(3)) phase_mixers(A, C, l);
            else if (s == 3 && EN(4)) phase_post(A, C, l);
            else if (s == 4 && EN(5)) { pg8::Gemm g{WS_PTR(const bf16, WS_XN), WS_PTR(const bf16, WS_WOUTT) + (size_t)l * D * D, M, D, D}; pg8::StaticOrder S; S.init(M, D, C.G, C.bid);
                pg8::EpiRes E{A.out};
                pg8::gemm_phase<pg8::EpiRes, pg8::StaticOrder, true, true>(C.lds, g, S, E); }
            else if (s == 5 && EN(6)) phase_norm(A, C, l);
        }
        if (ph + 1 < hi) {
            if (ph == 0) cg::this_grid().sync();
            else xcd_barrier(bar);
        }
    }
}

#ifndef MK_MULTI
#define MK_MULTI 0
#endif
extern "C" void kernel_launch(void* const* d_in, const int* in_sizes, int n_in, void* d_out, int out_size, void* d_ws, size_t ws_size, hipStream_t stream) {
    static int grid = 0;
    if (grid == 0) {
        if (n_in != 25 || (size_t)out_size != O_END || ws_size < WS_END) { fprintf(stderr, "kernel_launch: unexpected sizes: n_in %d out %d ws %zu (need %zu)\n", n_in, out_size, ws_size, (size_t)WS_END); grid = -1; return; }
        int dev = 0, cus = 0, per_cu = 0;
        if (hipGetDevice(&dev) != hipSuccess || hipDeviceGetAttribute(&cus, hipDeviceAttributeMultiprocessorCount, dev) != hipSuccess) { grid = -1; return; }
        if (hipFuncSetAttribute((const void*)hybrid_fwd, hipFuncAttributeMaxDynamicSharedMemorySize, LDS_BYTES) != hipSuccess) { fprintf(stderr, "kernel_launch: hipFuncSetAttribute failed\n"); grid = -1; return; }
        if (hipOccupancyMaxActiveBlocksPerMultiprocessor(&per_cu, (const void*)hybrid_fwd, NWAVES * 64, LDS_BYTES) != hipSuccess || per_cu < 1) { fprintf(stderr, "kernel_launch: occupancy query gives %d\n", per_cu); per_cu = 1; }
        (void)hipGetLastError();
        grid = cus;
    }
    if (grid < 0) return;
    (void)hipMemsetAsync((char*)d_ws + WS_CTL, 0, CTL_ZERO_BYTES, stream);
    Args a{};
    for (int i = 0; i < 25; ++i) a.in[i] = (const float*)d_in[i];
    a.out = (float*)d_out; a.ws = (unsigned char*)d_ws;
#if MK_MULTI
    for (int ph = 0; ph < N_PHASES; ++ph) { a.ph_lo = ph; a.ph_hi = ph + 1; a.coop = 0;
        hipLaunchKernelGGL(hybrid_fwd, dim3(grid), dim3(NWAVES * 64), LDS_BYTES, stream, a); }
#else
    a.ph_lo = 0; a.ph_hi = N_PHASES; a.coop = 1;
    void* args[] = {&a};
    hipError_t e = hipLaunchCooperativeKernel((const void*)hybrid_fwd, dim3(grid), dim3(NWAVES * 64), args, LDS_BYTES, stream);
    if (e != hipSuccess) fprintf(stderr, "kernel_launch: cooperative launch failed: %s (grid %d)\n", hipGetErrorString(e), grid);
#endif
}
```

```cpp
#include <hip/hip_runtime.h>
#include <hip/hip_cooperative_groups.h>
#include <cstdio>
#include <cstdint>
namespace cg = cooperative_groups;
namespace pg8 {
#define PG8_LAS __attribute__((address_space(3)))
typedef unsigned short bf16_t;
typedef short bf16x8 __attribute__((ext_vector_type(8)));
typedef float f32x4 __attribute__((ext_vector_type(4)));
typedef unsigned u32x4 __attribute__((ext_vector_type(4)));
constexpr int BM = 256, BK = 64, HALF = 128, HTB = HALF * BK * 2  , STAGE_BYTES = 8 * HTB, NXCD = 8, WGM = 8;

__host__ __device__ __forceinline__ int lds_byte(int r, int c) { const int st = (r >> 4) * 2 + (c >> 5), rr = r & 15, cc = c & 31, ob = rr * 64 + cc * 2; return st * 1024 + (ob ^ (((ob >> 9) & 1) << 5)); }
__host__ __device__ __forceinline__ void stage_rc(int b, int& R, int& C) { const int st = b / 1024, sb = b % 1024, swz = sb ^ (((sb >> 9) & 1) << 5); R = (st >> 1) * 16 + swz / 64; C = (st & 1) * 32 + (swz % 64) / 2; }
__host__ __device__ __forceinline__ int perm32(int rho) { const int n = rho >> 4, i = rho & 15; return 8 * (i >> 2) + 4 * n + (i & 3); }

struct Unit { int pm, pn; };
struct Gemm { const bf16_t* A; const bf16_t* Bt; int M, N, K, ld; };

struct StaticOrder {
    int nM, nN, nwg, G, c;
    __host__ __device__ void init(int M, int N, int G_, int c_) { nM = M / BM; nN = N / BM; nwg = nM * nN; G = G_; c = c_; }
    __host__ __device__ bool next(int i, Unit& u) const {
        const long L = (long)i * G + c; if (L >= nwg) return false;
        int wgid = (int)L; { const int q = nwg / NXCD, r = nwg % NXCD, xcd = wgid % NXCD, off = wgid / NXCD; wgid = (xcd < r ? xcd * (q + 1) : r * (q + 1) + (xcd - r) * q) + off; }
        const int nig = WGM * nN, gid = wgid / nig, fm = gid * WGM, gsz = (nM - fm) < WGM ? (nM - fm) : WGM;
        u.pm = fm + ((wgid % nig) % gsz); u.pn = (wgid % nig) / gsz; return true;
    }
    __device__ __forceinline__ void a_ready(const Unit&) const {}
    __device__ __forceinline__ void done(const Unit&) const {}
};
__device__ __forceinline__ unsigned cvt_pk_bf16(float lo, float hi) { unsigned r; asm volatile("v_cvt_pk_bf16_f32 %0, %1, %2" : "=v"(r) : "v"(lo), "v"(hi)); return r; }
typedef float f32x2 __attribute__((ext_vector_type(2)));
struct EpiU {
    static constexpr bool PERM = true, AFTER_DRAIN = false;
    bf16_t* O; const float* SS;
    __device__ __forceinline__ void operator()(const f32x4 (&acc)[2][2][4][2], const Unit& u, int wr, int wc, int fr, int fq) const {
        const int row0 = u.pm * BM + wr * 64 + fr; const int col0 = u.pn * BM + wc * 32 + 8 * fq;
#pragma unroll
        for (int ai = 0; ai < 2; ++ai)
#pragma unroll
            for (int m = 0; m < 4; ++m) { bf16_t* rowp = O + (size_t)(row0 + ai * HALF + m * 16) * 5504 + col0;
                const float rs = 1.0f / sqrtf(SS[row0 + ai * HALF + m * 16] * (1.0f / 2048.0f) + 1e-5f);
#pragma unroll
                for (int bj = 0; bj < 2; ++bj) { if (u.pn * BM + bj * HALF < 5504) { const f32x4 v0 = acc[ai][bj][m][0] * rs, v1 = acc[ai][bj][m][1] * rs;
                    u32x4 w; w.x = cvt_pk_bf16(v0[0], v0[1]); w.y = cvt_pk_bf16(v0[2], v0[3]); w.z = cvt_pk_bf16(v1[0], v1[1]); w.w = cvt_pk_bf16(v1[2], v1[3]);
                    *(u32x4*)(rowp + bj * HALF) = w; } } }
    }
};
struct EpiRes {
    static constexpr bool PERM = false, AFTER_DRAIN = false;
    float* H;
    __device__ __forceinline__ void operator()(const f32x4 (&acc)[2][2][4][2], const Unit& u, int wr, int wc, int fr, int fq) const {
        const int col0 = u.pn * BM + wc * 32 + 4 * fq;
#pragma unroll
        for (int ai = 0; ai < 2; ++ai)
#pragma unroll
            for (int m = 0; m < 4; ++m) { float* rowp = H + (size_t)(u.pm * BM + ai * HALF + wr * 64 + m * 16 + fr) * 2048 + col0;
#pragma unroll
                for (int bj = 0; bj < 2; ++bj)
#pragma unroll
                    for (int n = 0; n < 2; ++n) { f32x4* p = (f32x4*)(rowp + bj * HALF + n * 16); *p = *p + acc[ai][bj][m][n]; } }
    }
};

struct EpiResN {
    static constexpr bool PERM = true, AFTER_DRAIN = false;
    float* H; const float* HinP; const float* HinS; bf16_t* HB; float* SSn; bool fin;
    __device__ __forceinline__ void operator()(const f32x4 (&acc)[2][2][4][2], const Unit& u, int wr, int wc, int fr, int fq) const {
        const int col0 = u.pn * BM + wc * 32 + 8 * fq;
#pragma unroll
        for (int ai = 0; ai < 2; ++ai)
#pragma unroll
            for (int m = 0; m < 4; ++m) { const int row = u.pm * BM + ai * HALF + wr * 64 + m * 16 + fr; float* rowp = H + (size_t)row * 2048 + col0; bf16_t* hbp = HB + (size_t)row * 2048 + col0;
                const float* inp = (u.pm < 128 ? HinP : HinS) + (size_t)row * 2048 + col0;
                float ss = 0.f;
#pragma unroll
                for (int bj = 0; bj < 2; ++bj) { const f32x4 h0 = *(const f32x4*)(inp + bj * HALF) + acc[ai][bj][m][0], h1 = *(const f32x4*)(inp + bj * HALF + 4) + acc[ai][bj][m][1];
                    *(f32x4*)(rowp + bj * HALF) = h0; *(f32x4*)(rowp + bj * HALF + 4) = h1;
                    if (fin) { ss += ((h0[0] * h0[0] + h0[1] * h0[1]) + (h0[2] * h0[2] + h0[3] * h0[3])) + ((h1[0] * h1[0] + h1[1] * h1[1]) + (h1[2] * h1[2] + h1[3] * h1[3]));
                        u32x4 w; w.x = cvt_pk_bf16(h0[0], h0[1]); w.y = cvt_pk_bf16(h0[2], h0[3]); w.z = cvt_pk_bf16(h1[0], h1[1]); w.w = cvt_pk_bf16(h1[2], h1[3]);
                        *(u32x4*)(hbp + bj * HALF) = w; } }
                if (fin) { { const int ln = fr + 16 * fq; ss += __int_as_float(__builtin_amdgcn_ds_bpermute((ln ^ 16) << 2, __float_as_int(ss))); ss += __int_as_float(__builtin_amdgcn_ds_bpermute((ln ^ 32) << 2, __float_as_int(ss))); }
                    if (fq == 0) atomicAdd(SSn + row, ss); } }
    }
};
template <class Epi, class Sched, bool ALIGN_EPI = false, bool SP2 = false>
__device__ __forceinline__ void gemm_phase(PG8_LAS unsigned char* lds, const Gemm g, const Sched& S, const Epi& E) {
    int tid_l = threadIdx.x; asm volatile("" : "+v"(tid_l));
    const int tid = tid_l, wid = __builtin_amdgcn_readfirstlane(tid >> 6), lane = tid & 63, wr = wid >> 2, wc = wid & 3, fr = lane & 15, fq = lane >> 4;
    const int K = g.ld, nt = g.K / BK;
    unsigned voffA[2], voffB[2];
#pragma unroll
    for (int i = 0; i < 2; ++i) { int R, C; stage_rc(tid * 16 + i * 8192, R, C); const int Rb = Epi::PERM ? ((R & ~31) + perm32(R & 31)) : R;
        voffA[i] = (unsigned)(R * K + C) * 2u; voffB[i] = (unsigned)(Rb * K + C) * 2u; }
    const size_t kstep = (size_t)(BK * 2);
    const size_t hstep = (size_t)HALF * K * 2;
    const size_t tstep = 2 * hstep;
    const unsigned ldsw = (unsigned)wid * 1024u;
    const int aoff = lds_byte(wr * 64 + fr, fq * 8), boff = lds_byte(wc * 32 + fr, fq * 8);
#define PG8_SA(b, h) (((b) * 2 + (h)) * HTB)
#define PG8_SB(b, h) ((4 + (b) * 2 + (h)) * HTB)
#define PG8_STAGE(bufoff, gbase, voff) do { _Pragma("unroll") for (int _i = 0; _i < 2; ++_i) \
        __builtin_amdgcn_global_load_lds((const unsigned*)((const char*)(gbase) + (voff)[_i]), (PG8_LAS unsigned*)(lds + (bufoff) + ldsw + _i * 8192), 16, 0, 0); } while (0)
#define PG8_LDA(dst, b, h) do { _Pragma("unroll") for (int m = 0; m < 4; ++m) _Pragma("unroll") for (int k = 0; k < 2; ++k) dst[m][k] = *(const PG8_LAS bf16x8*)(lds + PG8_SA(b, h) + aoff + m * 2048 + k * 1024); } while (0)
#define PG8_LDB(dst, b, h) do { _Pragma("unroll") for (int n = 0; n < 2; ++n) _Pragma("unroll") for (int k = 0; k < 2; ++k) dst[n][k] = *(const PG8_LAS bf16x8*)(lds + PG8_SB(b, h) + boff + n * 2048 + k * 1024); } while (0)
#define PG8_MMA(ai, bj, At, Bt) do { __builtin_amdgcn_s_setprio(1); _Pragma("unroll") for (int m = 0; m < 4; ++m) _Pragma("unroll") for (int n = 0; n < 2; ++n) _Pragma("unroll") for (int k = 0; k < 2; ++k) \
        acc[ai][bj][m][n] = __builtin_amdgcn_mfma_f32_16x16x32_bf16(Bt[n][k], At[m][k], acc[ai][bj][m][n], 0, 0, 0); __builtin_amdgcn_s_setprio(0); } while (0)
#define PG8_WAIT_V(n) asm volatile("s_waitcnt vmcnt(" #n ")" ::: "memory")
#define PG8_WAIT_L(n) asm volatile("s_waitcnt lgkmcnt(" #n ")" ::: "memory")
#define PG8_BAR __builtin_amdgcn_s_barrier()
#define PG8_SCHED __builtin_amdgcn_sched_barrier(0)
    Unit cur, nxt; int ui = 0;
    if (!S.next(0, cur)) return;
    f32x4 acc[2][2][4][2];
#pragma unroll
    for (int a = 0; a < 2; ++a)
#pragma unroll
        for (int b = 0; b < 2; ++b)
#pragma unroll
            for (int m = 0; m < 4; ++m)
#pragma unroll
                for (int n = 0; n < 2; ++n) acc[a][b][m][n] = (f32x4){0.f, 0.f, 0.f, 0.f};
    bf16x8 At[4][2], B0[2][2], B1[2][2];
    const char* cA = (const char*)g.A + (size_t)cur.pm * tstep; const char* cB = (const char*)g.Bt + (size_t)cur.pn * tstep;
    S.a_ready(cur);
    if constexpr (SP2) {
        PG8_STAGE(PG8_SB(0, 0), cB, voffB); PG8_STAGE(PG8_SB(0, 1), cB + hstep, voffB); PG8_STAGE(PG8_SA(0, 0), cA, voffA); PG8_STAGE(PG8_SA(0, 1), cA + hstep, voffA);
        if (wr == 1) PG8_BAR;
        PG8_WAIT_V(2); PG8_BAR;
        PG8_STAGE(PG8_SB(1, 0), cB + kstep, voffB); PG8_STAGE(PG8_SA(1, 0), cA + kstep, voffA); PG8_STAGE(PG8_SB(1, 1), cB + hstep + kstep, voffB);
        PG8_WAIT_V(6); PG8_BAR;
    } else {
        PG8_STAGE(PG8_SB(0, 0), cB, voffB); PG8_STAGE(PG8_SA(0, 0), cA, voffA); PG8_STAGE(PG8_SB(0, 1), cB + hstep, voffB); PG8_STAGE(PG8_SA(0, 1), cA + hstep, voffA);
        if (wr == 1) PG8_BAR;
        PG8_WAIT_V(4); PG8_BAR;
        PG8_STAGE(PG8_SB(1, 0), cB + kstep, voffB); PG8_STAGE(PG8_SA(1, 0), cA + kstep, voffA); PG8_STAGE(PG8_SB(1, 1), cB + hstep + kstep, voffB);
        PG8_WAIT_V(6); PG8_BAR;
    }
    for (;;) {
        const bool has_next = S.next(ui + 1, nxt);
        const char* nA = has_next ? (const char*)g.A + (size_t)nxt.pm * tstep : cA; const char* nB = has_next ? (const char*)g.Bt + (size_t)nxt.pn * tstep : cB;
        for (int t = 0; t < nt; t += 2) {
            const bool last = (t == nt - 2);
            const char* a1 = cA + (size_t)(t + 1) * kstep;
            const char* a2 = last ? nA : cA + (size_t)(t + 2) * kstep; const char* b2 = last ? nB : cB + (size_t)(t + 2) * kstep;
            const char* a3 = a2 + kstep; const char* b3 = b2 + kstep;
            if (last && has_next) S.a_ready(nxt);
            if constexpr (SP2) {
            PG8_LDB(B0, 0, 0); PG8_LDB(B1, 0, 1); PG8_SCHED; PG8_LDA(At, 0, 0); PG8_STAGE(PG8_SA(1, 1), a1 + hstep, voffA);
            PG8_WAIT_V(8); PG8_WAIT_L(0); PG8_BAR; PG8_MMA(0, 0, At, B0); PG8_MMA(0, 1, At, B1); PG8_BAR; PG8_SCHED;
            PG8_LDA(At, 0, 1); PG8_STAGE(PG8_SB(0, 0), b2, voffB); PG8_STAGE(PG8_SB(0, 1), b2 + hstep, voffB); PG8_STAGE(PG8_SA(0, 0), a2, voffA);
            PG8_WAIT_V(8); PG8_WAIT_L(0); PG8_BAR; PG8_MMA(1, 0, At, B0); PG8_MMA(1, 1, At, B1); PG8_BAR; PG8_SCHED;
            PG8_LDB(B0, 1, 0); PG8_LDB(B1, 1, 1); PG8_SCHED; PG8_LDA(At, 1, 0); PG8_STAGE(PG8_SA(0, 1), a2 + hstep, voffA);
            PG8_WAIT_V(8); PG8_WAIT_L(0); PG8_BAR; PG8_MMA(0, 0, At, B0); PG8_MMA(0, 1, At, B1); PG8_BAR; PG8_SCHED;
            PG8_LDA(At, 1, 1); PG8_STAGE(PG8_SB(1, 0), b3, voffB); PG8_STAGE(PG8_SB(1, 1), b3 + hstep, voffB); PG8_STAGE(PG8_SA(1, 0), a3, voffA);
            PG8_WAIT_V(8); PG8_WAIT_L(0); PG8_BAR; PG8_MMA(1, 0, At, B0); PG8_MMA(1, 1, At, B1); PG8_BAR; PG8_SCHED;
            } else {
            PG8_LDB(B0, 0, 0); PG8_SCHED; PG8_LDA(At, 0, 0); PG8_STAGE(PG8_SA(1, 1), a1 + hstep, voffA);
            PG8_WAIT_L(8); PG8_BAR; PG8_WAIT_L(0); PG8_MMA(0, 0, At, B0); PG8_BAR; PG8_SCHED;
            PG8_LDB(B1, 0, 1); PG8_STAGE(PG8_SB(0, 0), b2, voffB);
            PG8_BAR; PG8_WAIT_L(0); PG8_MMA(0, 1, At, B1); PG8_BAR;
            PG8_LDA(At, 0, 1); PG8_STAGE(PG8_SA(0, 0), a2, voffA);
            PG8_BAR; PG8_WAIT_L(0); PG8_MMA(1, 0, At, B0); PG8_BAR; PG8_SCHED;
            PG8_STAGE(PG8_SB(0, 1), b2 + hstep, voffB);
            PG8_WAIT_V(6); PG8_BAR; PG8_MMA(1, 1, At, B1); PG8_BAR;
            PG8_LDB(B0, 1, 0); PG8_SCHED; PG8_LDA(At, 1, 0); PG8_STAGE(PG8_SA(0, 1), a2 + hstep, voffA);
            PG8_WAIT_L(8); PG8_BAR; PG8_WAIT_L(0); PG8_MMA(0, 0, At, B0); PG8_BAR; PG8_SCHED;
            PG8_LDB(B1, 1, 1); PG8_STAGE(PG8_SB(1, 0), b3, voffB);
            PG8_BAR; PG8_WAIT_L(0); PG8_MMA(0, 1, At, B1); PG8_BAR;
            PG8_LDA(At, 1, 1); PG8_STAGE(PG8_SA(1, 0), a3, voffA);
            PG8_BAR; PG8_WAIT_L(0); PG8_MMA(1, 0, At, B0); PG8_BAR; PG8_SCHED;
            PG8_STAGE(PG8_SB(1, 1), b3 + hstep, voffB);
            PG8_WAIT_V(6); PG8_BAR; PG8_MMA(1, 1, At, B1); PG8_BAR;
            }
        }
        if constexpr (ALIGN_EPI) { if (wr == 0) PG8_BAR; }
        if constexpr (!Epi::AFTER_DRAIN) { E(acc, cur, wr, wc, fr, fq); S.done(cur); }
        if (!has_next) break;
#pragma unroll
        for (int a = 0; a < 2; ++a)
#pragma unroll
            for (int b = 0; b < 2; ++b)
#pragma unroll
                for (int m = 0; m < 4; ++m)
#pragma unroll
                    for (int n = 0; n < 2; ++n) acc[a][b][m][n] = (f32x4){0.f, 0.f, 0.f, 0.f};
        cur = nxt; cA = nA; cB = nB; ++ui;
        if constexpr (ALIGN_EPI) { if (wr == 1) PG8_BAR; }
    }
    PG8_WAIT_V(0);
    if constexpr (!ALIGN_EPI) { if (wr == 0) PG8_BAR; }
    PG8_BAR;
    if constexpr (Epi::AFTER_DRAIN) { E.fused(acc, cur, wr, wc, fr, fq, lds, wid, lane); S.done(cur); }
#undef PG8_SA
#undef PG8_SB
#undef PG8_STAGE
#undef PG8_LDA
#undef PG8_LDB
#undef PG8_MMA
#undef PG8_WAIT_V
#undef PG8_WAIT_L
#undef PG8_BAR
#undef PG8_SCHED
}
}

constexpr int NWAVES = 8;
constexpr int D = 2048, BATCH = 4, SEQ = 8192, DEPTH = 4, DECB = 8, DECS = 32;
constexpr int MP = BATCH * SEQ, MS = DECB * DECS, M = MP + MS;
constexpr int DIN = 5504, DINP = 5632;
constexpr int C_P = 0, C_GP = 512, C_Q = 1024, C_K = 2048, C_V = 2176, C_GA = 2304, C_XC = 3328, C_GR = 4992;
constexpr int DSH = 1664;
constexpr float NORM_EPS = 1e-5f, LNX_EPS = 1e-5f * 64.f;
constexpr size_t UPITCH_B = (size_t)DIN * 2;
constexpr size_t UXC_B = (size_t)C_XC * 2;
constexpr size_t O_YP = 0, O_YS = (size_t)MP * D, O_POOLP = O_YS + (size_t)MS * D;
constexpr size_t O_KP = O_POOLP + (size_t)DEPTH * BATCH * 15 * 512, O_VP = O_KP + (size_t)DEPTH * BATCH * 128 * 128;
constexpr size_t O_SHP = O_VP + (size_t)DEPTH * BATCH * 128 * 128, O_WKVP = O_SHP + (size_t)DEPTH * BATCH * DSH;
constexpr size_t O_POOLS = O_WKVP + (size_t)DEPTH * BATCH * 8 * 4096, O_KS = O_POOLS + (size_t)DEPTH * DECB * 15 * 512;
constexpr size_t O_VS = O_KS + (size_t)DEPTH * DECB * 128 * 128, O_SHS = O_VS + (size_t)DEPTH * DECB * 128 * 128;
constexpr size_t O_WKVS = O_SHS + (size_t)DEPTH * DECB * DSH, O_END = O_WKVS + (size_t)DEPTH * DECB * 8 * 4096;
constexpr size_t MiB = 1u << 20;
constexpr size_t WS_CTL = 0, CTL_ZERO_BYTES = 1 * MiB;
constexpr size_t WS_WINT = 1 * MiB;
constexpr size_t WS_WOUTT = WS_WINT + (size_t)DEPTH * DINP * D * 2;
constexpr size_t WS_PWT = WS_WOUTT + (size_t)DEPTH * D * D * 2;
constexpr size_t WS_BIAS = WS_PWT + (size_t)DEPTH * 4 * 128 * 128 * 2;
constexpr size_t WS_RK = WS_BIAS + 256 * 16 * 4;
constexpr size_t WS_SS = WS_RK + (size_t)M * 8 * 4;
constexpr size_t WS_XN = WS_SS + (size_t)5 * M * 4 + 1280;
constexpr size_t WS_U = WS_XN + (size_t)M * D * 2;
constexpr size_t WS_SCN = WS_U + (size_t)M * DIN * 2;
constexpr size_t WS_END = WS_SCN + (size_t)M * 3072 * 4;
static_assert(WS_END <= (size_t)1024 * MiB, "workspace map exceeds 1 GiB");
static_assert(WS_XN % 256 == 0 && WS_U % 256 == 0 && WS_SCN % 256 == 0 && WS_RK % 256 == 0 && WS_SS % 256 == 0, "alignment");
constexpr size_t WS_HB = WS_SCN;
constexpr int KSPLIT = 1280;
constexpr int CW_BAR = 4096, CW_SUB = 8192;
constexpr int RING_BYTES = 131072, LDSCTL_OFF = RING_BYTES, MISC_OFF = LDSCTL_OFF + 320, LDS_BYTES = 147456;

#define GAS __attribute__((address_space(1)))
#define LAS __attribute__((address_space(3)))
typedef unsigned short bf16;
typedef unsigned v4u __attribute__((ext_vector_type(4)));
typedef unsigned v2u __attribute__((ext_vector_type(2)));
typedef float f32x4 __attribute__((ext_vector_type(4)));
typedef float f32x16 __attribute__((ext_vector_type(16)));
typedef short bf16x8 __attribute__((ext_vector_type(8)));
typedef GAS unsigned gu32;
#define RLX_AGENT __ATOMIC_RELAXED, __HIP_MEMORY_SCOPE_AGENT
#define LDS_WAIT() asm volatile("s_waitcnt lgkmcnt(0)" ::: "memory")
#define VM_WAIT() asm volatile("s_waitcnt vmcnt(0)" ::: "memory")
__device__ __forceinline__ unsigned f2bf(float f) { unsigned u = __builtin_bit_cast(unsigned, f); return (u + 0x7fffu + ((u >> 16) & 1u)) >> 16; }
__device__ __forceinline__ unsigned pk2(float lo, float hi) { return f2bf(lo) | (f2bf(hi) << 16); }
__device__ __forceinline__ float bflo(unsigned w) { return __uint_as_float(w << 16); }
__device__ __forceinline__ float bfhi(unsigned w) { return __uint_as_float(w & 0xffff0000u); }
__device__ __forceinline__ float bf1(bf16 h) { return __uint_as_float(((unsigned)h) << 16); }
__device__ __forceinline__ float silu(float x) { return x / (1.f + __expf(-x)); }
__device__ __forceinline__ float shflx(float v, int mask, int lane) { return __int_as_float(__builtin_amdgcn_ds_bpermute((lane ^ mask) << 2, __float_as_int(v))); }
template <int CTRL> __device__ __forceinline__ float dpp_add(float x) {
    const int y = __builtin_amdgcn_update_dpp(0, __float_as_int(x), CTRL, 0xf, 0xf, true);
    return x + __int_as_float(y);
}
__device__ __forceinline__ float row16_sum(float x) {
    x = dpp_add<0xB1>(x);
    x = dpp_add<0x4E>(x);
    x = dpp_add<0x141>(x);
    x = dpp_add<0x140>(x);
    return x;
}
__device__ __forceinline__ float wave_sum_l(float v, int) {
    v = row16_sum(v);
    const int iv = __float_as_int(v);
    return (__int_as_float(__builtin_amdgcn_readlane(iv, 0)) + __int_as_float(__builtin_amdgcn_readlane(iv, 16))) + (__int_as_float(__builtin_amdgcn_readlane(iv, 32)) + __int_as_float(__builtin_amdgcn_readlane(iv, 48)));
}
#define XB_TMO      128
#define XB_XCNT(j)  (256  + 64 * (j))
#define XB_XSUB(j)  (1280 + 64 * (j))
#define XB_XGEN(j)  (2304 + 64 * (j))
#define XB_TOP      3328
#define XB_TOPGEN   3392
#define XCD_BAR_WORDS 3456
#define XB_SPIN_CAP (1u << 18)

__device__ __forceinline__ unsigned xb_ld(unsigned* p)              { return __hip_atomic_load(p, __ATOMIC_RELAXED, __HIP_MEMORY_SCOPE_AGENT); }
__device__ __forceinline__ unsigned xb_add(unsigned* p, unsigned v) { return __hip_atomic_fetch_add(p, v, __ATOMIC_RELAXED, __HIP_MEMORY_SCOPE_AGENT); }
__device__ __forceinline__ unsigned xb_xcc_id() { return (unsigned)__builtin_amdgcn_s_getreg((3 << 11) | 20) & 0xFu; }
#define XB_SPIN(cond, bar) do { unsigned _sp = 0; while (cond) { __builtin_amdgcn_s_sleep(1); \
    if ((++_sp & 255u) == 0u) { if (xb_ld(&(bar)[XB_TMO])) break; if (_sp > XB_SPIN_CAP) { atomicAdd(&(bar)[XB_TMO], 1u); break; } } } } while (0)

struct XcdBarrier {
    unsigned* bar; unsigned x;
    volatile LAS unsigned* st;
};

__device__ __forceinline__ XcdBarrier xcd_barrier_post(unsigned* bar, volatile LAS unsigned* st) {
    XcdBarrier b; b.bar = bar; b.x = xb_xcc_id(); b.st = st;
    if (threadIdx.x == 0) (void)xb_add(&bar[XB_XCNT(b.x)], 1u);
    return b;
}
__device__ __forceinline__ void xcd_barrier_complete(unsigned* bar, unsigned x, unsigned& nloc, unsigned& nx) {
    const unsigned G = gridDim.x * gridDim.y * gridDim.z;
    unsigned sum, cnt, mine, sp = 0u;
    for (;;) {
        sum = 0u; cnt = 0u; mine = 0u;
#pragma unroll
        for (unsigned j = 0; j < 16; ++j) { const unsigned c = xb_ld(&bar[XB_XCNT(j)]); sum += c; cnt += (c > 0u) ? 1u : 0u; mine = (j == x) ? c : mine; }
        if (sum == G) break;
        __builtin_amdgcn_s_sleep(1);
        if ((++sp & 255u) == 0u) { if (xb_ld(&bar[XB_TMO])) break; if (sp > XB_SPIN_CAP) { atomicAdd(&bar[XB_TMO], 1u); break; } }
    }
    nloc = mine > 0u ? mine : 1u; nx = cnt > 0u ? cnt : 1u;
}

__device__ __forceinline__ void xcd_barrier(const XcdBarrier& b) {
    asm volatile("s_waitcnt vmcnt(0)" ::: "memory");
    __syncthreads();
    if (threadIdx.x == 0) {
        unsigned* bar = b.bar;
        __builtin_amdgcn_s_waitcnt(0);
        unsigned nloc = b.st[0], nx = b.st[1];
        if (nloc == 0u) { xcd_barrier_complete(bar, b.x, nloc, nx); b.st[0] = nloc; b.st[1] = nx; }
        const unsigned old = xb_add(&bar[XB_XSUB(b.x)], 1u);
        const unsigned gen = old / nloc;
        if (old + 1u == (gen + 1u) * nloc) {
            __builtin_amdgcn_fence(__ATOMIC_RELEASE, "agent");
            asm volatile("s_waitcnt vmcnt(0)" ::: "memory");
            const unsigned og = xb_add(&bar[XB_TOP], 1u);
            const unsigned tg = og / nx;
            if (og + 1u == (tg + 1u) * nx) xb_add(&bar[XB_TOPGEN], 1u);
            else XB_SPIN(xb_ld(&bar[XB_TOPGEN]) == tg, bar);
            __builtin_amdgcn_fence(__ATOMIC_ACQUIRE, "agent");
            xb_add(&bar[XB_XGEN(b.x)], 1u);
            asm volatile("s_waitcnt vmcnt(0)" ::: "memory");
        } else {
            XB_SPIN(xb_ld(&bar[XB_XGEN(b.x)]) == gen, bar);
            __builtin_amdgcn_fence(__ATOMIC_ACQUIRE, "agent");
            asm volatile("s_waitcnt vmcnt(0)" ::: "memory");
        }
    }
    __syncthreads();
}

struct Args { const float* in[25]; float* out; unsigned char* ws; int ph_lo, ph_hi, coop, pad; };
struct Ctx { LAS unsigned char* lds; int tid, lane, wave, G, bid; };
enum { I_XP = 0, I_XS, I_SPOOL, I_CK, I_CV, I_SSHIFT, I_SWKV, I_NORMW, I_WIN, I_WOUT, I_POOLW, I_POOLS, I_SINKS, I_RELB, I_MU, I_W0, I_WUP, I_A0, I_AUP, I_KK, I_KA, I_RK, I_LNXW, I_LNXB, I_FNW };

#define WS_PTR(T, off) ((T*)(wsb + (off)))
#define WSB_DECL unsigned char* wsb = A.ws; asm volatile("" : "+s"(wsb))

__device__ __forceinline__ void transpose_item(const float* W, int K, int N, bf16* WT, LAS float* scr, int item, int lane, const float* kscale = nullptr) {
    const int nblk = N / 32, kb = item / nblk, nb = item % nblk, k0 = 64 * kb, n0 = 32 * nb;
    { f32x4 t[8]; float sc[8];
#pragma unroll
      for (int i = 0; i < 8; ++i) { const int kk = 8 * i + (lane >> 3); t[i] = *(const f32x4*)(W + (size_t)(k0 + kk) * N + n0 + 4 * (lane & 7)); sc[i] = kscale ? kscale[k0 + kk] : 1.0f; }
#pragma unroll
      for (int i = 0; i < 8; ++i) { const int kk = 8 * i + (lane >> 3); LAS float* d = scr + kk * 33 + 4 * (lane & 7); d[0] = t[i].x * sc[i]; d[1] = t[i].y * sc[i]; d[2] = t[i].z * sc[i]; d[3] = t[i].w * sc[i]; } }
    LDS_WAIT(); asm volatile("" ::: "memory");
    const int c = lane & 7;
#pragma unroll
    for (int j = 0; j < 4; ++j) { const int n = (lane >> 3) + 8 * j; const LAS float* s = scr + (8 * c) * 33 + n;
        v4u o; o.x = pk2(s[0 * 33], s[1 * 33]); o.y = pk2(s[2 * 33], s[3 * 33]); o.z = pk2(s[4 * 33], s[5 * 33]); o.w = pk2(s[6 * 33], s[7 * 33]);
        *(v4u*)(WT + (size_t)(n0 + n) * K + k0 + 8 * c) = o; }
    LDS_WAIT(); asm volatile("" ::: "memory");
}
__device__ __forceinline__ void norm_row(const float* src, const float* w, bf16* xn, float* hcopy, float* y, int lane) {
    const f32x4* xr = (const f32x4*)src + lane;
    f32x4 v[8]; float s = 0.f;
#pragma unroll
    for (int j = 0; j < 8; ++j) { v[j] = xr[64 * j]; s += (v[j].x * v[j].x + v[j].y * v[j].y) + (v[j].z * v[j].z + v[j].w * v[j].w); }
    const float rstd = 1.f / sqrtf(wave_sum_l(s, lane) * (1.f / D) + NORM_EPS);
    if (hcopy) {
#pragma unroll
        for (int j = 0; j < 8; ++j) ((f32x4*)hcopy + lane)[64 * j] = v[j];
    }
    const f32x4* wr = (const f32x4*)w + lane;
#pragma unroll
    for (int j = 0; j < 8; ++j) { const f32x4 ww = wr[64 * j]; const f32x4 o = v[j] * rstd * ww;
        if (xn) { v2u p; p.x = pk2(o.x, o.y); p.y = pk2(o.z, o.w); ((v2u*)xn + lane)[64 * j] = p; }
        if (y) ((f32x4*)y + lane)[64 * j] = o; }
}
__device__ __forceinline__ int t5_bucket(int rel) {
    const int n = rel < 0 ? -rel : rel; int v;
    if (n < 8) v = n; else v = 8 + (n >= 12) + (n >= 16) + (n >= 23) + (n >= 32) + (n >= 46) + (n >= 64) + (n >= 91);
    return (rel > 0 ? 16 : 0) + v;
}

__device__ __forceinline__ void phase_prologue(const Args& A, const Ctx& C0) {
    Ctx C = C0; C.tid = threadIdx.x; asm volatile("" : "+v"(C.tid)); asm volatile("" : "+s"(C.G), "+s"(C.bid)); C.lane = C.tid & 63; C.wave = __builtin_amdgcn_readfirstlane(C.tid >> 6);
    WSB_DECL;
    LAS float* scr = (LAS float*)(C.lds + C.wave * 16384);
    const int gw = C.bid * NWAVES + C.wave, NGW = C.G * NWAVES;
    constexpr int I_IN = (D / 64) * (DIN / 32), I_OUT = (D / 64) * (D / 32), I_PW = 4 * 8, PER_L = I_IN + I_OUT + I_PW;
    for (int it = gw; it < DEPTH * PER_L; it += NGW) {
        const int l = it / PER_L; int r = it % PER_L;
        if (r < I_IN) { transpose_item(A.in[I_WIN] + (size_t)l * D * DIN, D, DIN, WS_PTR(bf16, WS_WINT) + (size_t)l * DINP * D, scr, r, C.lane, A.in[I_NORMW] + (size_t)l * D); continue; } r -= I_IN;
        if (r < I_OUT) { transpose_item(A.in[I_WOUT] + (size_t)l * D * D, D, D, WS_PTR(bf16, WS_WOUTT) + (size_t)l * D * D, scr, r, C.lane); continue; } r -= I_OUT;
        { const int g = r >> 3; transpose_item(A.in[I_POOLW] + (size_t)(l * 4 + g) * 128 * 128, 128, 128, WS_PTR(bf16, WS_PWT) + (size_t)(l * 4 + g) * 128 * 128, scr, r & 7, C.lane); }
    }
    { const int gt = C.bid * 512 + C.tid, NGT = C.G * 512; constexpr int PER = (DINP - DIN) * D * 2 / 16;
      for (int i = gt; i < DEPTH * PER; i += NGT) { const int l = i / PER, r = i % PER; ((v4u*)(WS_PTR(bf16, WS_WINT) + (size_t)l * DINP * D + (size_t)DIN * D))[r] = (v4u){0u, 0u, 0u, 0u}; } }
    if (C.bid == 0) { float* B = WS_PTR(float, WS_BIAS);
        for (int i = C.tid; i < 256 * 16; i += 512) { const int ri = i >> 4, h = i & 15; const int rel = ri - 191; B[i] = (ri < 255) ? A.in[I_RELB][t5_bucket(rel) * 16 + h] : 0.f; } }
    { float* SS = WS_PTR(float, WS_SS); bf16* HB = WS_PTR(bf16, WS_HB);
      for (int m = gw; m < M; m += 4 * NGW) {
          const f32x4* x[4]; f32x4 v[4][8]; int mr[4]; bool ok[4];
#pragma unroll
          for (int r = 0; r < 4; ++r) { ok[r] = m + r * NGW < M; mr[r] = ok[r] ? m + r * NGW : m;
              x[r] = (const f32x4*)(mr[r] < MP ? A.in[I_XP] + (size_t)mr[r] * D : A.in[I_XS] + (size_t)(mr[r] - MP) * D) + C.lane; }
#pragma unroll
          for (int r = 0; r < 4; ++r)
#pragma unroll
              for (int j = 0; j < 8; ++j) v[r][j] = x[r][64 * j];
#pragma unroll
          for (int r = 0; r < 4; ++r) { float t = 0.f;
#pragma unroll
              for (int j = 0; j < 8; ++j) t += (v[r][j].x * v[r][j].x + v[r][j].y * v[r][j].y) + (v[r][j].z * v[r][j].z + v[r][j].w * v[r][j].w);
              t = wave_sum_l(t, C.lane);
              if (ok[r]) {
#pragma unroll
                  for (int j = 0; j < 8; ++j) { v2u p; p.x = pk2(v[r][j].x, v[r][j].y); p.y = pk2(v[r][j].z, v[r][j].w); ((v2u*)(HB + (size_t)mr[r] * D) + C.lane)[64 * j] = p; }
                  if (C.lane == 0) SS[mr[r]] = t; } } }
      const int gt = C.bid * 512 + C.tid, NGT = C.G * 512;
      for (int i = gt; i < 4 * M; i += NGT) SS[M + i] = 0.f; }
}

__device__ __forceinline__ void phase_prep(const Args& A, const Ctx& C0, int l) {
    Ctx C = C0; C.tid = threadIdx.x; asm volatile("" : "+v"(C.tid)); asm volatile("" : "+s"(C.G), "+s"(C.bid)); C.lane = C.tid & 63; C.wave = __builtin_amdgcn_readfirstlane(C.tid >> 6);
    WSB_DECL;
    LAS float* raw = (LAS float*)C.lds;
    const bf16* U = WS_PTR(const bf16, WS_U);
    float* SCN = WS_PTR(float, WS_SCN); float* RKB = WS_PTR(float, WS_RK);
    const int c = C.tid, head = C.wave;
    bf16x8 wfr[2][4][2];
    { const int fr = C.lane & 15, fq = C.lane >> 4;
#pragma unroll
      for (int mat = 0; mat < 2; ++mat) { const float* W = A.in[mat ? I_AUP : I_WUP] + (size_t)l * 64 * 512 + head * 64 + fr;
#pragma unroll
          for (int ct = 0; ct < 4; ++ct)
#pragma unroll
              for (int ks = 0; ks < 2; ++ks) { const float* p = W + (size_t)(ks * 32 + 8 * fq) * 512 + ct * 16;
                  union { bf16x8 v; unsigned w[4]; } f;
#pragma unroll
                  for (int e = 0; e < 4; ++e) f.w[e] = pk2(p[(2 * e) * 512], p[(2 * e + 1) * 512]);
                  wfr[mat][ct][ks] = f.v; } } }
    LAS bf16* lob = (LAS bf16*)(C.lds + 9 * DSH * 4);
    LAS float* outw = (LAS float*)(C.lds + 9 * DSH * 4 + 16 * 136 * 2);
    LAS float* outa = outw + 8 * 512;
    const float w0 = A.in[I_W0][l * 512 + c], a0 = A.in[I_A0][l * 512 + c], kkc = A.in[I_KK][l * 512 + c], kac = A.in[I_KA][l * 512 + c], rkc = A.in[I_RK][l * 512 + c];
    const float* mul = A.in[I_MU] + (size_t)l * DSH;
    const float mu_r = mul[c], mu_k = mul[512 + c], mu_v = mul[1024 + c];
    v4u px[4];
#define PREP_FETCH(tl) do { const int _r0 = (tl) * 8; const bool _ss = _r0 < MP ? (_r0 % SEQ) == 0 : ((_r0 - MP) % DECS) == 0; \
        _Pragma("unroll") for (int _it = 0; _it < 4; ++_it) { const int _idx = C.tid + 512 * _it; const int _rr = _idx / 208, _v = _idx % 208; px[_it] = (v4u){0u, 0u, 0u, 0u}; \
            if (_idx < 9 * 208 && !(_rr == 0 && _ss)) px[_it] = *(const v4u*)(U + (size_t)(_r0 - 1 + _rr) * DIN + C_XC + _v * 8); } } while (0)
    if (C.bid < M / 8) PREP_FETCH(C.bid);
    for (int tile = C.bid; tile < M / 8; tile += C.G) {
        const int row0 = tile * 8;
        bool seq_start; const float* shiftp = nullptr;
        if (row0 < MP) seq_start = (row0 % SEQ) == 0; else { const int rs = row0 - MP; seq_start = (rs % DECS) == 0; shiftp = A.in[I_SSHIFT] + (size_t)(l * DECB + rs / DECS) * DSH; }
#pragma unroll
        for (int it = 0; it < 4; ++it) { const int idx = C.tid + 512 * it; const int rr = idx / 208, v = idx % 208;
            if (idx < 9 * 208) { const v4u x = px[it];
                f32x4 f0 = (f32x4){bflo(x.x), bfhi(x.x), bflo(x.y), bfhi(x.y)}, f1 = (f32x4){bflo(x.z), bfhi(x.z), bflo(x.w), bfhi(x.w)};
                if (rr == 0 && seq_start && shiftp) { f0 = *(const f32x4*)(shiftp + v * 8); f1 = *(const f32x4*)(shiftp + v * 8 + 4); }
                *(LAS f32x4*)(raw + rr * DSH + v * 8) = f0; *(LAS f32x4*)(raw + rr * DSH + v * 8 + 4) = f1; } }
        if (tile + C.G < M / 8) PREP_FETCH(tile + C.G);
        __syncthreads();
#pragma unroll
        for (int k = 0; k < 2; ++k) { const int idx = C.tid + 512 * k, tt = idx >> 7, j = idx & 127, i = 1536 + j;
            const float cur = raw[(tt + 1) * DSH + i], prev = raw[tt * DSH + i]; const float xs = cur + (prev - cur) * mul[i];
            float o = xs; if (j < 64) { const float e = __expf(2.f * xs); o = 1.f - 2.f / (e + 1.f); }
            lob[tt * 136 + j] = (bf16)f2bf(o); }
        __syncthreads();
        { const int fr = C.lane & 15, fq = C.lane >> 4;
#pragma unroll
          for (int mat = 0; mat < 2; ++mat) { bf16x8 af[2];
#pragma unroll
              for (int ks = 0; ks < 2; ++ks) af[ks] = *(const LAS bf16x8*)(lob + fr * 136 + mat * 64 + ks * 32 + 8 * fq);
#pragma unroll
              for (int ct = 0; ct < 4; ++ct) { f32x4 acc = (f32x4){0.f, 0.f, 0.f, 0.f};
#pragma unroll
                  for (int ks = 0; ks < 2; ++ks) acc = __builtin_amdgcn_mfma_f32_16x16x32_bf16(af[ks], wfr[mat][ct][ks], acc, 0, 0, 0);
                  if (fq < 2) { LAS float* o = (mat ? outa : outw) + (4 * fq) * 512 + head * 64 + ct * 16 + fr;
                      o[0] = acc[0]; o[512] = acc[1]; o[1024] = acc[2]; o[1536] = acc[3]; } } } }
        __syncthreads();
#pragma unroll 2
        for (int tt = 0; tt < 8; ++tt) {
            const float aw = outw[tt * 512 + c], aa = outa[tt * 512 + c];
            const int row = row0 + tt;
            const LAS float* cu = raw + (tt + 1) * DSH; const LAS float* pv = raw + tt * DSH;
            const float r = cu[c] + (pv[c] - cu[c]) * mu_r, k = cu[512 + c] + (pv[512 + c] - cu[512 + c]) * mu_k, v = cu[1024 + c] + (pv[1024 + c] - cu[1024 + c]) * mu_v;
            const float lw = w0 + aw; const float z = -lw;
            const float sp = fmaxf(z, 0.f) + logf(1.f + expf(-fabsf(z)));
            const float wraw = -sp - 0.5f; const float decay = expf(-expf(wraw));
            const float ai = 1.f / (1.f + expf(-(a0 + aa)));
            const float kkr = k * kkc; const float ss = wave_sum_l(kkr * kkr, C.lane);
            const float kk = kkr / fmaxf(sqrtf(ss), 1e-12f);
            const float k2 = k * (1.f + (ai - 1.f) * kac); const float b = kk * ai;
            const float rk = wave_sum_l(r * k2 * rkc, C.lane);
            float* s = SCN + (size_t)row * 3072 + head * 384 + C.lane;
            s[0] = kk; s[64] = b; s[128] = decay; s[192] = k2; s[256] = r; s[320] = v;
            if (C.lane == 0) RKB[row * 8 + head] = rk;
        }
        { const int lastrow = row0 + 7; bool is_last; float* dst;
          if (lastrow < MP) { is_last = (lastrow % SEQ) == SEQ - 1; dst = A.out + O_SHP + (size_t)(l * BATCH + lastrow / SEQ) * DSH; }
          else { const int rs = lastrow - MP; is_last = (rs % DECS) == DECS - 1; dst = A.out + O_SHS + (size_t)(l * DECB + rs / DECS) * DSH; }
          if (is_last) for (int i = C.tid; i < DSH; i += 512) dst[i] = raw[8 * DSH + i]; }
        __syncthreads();
    }
    { const int gt = C.bid * 512 + C.tid, NGT = C.G * 512;
      constexpr int NP = BATCH * 128 * 2 * 32, NS = DECB * 128 * 2 * 32;
      for (int i = gt; i < NP + NS; i += NGT) {
          if (i < NP) { const int q4 = i & 31, kv = (i >> 5) & 1, j = (i >> 6) & 127, b = i >> 13;
              const v2u x = *(const v2u*)(U + (size_t)(b * SEQ + SEQ - 128 + j) * DIN + (kv ? C_V : C_K) + q4 * 4);
              float* dst = A.out + (kv ? O_VP : O_KP) + ((size_t)(l * BATCH + b) * 128 + j) * 128 + q4 * 4;
              *(f32x4*)dst = (f32x4){bflo(x.x), bfhi(x.x), bflo(x.y), bfhi(x.y)}; }
          else { const int ii = i - NP; const int q4 = ii & 31, kv = (ii >> 5) & 1, j = (ii >> 6) & 127, b = ii >> 13;
              float* dst = A.out + (kv ? O_VS : O_KS) + ((size_t)(l * DECB + b) * 128 + j) * 128 + q4 * 4;
              if (j < 96) *(f32x4*)dst = *(const f32x4*)(A.in[kv ? I_CV : I_CK] + ((size_t)(l * DECB + b) * 128 + j + 32) * 128 + q4 * 4);
              else { const v2u x = *(const v2u*)(U + (size_t)(MP + b * DECS + j - 96) * DIN + (kv ? C_V : C_K) + q4 * 4);
                  *(f32x4*)dst = (f32x4){bflo(x.x), bfhi(x.x), bflo(x.y), bfhi(x.y)}; } }
      } }
}
#define SCAN_CHUNK_ASM \
    "ds_read_b128 v[164:167], %6 offset:0\n\t" \
    "ds_read_b128 v[168:171], %6 offset:256\n\t" \
    "ds_read_b128 v[172:175], %6 offset:512\n\t" \
    "ds_read_b128 v[176:179], %6 offset:768\n\t" \
    "ds_read_b128 v[180:183], %6 offset:1024\n\t" \
    "ds_read_b32 v184, %7 offset:0\n\t" \
    "ds_read_b128 v[186:189], %6 offset:1536\n\t" \
    "ds_read_b128 v[190:193], %6 offset:1792\n\t" \
    "ds_read_b128 v[194:197], %6 offset:2048\n\t" \
    "ds_read_b128 v[198:201], %6 offset:2304\n\t" \
    "ds_read_b128 v[202:205], %6 offset:2560\n\t" \
    "ds_read_b32 v206, %7 offset:1536\n\t" \
    "s_waitcnt lgkmcnt(0)\n\t" \
    "v_mul_f32 v137, v184, v176\n\t" \
    "v_mul_f32 v138, v184, v177\n\t" \
    "v_mul_f32 v139, v184, v178\n\t" \
    "v_mul_f32 v140, v184, v179\n\t" \
    "v_mul_f32 v145, %0, v164\n\t" \
    "v_mul_f32 v146, %1, v165\n\t" \
    "v_fma_f32 v145, %2, v166, v145\n\t" \
    "v_fma_f32 v146, %3, v167, v146\n\t" \
    "v_add_f32 v145, v145, v146\n\t" \
    "ds_read_b128 v[208:211], %6 offset:3072\n\t" \
    "ds_read_b128 v[212:215], %6 offset:3328\n\t" \
    "ds_read_b128 v[216:219], %6 offset:3584\n\t" \
    "ds_read_b128 v[220:223], %6 offset:3840\n\t" \
    "ds_read_b128 v[224:227], %6 offset:4096\n\t" \
    "ds_read_b32 v228, %7 offset:3072\n\t" \
    "s_waitcnt lgkmcnt(6)\n\t" \
    "v_add_f32_dpp v145, v145, v145 quad_perm:[1,0,3,2] row_mask:0xf bank_mask:0xf bound_ctrl:1\n\t" \
    "s_nop 0\n\t" \
    "s_nop 0\n\t" \
    "v_add_f32_dpp v145, v145, v145 quad_perm:[2,3,0,1] row_mask:0xf bank_mask:0xf bound_ctrl:1\n\t" \
    "s_nop 0\n\t" \
    "s_nop 0\n\t" \
    "v_add_f32_dpp v145, v145, v145 row_half_mirror row_mask:0xf bank_mask:0xf bound_ctrl:1\n\t" \
    "s_nop 0\n\t" \
    "s_nop 0\n\t" \
    "v_add_f32_dpp v145, v145, v145 row_mirror row_mask:0xf bank_mask:0xf bound_ctrl:1\n\t" \
    "v_fma_f32 v137, -v145, v168, v137\n\t" \
    "v_fma_f32 v138, -v145, v169, v138\n\t" \
    "v_fma_f32 v139, -v145, v170, v139\n\t" \
    "v_fma_f32 v140, -v145, v171, v140\n\t" \
    "v_fma_f32 %0, %0, v172, v137\n\t" \
    "v_fma_f32 %1, %1, v173, v138\n\t" \
    "v_fma_f32 %2, %2, v174, v139\n\t" \
    "v_fma_f32 %3, %3, v175, v140\n\t" \
    "v_mul_f32 v137, v206, v198\n\t" \
    "v_mul_f32 v138, v206, v199\n\t" \
    "v_mul_f32 v139, v206, v200\n\t" \
    "v_mul_f32 v140, v206, v201\n\t" \
    "v_mul_f32 v145, %0, v186\n\t" \
    "v_mul_f32 v146, %1, v187\n\t" \
    "v_fma_f32 v145, %2, v188, v145\n\t" \
    "v_fma_f32 v146, %3, v189, v146\n\t" \
    "v_add_f32 v145, v145, v146\n\t" \
    "ds_read_b128 v[230:233], %6 offset:4608\n\t" \
    "ds_read_b128 v[234:237], %6 offset:4864\n\t" \
    "ds_read_b128 v[238:241], %6 offset:5120\n\t" \
    "ds_read_b128 v[242:245], %6 offset:5376\n\t" \
    "ds_read_b128 v[246:249], %6 offset:5632\n\t" \
    "ds_read_b32 v250, %7 offset:4608\n\t" \
    "s_waitcnt lgkmcnt(6)\n\t" \
    "v_add_f32_dpp v145, v145, v145 quad_perm:[1,0,3,2] row_mask:0xf bank_mask:0xf bound_ctrl:1\n\t" \
    "v_mul_f32 v148, %0, v180\n\t" \
    "v_mul_f32 v146, %1, v181\n\t" \
    "v_add_f32_dpp v145, v145, v145 quad_perm:[2,3,0,1] row_mask:0xf bank_mask:0xf bound_ctrl:1\n\t" \
    "v_fma_f32 v148, %2, v182, v148\n\t" \
    "v_fma_f32 v146, %3, v183, v146\n\t" \
    "v_add_f32_dpp v145, v145, v145 row_half_mirror row_mask:0xf bank_mask:0xf bound_ctrl:1\n\t" \
    "v_add_f32 v148, v148, v146\n\t" \
    "s_nop 0\n\t" \
    "v_add_f32_dpp v145, v145, v145 row_mirror row_mask:0xf bank_mask:0xf bound_ctrl:1\n\t" \
    "v_fma_f32 v137, -v145, v190, v137\n\t" \
    "v_fma_f32 v138, -v145, v191, v138\n\t" \
    "v_fma_f32 v139, -v145, v192, v139\n\t" \
    "v_fma_f32 v140, -v145, v193, v140\n\t" \
    "v_fma_f32 %0, %0, v194, v137\n\t" \
    "v_fma_f32 %1, %1, v195, v138\n\t" \
    "v_fma_f32 %2, %2, v196, v139\n\t" \
    "v_fma_f32 %3, %3, v197, v140\n\t" \
    "v_mul_f32 v137, v228, v220\n\t" \
    "v_mul_f32 v138, v228, v221\n\t" \
    "v_mul_f32 v139, v228, v222\n\t" \
    "v_mul_f32 v140, v228, v223\n\t" \
    "v_mul_f32 v145, %0, v208\n\t" \
    "v_mul_f32 v146, %1, v209\n\t" \
    "v_fma_f32 v145, %2, v210, v145\n\t" \
    "v_fma_f32 v146, %3, v211, v146\n\t" \
    "v_add_f32 v145, v145, v146\n\t" \
    "ds_read_b128 v[164:167], %6 offset:6144\n\t" \
    "ds_read_b128 v[168:171], %6 offset:6400\n\t" \
    "ds_read_b128 v[172:175], %6 offset:6656\n\t" \
    "ds_read_b128 v[176:179], %6 offset:6912\n\t" \
    "ds_read_b128 v[180:183], %6 offset:7168\n\t" \
    "ds_read_b32 v184, %7 offset:6144\n\t" \
    "s_waitcnt lgkmcnt(6)\n\t" \
    "v_add_f32_dpp v145, v145, v145 quad_perm:[1,0,3,2] row_mask:0xf bank_mask:0xf bound_ctrl:1\n\t" \
    "v_mul_f32 v149, %0, v202\n\t" \
    "v_mul_f32 v146, %1, v203\n\t" \
    "v_add_f32_dpp v145, v145, v145 quad_perm:[2,3,0,1] row_mask:0xf bank_mask:0xf bound_ctrl:1\n\t" \
    "v_fma_f32 v149, %2, v204, v149\n\t" \
    "v_fma_f32 v146, %3, v205, v146\n\t" \
    "v_add_f32_dpp v145, v145, v145 row_half_mirror row_mask:0xf bank_mask:0xf bound_ctrl:1\n\t" \
    "v_add_f32 v149, v149, v146\n\t" \
    "s_nop 0\n\t" \
    "v_add_f32_dpp v145, v145, v145 row_mirror row_mask:0xf bank_mask:0xf bound_ctrl:1\n\t" \
    "v_fma_f32 v137, -v145, v212, v137\n\t" \
    "v_fma_f32 v138, -v145, v213, v138\n\t" \
    "v_fma_f32 v139, -v145, v214, v139\n\t" \
    "v_fma_f32 v140, -v145, v215, v140\n\t" \
    "v_fma_f32 %0, %0, v216, v137\n\t" \
    "v_fma_f32 %1, %1, v217, v138\n\t" \
    "v_fma_f32 %2, %2, v218, v139\n\t" \
    "v_fma_f32 %3, %3, v219, v140\n\t" \
    "v_mul_f32 v137, v250, v242\n\t" \
    "v_mul_f32 v138, v250, v243\n\t" \
    "v_mul_f32 v139, v250, v244\n\t" \
    "v_mul_f32 v140, v250, v245\n\t" \
    "v_mul_f32 v145, %0, v230\n\t" \
    "v_mul_f32 v146, %1, v231\n\t" \
    "v_fma_f32 v145, %2, v232, v145\n\t" \
    "v_fma_f32 v146, %3, v233, v146\n\t" \
    "v_add_f32 v145, v145, v146\n\t" \
    "ds_read_b128 v[186:189], %6 offset:7680\n\t" \
    "ds_read_b128 v[190:193], %6 offset:7936\n\t" \
    "ds_read_b128 v[194:197], %6 offset:8192\n\t" \
    "ds_read_b128 v[198:201], %6 offset:8448\n\t" \
    "ds_read_b128 v[202:205], %6 offset:8704\n\t" \
    "ds_read_b32 v206, %7 offset:7680\n\t" \
    "s_waitcnt lgkmcnt(6)\n\t" \
    "v_add_f32_dpp v145, v145, v145 quad_perm:[1,0,3,2] row_mask:0xf bank_mask:0xf bound_ctrl:1\n\t" \
    "v_mul_f32 v150, %0, v224\n\t" \
    "v_mul_f32 v146, %1, v225\n\t" \
    "v_add_f32_dpp v145, v145, v145 quad_perm:[2,3,0,1] row_mask:0xf bank_mask:0xf bound_ctrl:1\n\t" \
    "v_fma_f32 v150, %2, v226, v150\n\t" \
    "v_fma_f32 v146, %3, v227, v146\n\t" \
    "v_add_f32_dpp v145, v145, v145 row_half_mirror row_mask:0xf bank_mask:0xf bound_ctrl:1\n\t" \
    "v_add_f32 v150, v150, v146\n\t" \
    "s_nop 0\n\t" \
    "v_add_f32_dpp v145, v145, v145 row_mirror row_mask:0xf bank_mask:0xf bound_ctrl:1\n\t" \
    "v_fma_f32 v137, -v145, v234, v137\n\t" \
    "v_fma_f32 v138, -v145, v235, v138\n\t" \
    "v_fma_f32 v139, -v145, v236, v139\n\t" \
    "v_fma_f32 v140, -v145, v237, v140\n\t" \
    "v_fma_f32 %0, %0, v238, v137\n\t" \
    "v_fma_f32 %1, %1, v239, v138\n\t" \
    "v_fma_f32 %2, %2, v240, v139\n\t" \
    "v_fma_f32 %3, %3, v241, v140\n\t" \
    "v_mul_f32 v137, v184, v176\n\t" \
    "v_mul_f32 v138, v184, v177\n\t" \
    "v_mul_f32 v139, v184, v178\n\t" \
    "v_mul_f32 v140, v184, v179\n\t" \
    "v_mul_f32 v145, %0, v164\n\t" \
    "v_mul_f32 v146, %1, v165\n\t" \
    "v_fma_f32 v145, %2, v166, v145\n\t" \
    "v_fma_f32 v146, %3, v167, v146\n\t" \
    "v_add_f32 v145, v145, v146\n\t" \
    "ds_read_b128 v[208:211], %6 offset:9216\n\t" \
    "ds_read_b128 v[212:215], %6 offset:9472\n\t" \
    "ds_read_b128 v[216:219], %6 offset:9728\n\t" \
    "ds_read_b128 v[220:223], %6 offset:9984\n\t" \
    "ds_read_b128 v[224:227], %6 offset:10240\n\t" \
    "ds_read_b32 v228, %7 offset:9216\n\t" \
    "s_waitcnt lgkmcnt(6)\n\t" \
    "v_add_f32_dpp v145, v145, v145 quad_perm:[1,0,3,2] row_mask:0xf bank_mask:0xf bound_ctrl:1\n\t" \
    "v_mul_f32 v151, %0, v246\n\t" \
    "v_mul_f32 v146, %1, v247\n\t" \
    "v_add_f32_dpp v145, v145, v145 quad_perm:[2,3,0,1] row_mask:0xf bank_mask:0xf bound_ctrl:1\n\t" \
    "v_fma_f32 v151, %2, v248, v151\n\t" \
    "v_fma_f32 v146, %3, v249, v146\n\t" \
    "v_add_f32_dpp v145, v145, v145 row_half_mirror row_mask:0xf bank_mask:0xf bound_ctrl:1\n\t" \
    "v_add_f32 v151, v151, v146\n\t" \
    "s_nop 0\n\t" \
    "v_add_f32_dpp v145, v145, v145 row_mirror row_mask:0xf bank_mask:0xf bound_ctrl:1\n\t" \
    "v_fma_f32 v137, -v145, v168, v137\n\t" \
    "v_fma_f32 v138, -v145, v169, v138\n\t" \
    "v_fma_f32 v139, -v145, v170, v139\n\t" \
    "v_fma_f32 v140, -v145, v171, v140\n\t" \
    "v_fma_f32 %0, %0, v172, v137\n\t" \
    "v_fma_f32 %1, %1, v173, v138\n\t" \
    "v_fma_f32 %2, %2, v174, v139\n\t" \
    "v_fma_f32 %3, %3, v175, v140\n\t" \
    "v_mul_f32 v137, v206, v198\n\t" \
    "v_mul_f32 v138, v206, v199\n\t" \
    "v_mul_f32 v139, v206, v200\n\t" \
    "v_mul_f32 v140, v206, v201\n\t" \
    "v_mul_f32 v145, %0, v186\n\t" \
    "v_mul_f32 v146, %1, v187\n\t" \
    "v_fma_f32 v145, %2, v188, v145\n\t" \
    "v_fma_f32 v146, %3, v189, v146\n\t" \
    "v_add_f32 v145, v145, v146\n\t" \
    "ds_read_b128 v[230:233], %6 offset:10752\n\t" \
    "ds_read_b128 v[234:237], %6 offset:11008\n\t" \
    "ds_read_b128 v[238:241], %6 offset:11264\n\t" \
    "ds_read_b128 v[242:245], %6 offset:11520\n\t" \
    "ds_read_b128 v[246:249], %6 offset:11776\n\t" \
    "ds_read_b32 v250, %7 offset:10752\n\t" \
    "s_waitcnt lgkmcnt(6)\n\t" \
    "v_add_f32_dpp v145, v145, v145 quad_perm:[1,0,3,2] row_mask:0xf bank_mask:0xf bound_ctrl:1\n\t" \
    "v_mul_f32 v152, %0, v180\n\t" \
    "v_mul_f32 v146, %1, v181\n\t" \
    "v_add_f32_dpp v145, v145, v145 quad_perm:[2,3,0,1] row_mask:0xf bank_mask:0xf bound_ctrl:1\n\t" \
    "v_fma_f32 v152, %2, v182, v152\n\t" \
    "v_fma_f32 v146, %3, v183, v146\n\t" \
    "v_add_f32_dpp v145, v145, v145 row_half_mirror row_mask:0xf bank_mask:0xf bound_ctrl:1\n\t" \
    "v_add_f32 v152, v152, v146\n\t" \
    "s_nop 0\n\t" \
    "v_add_f32_dpp v145, v145, v145 row_mirror row_mask:0xf bank_mask:0xf bound_ctrl:1\n\t" \
    "v_fma_f32 v137, -v145, v190, v137\n\t" \
    "v_fma_f32 v138, -v145, v191, v138\n\t" \
    "v_fma_f32 v139, -v145, v192, v139\n\t" \
    "v_fma_f32 v140, -v145, v193, v140\n\t" \
    "v_fma_f32 %0, %0, v194, v137\n\t" \
    "v_fma_f32 %1, %1, v195, v138\n\t" \
    "v_fma_f32 %2, %2, v196, v139\n\t" \
    "v_fma_f32 %3, %3, v197, v140\n\t" \
    "v_mul_f32 v137, v228, v220\n\t" \
    "v_mul_f32 v138, v228, v221\n\t" \
    "v_mul_f32 v139, v228, v222\n\t" \
    "v_mul_f32 v140, v228, v223\n\t" \
    "v_mul_f32 v145, %0, v208\n\t" \
    "v_mul_f32 v146, %1, v209\n\t" \
    "v_fma_f32 v145, %2, v210, v145\n\t" \
    "v_fma_f32 v146, %3, v211, v146\n\t" \
    "v_add_f32 v145, v145, v146\n\t" \
    "ds_read_b128 v[164:167], %6 offset:12288\n\t" \
    "ds_read_b128 v[168:171], %6 offset:12544\n\t" \
    "ds_read_b128 v[172:175], %6 offset:12800\n\t" \
    "ds_read_b128 v[176:179], %6 offset:13056\n\t" \
    "ds_read_b128 v[180:183], %6 offset:13312\n\t" \
    "ds_read_b32 v184, %7 offset:12288\n\t" \
    "s_waitcnt lgkmcnt(6)\n\t" \
    "v_add_f32_dpp v145, v145, v145 quad_perm:[1,0,3,2] row_mask:0xf bank_mask:0xf bound_ctrl:1\n\t" \
    "v_mul_f32 v153, %0, v202\n\t" \
    "v_mul_f32 v146, %1, v203\n\t" \
    "v_add_f32_dpp v145, v145, v145 quad_perm:[2,3,0,1] row_mask:0xf bank_mask:0xf bound_ctrl:1\n\t" \
    "v_fma_f32 v153, %2, v204, v153\n\t" \
    "v_fma_f32 v146, %3, v205, v146\n\t" \
    "v_add_f32_dpp v145, v145, v145 row_half_mirror row_mask:0xf bank_mask:0xf bound_ctrl:1\n\t" \
    "v_add_f32 v153, v153, v146\n\t" \
    "s_nop 0\n\t" \
    "v_add_f32_dpp v145, v145, v145 row_mirror row_mask:0xf bank_mask:0xf bound_ctrl:1\n\t" \
    "v_fma_f32 v137, -v145, v212, v137\n\t" \
    "v_fma_f32 v138, -v145, v213, v138\n\t" \
    "v_fma_f32 v139, -v145, v214, v139\n\t" \
    "v_fma_f32 v140, -v145, v215, v140\n\t" \
    "v_fma_f32 %0, %0, v216, v137\n\t" \
    "v_fma_f32 %1, %1, v217, v138\n\t" \
    "v_fma_f32 %2, %2, v218, v139\n\t" \
    "v_fma_f32 %3, %3, v219, v140\n\t" \
    "v_mul_f32 v137, v250, v242\n\t" \
    "v_mul_f32 v138, v250, v243\n\t" \
    "v_mul_f32 v139, v250, v244\n\t" \
    "v_mul_f32 v140, v250, v245\n\t" \
    "v_mul_f32 v145, %0, v230\n\t" \
    "v_mul_f32 v146, %1, v231\n\t" \
    "v_fma_f32 v145, %2, v232, v145\n\t" \
    "v_fma_f32 v146, %3, v233, v146\n\t" \
    "v_add_f32 v145, v145, v146\n\t" \
    "ds_read_b128 v[186:189], %6 offset:13824\n\t" \
    "ds_read_b128 v[190:193], %6 offset:14080\n\t" \
    "ds_read_b128 v[194:197], %6 offset:14336\n\t" \
    "ds_read_b128 v[198:201], %6 offset:14592\n\t" \
    "ds_read_b128 v[202:205], %6 offset:14848\n\t" \
    "ds_read_b32 v206, %7 offset:13824\n\t" \
    "s_waitcnt lgkmcnt(6)\n\t" \
    "v_add_f32_dpp v145, v145, v145 quad_perm:[1,0,3,2] row_mask:0xf bank_mask:0xf bound_ctrl:1\n\t" \
    "v_mul_f32 v154, %0, v224\n\t" \
    "v_mul_f32 v146, %1, v225\n\t" \
    "v_add_f32_dpp v145, v145, v145 quad_perm:[2,3,0,1] row_mask:0xf bank_mask:0xf bound_ctrl:1\n\t" \
    "v_fma_f32 v154, %2, v226, v154\n\t" \
    "v_fma_f32 v146, %3, v227, v146\n\t" \
    "v_add_f32_dpp v145, v145, v145 row_half_mirror row_mask:0xf bank_mask:0xf bound_ctrl:1\n\t" \
    "v_add_f32 v154, v154, v146\n\t" \
    "s_nop 0\n\t" \
    "v_add_f32_dpp v145, v145, v145 row_mirror row_mask:0xf bank_mask:0xf bound_ctrl:1\n\t" \
    "v_fma_f32 v137, -v145, v234, v137\n\t" \
    "v_fma_f32 v138, -v145, v235, v138\n\t" \
    "v_fma_f32 v139, -v145, v236, v139\n\t" \
    "v_fma_f32 v140, -v145, v237, v140\n\t" \
    "v_fma_f32 %0, %0, v238, v137\n\t" \
    "v_fma_f32 %1, %1, v239, v138\n\t" \
    "v_fma_f32 %2, %2, v240, v139\n\t" \
    "v_fma_f32 %3, %3, v241, v140\n\t" \
    "v_mul_f32 v137, v184, v176\n\t" \
    "v_mul_f32 v138, v184, v177\n\t" \
    "v_mul_f32 v139, v184, v178\n\t" \
    "v_mul_f32 v140, v184, v179\n\t" \
    "v_mul_f32 v145, %0, v164\n\t" \
    "v_mul_f32 v146, %1, v165\n\t" \
    "v_fma_f32 v145, %2, v166, v145\n\t" \
    "v_fma_f32 v146, %3, v167, v146\n\t" \
    "v_add_f32 v145, v145, v146\n\t" \
    "ds_read_b128 v[208:211], %6 offset:15360\n\t" \
    "ds_read_b128 v[212:215], %6 offset:15616\n\t" \
    "ds_read_b128 v[216:219], %6 offset:15872\n\t" \
    "ds_read_b128 v[220:223], %6 offset:16128\n\t" \
    "ds_read_b128 v[224:227], %6 offset:16384\n\t" \
    "ds_read_b32 v228, %7 offset:15360\n\t" \
    "s_waitcnt lgkmcnt(6)\n\t" \
    "v_add_f32_dpp v145, v145, v145 quad_perm:[1,0,3,2] row_mask:0xf bank_mask:0xf bound_ctrl:1\n\t" \
    "v_mul_f32 v155, %0, v246\n\t" \
    "v_mul_f32 v146, %1, v247\n\t" \
    "v_add_f32_dpp v145, v145, v145 quad_perm:[2,3,0,1] row_mask:0xf bank_mask:0xf bound_ctrl:1\n\t" \
    "v_fma_f32 v155, %2, v248, v155\n\t" \
    "v_fma_f32 v146, %3, v249, v146\n\t" \
    "v_add_f32_dpp v145, v145, v145 row_half_mirror row_mask:0xf bank_mask:0xf bound_ctrl:1\n\t" \
    "v_add_f32 v155, v155, v146\n\t" \
    "s_nop 0\n\t" \
    "v_add_f32_dpp v145, v145, v145 row_mirror row_mask:0xf bank_mask:0xf bound_ctrl:1\n\t" \
    "v_fma_f32 v137, -v145, v168, v137\n\t" \
    "v_fma_f32 v138, -v145, v169, v138\n\t" \
    "v_fma_f32 v139, -v145, v170, v139\n\t" \
    "v_fma_f32 v140, -v145, v171, v140\n\t" \
    "v_fma_f32 %0, %0, v172, v137\n\t" \
    "v_fma_f32 %1, %1, v173, v138\n\t" \
    "v_fma_f32 %2, %2, v174, v139\n\t" \
    "v_fma_f32 %3, %3, v175, v140\n\t" \
    "v_mul_f32 v137, v206, v198\n\t" \
    "v_mul_f32 v138, v206, v199\n\t" \
    "v_mul_f32 v139, v206, v200\n\t" \
    "v_mul_f32 v140, v206, v201\n\t" \
    "v_mul_f32 v145, %0, v186\n\t" \
    "v_mul_f32 v146, %1, v187\n\t" \
    "v_fma_f32 v145, %2, v188, v145\n\t" \
    "v_fma_f32 v146, %3, v189, v146\n\t" \
    "v_add_f32 v145, v145, v146\n\t" \
    "ds_read_b128 v[230:233], %6 offset:16896\n\t" \
    "ds_read_b128 v[234:237], %6 offset:17152\n\t" \
    "ds_read_b128 v[238:241], %6 offset:17408\n\t" \
    "ds_read_b128 v[242:245], %6 offset:17664\n\t" \
    "ds_read_b128 v[246:249], %6 offset:17920\n\t" \
    "ds_read_b32 v250, %7 offset:16896\n\t" \
    "s_waitcnt lgkmcnt(6)\n\t" \
    "v_add_f32_dpp v145, v145, v145 quad_perm:[1,0,3,2] row_mask:0xf bank_mask:0xf bound_ctrl:1\n\t" \
    "v_mul_f32 v156, %0, v180\n\t" \
    "v_mul_f32 v146, %1, v181\n\t" \
    "v_add_f32_dpp v145, v145, v145 quad_perm:[2,3,0,1] row_mask:0xf bank_mask:0xf bound_ctrl:1\n\t" \
    "v_fma_f32 v156, %2, v182, v156\n\t" \
    "v_fma_f32 v146, %3, v183, v146\n\t" \
    "v_add_f32_dpp v145, v145, v145 row_half_mirror row_mask:0xf bank_mask:0xf bound_ctrl:1\n\t" \
    "v_add_f32 v156, v156, v146\n\t" \
    "s_nop 0\n\t" \
    "v_add_f32_dpp v145, v145, v145 row_mirror row_mask:0xf bank_mask:0xf bound_ctrl:1\n\t" \
    "v_fma_f32 v137, -v145, v190, v137\n\t" \
    "v_fma_f32 v138, -v145, v191, v138\n\t" \
    "v_fma_f32 v139, -v145, v192, v139\n\t" \
    "v_fma_f32 v140, -v145, v193, v140\n\t" \
    "v_fma_f32 %0, %0, v194, v137\n\t" \
    "v_fma_f32 %1, %1, v195, v138\n\t" \
    "v_fma_f32 %2, %2, v196, v139\n\t" \
    "v_fma_f32 %3, %3, v197, v140\n\t" \
    "v_mul_f32 v137, v228, v220\n\t" \
    "v_mul_f32 v138, v228, v221\n\t" \
    "v_mul_f32 v139, v228, v222\n\t" \
    "v_mul_f32 v140, v228, v223\n\t" \
    "v_mul_f32 v145, %0, v208\n\t" \
    "v_mul_f32 v146, %1, v209\n\t" \
    "v_fma_f32 v145, %2, v210, v145\n\t" \
    "v_fma_f32 v146, %3, v211, v146\n\t" \
    "v_add_f32 v145, v145, v146\n\t" \
    "ds_read_b128 v[164:167], %6 offset:18432\n\t" \
    "ds_read_b128 v[168:171], %6 offset:18688\n\t" \
    "ds_read_b128 v[172:175], %6 offset:18944\n\t" \
    "ds_read_b128 v[176:179], %6 offset:19200\n\t" \
    "ds_read_b128 v[180:183], %6 offset:19456\n\t" \
    "ds_read_b32 v184, %7 offset:18432\n\t" \
    "s_waitcnt lgkmcnt(6)\n\t" \
    "v_add_f32_dpp v145, v145, v145 quad_perm:[1,0,3,2] row_mask:0xf bank_mask:0xf bound_ctrl:1\n\t" \
    "v_mul_f32 v157, %0, v202\n\t" \
    "v_mul_f32 v146, %1, v203\n\t" \
    "v_add_f32_dpp v145, v145, v145 quad_perm:[2,3,0,1] row_mask:0xf bank_mask:0xf bound_ctrl:1\n\t" \
    "v_fma_f32 v157, %2, v204, v157\n\t" \
    "v_fma_f32 v146, %3, v205, v146\n\t" \
    "v_add_f32_dpp v145, v145, v145 row_half_mirror row_mask:0xf bank_mask:0xf bound_ctrl:1\n\t" \
    "v_add_f32 v157, v157, v146\n\t" \
    "s_nop 0\n\t" \
    "v_add_f32_dpp v145, v145, v145 row_mirror row_mask:0xf bank_mask:0xf bound_ctrl:1\n\t" \
    "v_fma_f32 v137, -v145, v212, v137\n\t" \
    "v_fma_f32 v138, -v145, v213, v138\n\t" \
    "v_fma_f32 v139, -v145, v214, v139\n\t" \
    "v_fma_f32 v140, -v145, v215, v140\n\t" \
    "v_fma_f32 %0, %0, v216, v137\n\t" \
    "v_fma_f32 %1, %1, v217, v138\n\t" \
    "v_fma_f32 %2, %2, v218, v139\n\t" \
    "v_fma_f32 %3, %3, v219, v140\n\t" \
    "v_mul_f32 v137, v250, v242\n\t" \
    "v_mul_f32 v138, v250, v243\n\t" \
    "v_mul_f32 v139, v250, v244\n\t" \
    "v_mul_f32 v140, v250, v245\n\t" \
    "v_mul_f32 v145, %0, v230\n\t" \
    "v_mul_f32 v146, %1, v231\n\t" \
    "v_fma_f32 v145, %2, v232, v145\n\t" \
    "v_fma_f32 v146, %3, v233, v146\n\t" \
    "v_add_f32 v145, v145, v146\n\t" \
    "ds_read_b128 v[186:189], %6 offset:19968\n\t" \
    "ds_read_b128 v[190:193], %6 offset:20224\n\t" \
    "ds_read_b128 v[194:197], %6 offset:20480\n\t" \
    "ds_read_b128 v[198:201], %6 offset:20736\n\t" \
    "ds_read_b128 v[202:205], %6 offset:20992\n\t" \
    "ds_read_b32 v206, %7 offset:19968\n\t" \
    "s_waitcnt lgkmcnt(6)\n\t" \
    "v_add_f32_dpp v145, v145, v145 quad_perm:[1,0,3,2] row_mask:0xf bank_mask:0xf bound_ctrl:1\n\t" \
    "v_mul_f32 v158, %0, v224\n\t" \
    "v_mul_f32 v146, %1, v225\n\t" \
    "v_add_f32_dpp v145, v145, v145 quad_perm:[2,3,0,1] row_mask:0xf bank_mask:0xf bound_ctrl:1\n\t" \
    "v_fma_f32 v158, %2, v226, v158\n\t" \
    "v_fma_f32 v146, %3, v227, v146\n\t" \
    "v_add_f32_dpp v145, v145, v145 row_half_mirror row_mask:0xf bank_mask:0xf bound_ctrl:1\n\t" \
    "v_add_f32 v158, v158, v146\n\t" \
    "s_nop 0\n\t" \
    "v_add_f32_dpp v145, v145, v145 row_mirror row_mask:0xf bank_mask:0xf bound_ctrl:1\n\t" \
    "v_fma_f32 v137, -v145, v234, v137\n\t" \
    "v_fma_f32 v138, -v145, v235, v138\n\t" \
    "v_fma_f32 v139, -v145, v236, v139\n\t" \
    "v_fma_f32 v140, -v145, v237, v140\n\t" \
    "v_fma_f32 %0, %0, v238, v137\n\t" \
    "v_fma_f32 %1, %1, v239, v138\n\t" \
    "v_fma_f32 %2, %2, v240, v139\n\t" \
    "v_fma_f32 %3, %3, v241, v140\n\t" \
    "v_mul_f32 v137, v184, v176\n\t" \
    "v_mul_f32 v138, v184, v177\n\t" \
    "v_mul_f32 v139, v184, v178\n\t" \
    "v_mul_f32 v140, v184, v179\n\t" \
    "v_mul_f32 v145, %0, v164\n\t" \
    "v_mul_f32 v146, %1, v165\n\t" \
    "v_fma_f32 v145, %2, v166, v145\n\t" \
    "v_fma_f32 v146, %3, v167, v146\n\t" \
    "v_add_f32 v145, v145, v146\n\t" \
    "ds_read_b128 v[208:211], %6 offset:21504\n\t" \
    "ds_read_b128 v[212:215], %6 offset:21760\n\t" \
    "ds_read_b128 v[216:219], %6 offset:22016\n\t" \
    "ds_read_b128 v[220:223], %6 offset:22272\n\t" \
    "ds_read_b128 v[224:227], %6 offset:22528\n\t" \
    "ds_read_b32 v228, %7 offset:21504\n\t" \
    "s_waitcnt lgkmcnt(6)\n\t" \
    "v_add_f32_dpp v145, v145, v145 quad_perm:[1,0,3,2] row_mask:0xf bank_mask:0xf bound_ctrl:1\n\t" \
    "v_mul_f32 v159, %0, v246\n\t" \
    "v_mul_f32 v146, %1, v247\n\t" \
    "v_add_f32_dpp v145, v145, v145 quad_perm:[2,3,0,1] row_mask:0xf bank_mask:0xf bound_ctrl:1\n\t" \
    "v_fma_f32 v159, %2, v248, v159\n\t" \
    "v_fma_f32 v146, %3, v249, v146\n\t" \
    "v_add_f32_dpp v145, v145, v145 row_half_mirror row_mask:0xf bank_mask:0xf bound_ctrl:1\n\t" \
    "v_add_f32 v159, v159, v146\n\t" \
    "s_nop 0\n\t" \
    "v_add_f32_dpp v145, v145, v145 row_mirror row_mask:0xf bank_mask:0xf bound_ctrl:1\n\t" \
    "v_fma_f32 v137, -v145, v168, v137\n\t" \
    "v_fma_f32 v138, -v145, v169, v138\n\t" \
    "v_fma_f32 v139, -v145, v170, v139\n\t" \
    "v_fma_f32 v140, -v145, v171, v140\n\t" \
    "v_fma_f32 %0, %0, v172, v137\n\t" \
    "v_fma_f32 %1, %1, v173, v138\n\t" \
    "v_fma_f32 %2, %2, v174, v139\n\t" \
    "v_fma_f32 %3, %3, v175, v140\n\t" \
    "v_mul_f32 v137, v206, v198\n\t" \
    "v_mul_f32 v138, v206, v199\n\t" \
    "v_mul_f32 v139, v206, v200\n\t" \
    "v_mul_f32 v140, v206, v201\n\t" \
    "v_mul_f32 v145, %0, v186\n\t" \
    "v_mul_f32 v146, %1, v187\n\t" \
    "v_fma_f32 v145, %2, v188, v145\n\t" \
    "v_fma_f32 v146, %3, v189, v146\n\t" \
    "v_add_f32 v145, v145, v146\n\t" \
    "ds_read_b128 v[230:233], %6 offset:23040\n\t" \
    "ds_read_b128 v[234:237], %6 offset:23296\n\t" \
    "ds_read_b128 v[238:241], %6 offset:23552\n\t" \
    "ds_read_b128 v[242:245], %6 offset:23808\n\t" \
    "ds_read_b128 v[246:249], %6 offset:24064\n\t" \
    "ds_read_b32 v250, %7 offset:23040\n\t" \
    "s_waitcnt lgkmcnt(6)\n\t" \
    "v_add_f32_dpp v145, v145, v145 quad_perm:[1,0,3,2] row_mask:0xf bank_mask:0xf bound_ctrl:1\n\t" \
    "v_mul_f32 v160, %0, v180\n\t" \
    "v_mul_f32 v146, %1, v181\n\t" \
    "v_add_f32_dpp v145, v145, v145 quad_perm:[2,3,0,1] row_mask:0xf bank_mask:0xf bound_ctrl:1\n\t" \
    "v_fma_f32 v160, %2, v182, v160\n\t" \
    "v_fma_f32 v146, %3, v183, v146\n\t" \
    "v_add_f32_dpp v145, v145, v145 row_half_mirror row_mask:0xf bank_mask:0xf bound_ctrl:1\n\t" \
    "v_add_f32 v160, v160, v146\n\t" \
    "s_nop 0\n\t" \
    "v_add_f32_dpp v145, v145, v145 row_mirror row_mask:0xf bank_mask:0xf bound_ctrl:1\n\t" \
    "v_fma_f32 v137, -v145, v190, v137\n\t" \
    "v_fma_f32 v138, -v145, v191, v138\n\t" \
    "v_fma_f32 v139, -v145, v192, v139\n\t" \
    "v_fma_f32 v140, -v145, v193, v140\n\t" \
    "v_fma_f32 %0, %0, v194, v137\n\t" \
    "v_fma_f32 %1, %1, v195, v138\n\t" \
    "v_fma_f32 %2, %2, v196, v139\n\t" \
    "v_fma_f32 %3, %3, v197, v140\n\t" \
    "v_mul_f32 v137, v228, v220\n\t" \
    "v_mul_f32 v138, v228, v221\n\t" \
    "v_mul_f32 v139, v228, v222\n\t" \
    "v_mul_f32 v140, v228, v223\n\t" \
    "v_mul_f32 v145, %0, v208\n\t" \
    "v_mul_f32 v146, %1, v209\n\t" \
    "v_fma_f32 v145, %2, v210, v145\n\t" \
    "v_fma_f32 v146, %3, v211, v146\n\t" \
    "v_add_f32 v145, v145, v146\n\t" \
    "ds_read_b128 v[164:167], %6 offset:24576\n\t" \
    "ds_read_b128 v[168:171], %6 offset:24832\n\t" \
    "ds_read_b128 v[172:175], %6 offset:25088\n\t" \
    "ds_read_b128 v[176:179], %6 offset:25344\n\t" \
    "ds_read_b128 v[180:183], %6 offset:25600\n\t" \
    "ds_read_b32 v184, %7 offset:24576\n\t" \
    "s_waitcnt lgkmcnt(6)\n\t" \
    "v_add_f32_dpp v145, v145, v145 quad_perm:[1,0,3,2] row_mask:0xf bank_mask:0xf bound_ctrl:1\n\t" \
    "v_mul_f32 v161, %0, v202\n\t" \
    "v_mul_f32 v146, %1, v203\n\t" \
    "v_add_f32_dpp v145, v145, v145 quad_perm:[2,3,0,1] row_mask:0xf bank_mask:0xf bound_ctrl:1\n\t" \
    "v_fma_f32 v161, %2, v204, v161\n\t" \
    "v_fma_f32 v146, %3, v205, v146\n\t" \
    "v_add_f32_dpp v145, v145, v145 row_half_mirror row_mask:0xf bank_mask:0xf bound_ctrl:1\n\t" \
    "v_add_f32 v161, v161, v146\n\t" \
    "s_nop 0\n\t" \
    "v_add_f32_dpp v145, v145, v145 row_mirror row_mask:0xf bank_mask:0xf bound_ctrl:1\n\t" \
    "v_fma_f32 v137, -v145, v212, v137\n\t" \
    "v_fma_f32 v138, -v145, v213, v138\n\t" \
    "v_fma_f32 v139, -v145, v214, v139\n\t" \
    "v_fma_f32 v140, -v145, v215, v140\n\t" \
    "v_fma_f32 %0, %0, v216, v137\n\t" \
    "v_fma_f32 %1, %1, v217, v138\n\t" \
    "v_fma_f32 %2, %2, v218, v139\n\t" \
    "v_fma_f32 %3, %3, v219, v140\n\t" \
    "v_mul_f32 v137, v250, v242\n\t" \
    "v_mul_f32 v138, v250, v243\n\t" \
    "v_mul_f32 v139, v250, v244\n\t" \
    "v_mul_f32 v140, v250, v245\n\t" \
    "v_mul_f32 v145, %0, v230\n\t" \
    "v_mul_f32 v146, %1, v231\n\t" \
    "v_fma_f32 v145, %2, v232, v145\n\t" \
    "v_fma_f32 v146, %3, v233, v146\n\t" \
    "v_add_f32 v145, v145, v146\n\t" \
    "ds_read_b128 v[186:189], %6 offset:26112\n\t" \
    "ds_read_b128 v[190:193], %6 offset:26368\n\t" \
    "ds_read_b128 v[194:197], %6 offset:26624\n\t" \
    "ds_read_b128 v[198:201], %6 offset:26880\n\t" \
    "ds_read_b128 v[202:205], %6 offset:27136\n\t" \
    "ds_read_b32 v206, %7 offset:26112\n\t" \
    "s_waitcnt lgkmcnt(6)\n\t" \
    "v_add_f32_dpp v145, v145, v145 quad_perm:[1,0,3,2] row_mask:0xf bank_mask:0xf bound_ctrl:1\n\t" \
    "v_mul_f32 v162, %0, v224\n\t" \
    "v_mul_f32 v146, %1, v225\n\t" \
    "v_add_f32_dpp v145, v145, v145 quad_perm:[2,3,0,1] row_mask:0xf bank_mask:0xf bound_ctrl:1\n\t" \
    "v_fma_f32 v162, %2, v226, v162\n\t" \
    "v_fma_f32 v146, %3, v227, v146\n\t" \
    "v_add_f32_dpp v145, v145, v145 row_half_mirror row_mask:0xf bank_mask:0xf bound_ctrl:1\n\t" \
    "v_add_f32 v162, v162, v146\n\t" \
    "s_nop 0\n\t" \
    "v_add_f32_dpp v145, v145, v145 row_mirror row_mask:0xf bank_mask:0xf bound_ctrl:1\n\t" \
    "v_fma_f32 v137, -v145, v234, v137\n\t" \
    "v_fma_f32 v138, -v145, v235, v138\n\t" \
    "v_fma_f32 v139, -v145, v236, v139\n\t" \
    "v_fma_f32 v140, -v145, v237, v140\n\t" \
    "v_fma_f32 %0, %0, v238, v137\n\t" \
    "v_fma_f32 %1, %1, v239, v138\n\t" \
    "v_fma_f32 %2, %2, v240, v139\n\t" \
    "v_fma_f32 %3, %3, v241, v140\n\t" \
    "v_mul_f32 v137, v184, v176\n\t" \
    "v_mul_f32 v138, v184, v177\n\t" \
    "v_mul_f32 v139, v184, v178\n\t" \
    "v_mul_f32 v140, v184, v179\n\t" \
    "v_mul_f32 v145, %0, v164\n\t" \
    "v_mul_f32 v146, %1, v165\n\t" \
    "v_fma_f32 v145, %2, v166, v145\n\t" \
    "v_fma_f32 v146, %3, v167, v146\n\t" \
    "v_add_f32 v145, v145, v146\n\t" \
    "ds_read_b128 v[208:211], %6 offset:27648\n\t" \
    "ds_read_b128 v[212:215], %6 offset:27904\n\t" \
    "ds_read_b128 v[216:219], %6 offset:28160\n\t" \
    "ds_read_b128 v[220:223], %6 offset:28416\n\t" \
    "ds_read_b128 v[224:227], %6 offset:28672\n\t" \
    "ds_read_b32 v228, %7 offset:27648\n\t" \
    "s_waitcnt lgkmcnt(6)\n\t" \
    "v_add_f32_dpp v145, v145, v145 quad_perm:[1,0,3,2] row_mask:0xf bank_mask:0xf bound_ctrl:1\n\t" \
    "v_mul_f32 v163, %0, v246\n\t" \
    "v_mul_f32 v146, %1, v247\n\t" \
    "v_add_f32_dpp v145, v145, v145 quad_perm:[2,3,0,1] row_mask:0xf bank_mask:0xf bound_ctrl:1\n\t" \
    "v_fma_f32 v163, %2, v248, v163\n\t" \
    "v_fma_f32 v146, %3, v249, v146\n\t" \
    "v_add_f32_dpp v145, v145, v145 row_half_mirror row_mask:0xf bank_mask:0xf bound_ctrl:1\n\t" \
    "v_add_f32 v163, v163, v146\n\t" \
    "s_nop 0\n\t" \
    "v_add_f32_dpp v145, v145, v145 row_mirror row_mask:0xf bank_mask:0xf bound_ctrl:1\n\t" \
    "v_fma_f32 v137, -v145, v168, v137\n\t" \
    "v_fma_f32 v138, -v145, v169, v138\n\t" \
    "v_fma_f32 v139, -v145, v170, v139\n\t" \
    "v_fma_f32 v140, -v145, v171, v140\n\t" \
    "v_fma_f32 %0, %0, v172, v137\n\t" \
    "v_fma_f32 %1, %1, v173, v138\n\t" \
    "v_fma_f32 %2, %2, v174, v139\n\t" \
    "v_fma_f32 %3, %3, v175, v140\n\t" \
    "v_mul_f32 v137, v206, v198\n\t" \
    "v_mul_f32 v138, v206, v199\n\t" \
    "v_mul_f32 v139, v206, v200\n\t" \
    "v_mul_f32 v140, v206, v201\n\t" \
    "v_mul_f32 v145, %0, v186\n\t" \
    "v_mul_f32 v146, %1, v187\n\t" \
    "v_fma_f32 v145, %2, v188, v145\n\t" \
    "v_fma_f32 v146, %3, v189, v146\n\t" \
    "v_add_f32 v145, v145, v146\n\t" \
    "v_and_b32 v244, 8, %8\n\t" \
    "v_cmp_ne_u32 vcc, 0, v244\n\t" \
    "v_cndmask_b32 v244, v156, v148, vcc\n\t" \
    "v_cndmask_b32 v245, v157, v149, vcc\n\t" \
    "v_cndmask_b32 v246, v158, v150, vcc\n\t" \
    "v_cndmask_b32 v247, v159, v151, vcc\n\t" \
    "v_cndmask_b32 v230, v148, v156, vcc\n\t" \
    "v_cndmask_b32 v231, v149, v157, vcc\n\t" \
    "v_cndmask_b32 v232, v150, v158, vcc\n\t" \
    "v_cndmask_b32 v233, v151, v159, vcc\n\t" \
    "v_add_f32_dpp v230, v244, v230 row_mirror row_mask:0xf bank_mask:0xf bound_ctrl:1\n\t" \
    "v_add_f32_dpp v231, v245, v231 row_mirror row_mask:0xf bank_mask:0xf bound_ctrl:1\n\t" \
    "v_add_f32_dpp v232, v246, v232 row_mirror row_mask:0xf bank_mask:0xf bound_ctrl:1\n\t" \
    "v_add_f32_dpp v233, v247, v233 row_mirror row_mask:0xf bank_mask:0xf bound_ctrl:1\n\t" \
    "v_cndmask_b32 v244, v160, v152, vcc\n\t" \
    "v_cndmask_b32 v245, v161, v153, vcc\n\t" \
    "v_cndmask_b32 v246, v162, v154, vcc\n\t" \
    "v_cndmask_b32 v247, v163, v155, vcc\n\t" \
    "v_cndmask_b32 v234, v152, v160, vcc\n\t" \
    "v_cndmask_b32 v235, v153, v161, vcc\n\t" \
    "v_cndmask_b32 v236, v154, v162, vcc\n\t" \
    "v_cndmask_b32 v237, v155, v163, vcc\n\t" \
    "v_add_f32_dpp v234, v244, v234 row_mirror row_mask:0xf bank_mask:0xf bound_ctrl:1\n\t" \
    "v_add_f32_dpp v235, v245, v235 row_mirror row_mask:0xf bank_mask:0xf bound_ctrl:1\n\t" \
    "v_add_f32_dpp v236, v246, v236 row_mirror row_mask:0xf bank_mask:0xf bound_ctrl:1\n\t" \
    "v_add_f32_dpp v237, v247, v237 row_mirror row_mask:0xf bank_mask:0xf bound_ctrl:1\n\t" \
    "v_and_b32 v244, 4, %8\n\t" \
    "v_cmp_ne_u32 vcc, 0, v244\n\t" \
    "v_cndmask_b32 v244, v234, v230, vcc\n\t" \
    "v_cndmask_b32 v245, v235, v231, vcc\n\t" \
    "v_cndmask_b32 v246, v236, v232, vcc\n\t" \
    "v_cndmask_b32 v247, v237, v233, vcc\n\t" \
    "v_cndmask_b32 v238, v230, v234, vcc\n\t" \
    "v_cndmask_b32 v239, v231, v235, vcc\n\t" \
    "v_cndmask_b32 v240, v232, v236, vcc\n\t" \
    "v_cndmask_b32 v241, v233, v237, vcc\n\t" \
    "v_add_f32_dpp v238, v244, v238 row_half_mirror row_mask:0xf bank_mask:0xf bound_ctrl:1\n\t" \
    "v_add_f32_dpp v239, v245, v239 row_half_mirror row_mask:0xf bank_mask:0xf bound_ctrl:1\n\t" \
    "v_add_f32_dpp v240, v246, v240 row_half_mirror row_mask:0xf bank_mask:0xf bound_ctrl:1\n\t" \
    "v_add_f32_dpp v241, v247, v241 row_half_mirror row_mask:0xf bank_mask:0xf bound_ctrl:1\n\t" \
    "v_and_b32 v244, 2, %8\n\t" \
    "v_cmp_ne_u32 vcc, 0, v244\n\t" \
    "v_cndmask_b32 v244, v240, v238, vcc\n\t" \
    "v_cndmask_b32 v245, v241, v239, vcc\n\t" \
    "v_cndmask_b32 v242, v238, v240, vcc\n\t" \
    "v_cndmask_b32 v243, v239, v241, vcc\n\t" \
    "v_add_f32_dpp v242, v244, v242 quad_perm:[2,3,0,1] row_mask:0xf bank_mask:0xf bound_ctrl:1\n\t" \
    "v_add_f32_dpp v243, v245, v243 quad_perm:[2,3,0,1] row_mask:0xf bank_mask:0xf bound_ctrl:1\n\t" \
    "v_and_b32 v244, 1, %8\n\t" \
    "v_cmp_ne_u32 vcc, 0, v244\n\t" \
    "v_cndmask_b32 v244, v243, v242, vcc\n\t" \
    "v_cndmask_b32 v245, v242, v243, vcc\n\t" \
    "s_nop 0\n\t" \
    "v_add_f32_dpp %4, v244, v245 quad_perm:[1,0,3,2] row_mask:0xf bank_mask:0xf bound_ctrl:1\n\t" \
    "ds_read_b128 v[230:233], %6 offset:29184\n\t" \
    "ds_read_b128 v[234:237], %6 offset:29440\n\t" \
    "ds_read_b128 v[238:241], %6 offset:29696\n\t" \
    "ds_read_b128 v[242:245], %6 offset:29952\n\t" \
    "ds_read_b128 v[246:249], %6 offset:30208\n\t" \
    "ds_read_b32 v250, %7 offset:29184\n\t" \
    "s_waitcnt lgkmcnt(6)\n\t" \
    "v_add_f32_dpp v145, v145, v145 quad_perm:[1,0,3,2] row_mask:0xf bank_mask:0xf bound_ctrl:1\n\t" \
    "v_mul_f32 v148, %0, v180\n\t" \
    "v_mul_f32 v146, %1, v181\n\t" \
    "v_add_f32_dpp v145, v145, v145 quad_perm:[2,3,0,1] row_mask:0xf bank_mask:0xf bound_ctrl:1\n\t" \
    "v_fma_f32 v148, %2, v182, v148\n\t" \
    "v_fma_f32 v146, %3, v183, v146\n\t" \
    "v_add_f32_dpp v145, v145, v145 row_half_mirror row_mask:0xf bank_mask:0xf bound_ctrl:1\n\t" \
    "v_add_f32 v148, v148, v146\n\t" \
    "s_nop 0\n\t" \
    "v_add_f32_dpp v145, v145, v145 row_mirror row_mask:0xf bank_mask:0xf bound_ctrl:1\n\t" \
    "v_fma_f32 v137, -v145, v190, v137\n\t" \
    "v_fma_f32 v138, -v145, v191, v138\n\t" \
    "v_fma_f32 v139, -v145, v192, v139\n\t" \
    "v_fma_f32 v140, -v145, v193, v140\n\t" \
    "v_fma_f32 %0, %0, v194, v137\n\t" \
    "v_fma_f32 %1, %1, v195, v138\n\t" \
    "v_fma_f32 %2, %2, v196, v139\n\t" \
    "v_fma_f32 %3, %3, v197, v140\n\t" \
    "v_mul_f32 v137, v228, v220\n\t" \
    "v_mul_f32 v138, v228, v221\n\t" \
    "v_mul_f32 v139, v228, v222\n\t" \
    "v_mul_f32 v140, v228, v223\n\t" \
    "v_mul_f32 v145, %0, v208\n\t" \
    "v_mul_f32 v146, %1, v209\n\t" \
    "v_fma_f32 v145, %2, v210, v145\n\t" \
    "v_fma_f32 v146, %3, v211, v146\n\t" \
    "v_add_f32 v145, v145, v146\n\t" \
    "ds_read_b128 v[164:167], %6 offset:30720\n\t" \
    "ds_read_b128 v[168:171], %6 offset:30976\n\t" \
    "ds_read_b128 v[172:175], %6 offset:31232\n\t" \
    "ds_read_b128 v[176:179], %6 offset:31488\n\t" \
    "ds_read_b128 v[180:183], %6 offset:31744\n\t" \
    "ds_read_b32 v184, %7 offset:30720\n\t" \
    "s_waitcnt lgkmcnt(6)\n\t" \
    "v_add_f32_dpp v145, v145, v145 quad_perm:[1,0,3,2] row_mask:0xf bank_mask:0xf bound_ctrl:1\n\t" \
    "v_mul_f32 v149, %0, v202\n\t" \
    "v_mul_f32 v146, %1, v203\n\t" \
    "v_add_f32_dpp v145, v145, v145 quad_perm:[2,3,0,1] row_mask:0xf bank_mask:0xf bound_ctrl:1\n\t" \
    "v_fma_f32 v149, %2, v204, v149\n\t" \
    "v_fma_f32 v146, %3, v205, v146\n\t" \
    "v_add_f32_dpp v145, v145, v145 row_half_mirror row_mask:0xf bank_mask:0xf bound_ctrl:1\n\t" \
    "v_add_f32 v149, v149, v146\n\t" \
    "s_nop 0\n\t" \
    "v_add_f32_dpp v145, v145, v145 row_mirror row_mask:0xf bank_mask:0xf bound_ctrl:1\n\t" \
    "v_fma_f32 v137, -v145, v212, v137\n\t" \
    "v_fma_f32 v138, -v145, v213, v138\n\t" \
    "v_fma_f32 v139, -v145, v214, v139\n\t" \
    "v_fma_f32 v140, -v145, v215, v140\n\t" \
    "v_fma_f32 %0, %0, v216, v137\n\t" \
    "v_fma_f32 %1, %1, v217, v138\n\t" \
    "v_fma_f32 %2, %2, v218, v139\n\t" \
    "v_fma_f32 %3, %3, v219, v140\n\t" \
    "v_mul_f32 v137, v250, v242\n\t" \
    "v_mul_f32 v138, v250, v243\n\t" \
    "v_mul_f32 v139, v250, v244\n\t" \
    "v_mul_f32 v140, v250, v245\n\t" \
    "v_mul_f32 v145, %0, v230\n\t" \
    "v_mul_f32 v146, %1, v231\n\t" \
    "v_fma_f32 v145, %2, v232, v145\n\t" \
    "v_fma_f32 v146, %3, v233, v146\n\t" \
    "v_add_f32 v145, v145, v146\n\t" \
    "ds_read_b128 v[186:189], %6 offset:32256\n\t" \
    "ds_read_b128 v[190:193], %6 offset:32512\n\t" \
    "ds_read_b128 v[194:197], %6 offset:32768\n\t" \
    "ds_read_b128 v[198:201], %6 offset:33024\n\t" \
    "ds_read_b128 v[202:205], %6 offset:33280\n\t" \
    "ds_read_b32 v206, %7 offset:32256\n\t" \
    "s_waitcnt lgkmcnt(6)\n\t" \
    "v_add_f32_dpp v145, v145, v145 quad_perm:[1,0,3,2] row_mask:0xf bank_mask:0xf bound_ctrl:1\n\t" \
    "v_mul_f32 v150, %0, v224\n\t" \
    "v_mul_f32 v146, %1, v225\n\t" \
    "v_add_f32_dpp v145, v145, v145 quad_perm:[2,3,0,1] row_mask:0xf bank_mask:0xf bound_ctrl:1\n\t" \
    "v_fma_f32 v150, %2, v226, v150\n\t" \
    "v_fma_f32 v146, %3, v227, v146\n\t" \
    "v_add_f32_dpp v145, v145, v145 row_half_mirror row_mask:0xf bank_mask:0xf bound_ctrl:1\n\t" \
    "v_add_f32 v150, v150, v146\n\t" \
    "s_nop 0\n\t" \
    "v_add_f32_dpp v145, v145, v145 row_mirror row_mask:0xf bank_mask:0xf bound_ctrl:1\n\t" \
    "v_fma_f32 v137, -v145, v234, v137\n\t" \
    "v_fma_f32 v138, -v145, v235, v138\n\t" \
    "v_fma_f32 v139, -v145, v236, v139\n\t" \
    "v_fma_f32 v140, -v145, v237, v140\n\t" \
    "v_fma_f32 %0, %0, v238, v137\n\t" \
    "v_fma_f32 %1, %1, v239, v138\n\t" \
    "v_fma_f32 %2, %2, v240, v139\n\t" \
    "v_fma_f32 %3, %3, v241, v140\n\t" \
    "v_mul_f32 v137, v184, v176\n\t" \
    "v_mul_f32 v138, v184, v177\n\t" \
    "v_mul_f32 v139, v184, v178\n\t" \
    "v_mul_f32 v140, v184, v179\n\t" \
    "v_mul_f32 v145, %0, v164\n\t" \
    "v_mul_f32 v146, %1, v165\n\t" \
    "v_fma_f32 v145, %2, v166, v145\n\t" \
    "v_fma_f32 v146, %3, v167, v146\n\t" \
    "v_add_f32 v145, v145, v146\n\t" \
    "ds_read_b128 v[208:211], %6 offset:33792\n\t" \
    "ds_read_b128 v[212:215], %6 offset:34048\n\t" \
    "ds_read_b128 v[216:219], %6 offset:34304\n\t" \
    "ds_read_b128 v[220:223], %6 offset:34560\n\t" \
    "ds_read_b128 v[224:227], %6 offset:34816\n\t" \
    "ds_read_b32 v228, %7 offset:33792\n\t" \
    "s_waitcnt lgkmcnt(6)\n\t" \
    "v_add_f32_dpp v145, v145, v145 quad_perm:[1,0,3,2] row_mask:0xf bank_mask:0xf bound_ctrl:1\n\t" \
    "v_mul_f32 v151, %0, v246\n\t" \
    "v_mul_f32 v146, %1, v247\n\t" \
    "v_add_f32_dpp v145, v145, v145 quad_perm:[2,3,0,1] row_mask:0xf bank_mask:0xf bound_ctrl:1\n\t" \
    "v_fma_f32 v151, %2, v248, v151\n\t" \
    "v_fma_f32 v146, %3, v249, v146\n\t" \
    "v_add_f32_dpp v145, v145, v145 row_half_mirror row_mask:0xf bank_mask:0xf bound_ctrl:1\n\t" \
    "v_add_f32 v151, v151, v146\n\t" \
    "s_nop 0\n\t" \
    "v_add_f32_dpp v145, v145, v145 row_mirror row_mask:0xf bank_mask:0xf bound_ctrl:1\n\t" \
    "v_fma_f32 v137, -v145, v168, v137\n\t" \
    "v_fma_f32 v138, -v145, v169, v138\n\t" \
    "v_fma_f32 v139, -v145, v170, v139\n\t" \
    "v_fma_f32 v140, -v145, v171, v140\n\t" \
    "v_fma_f32 %0, %0, v172, v137\n\t" \
    "v_fma_f32 %1, %1, v173, v138\n\t" \
    "v_fma_f32 %2, %2, v174, v139\n\t" \
    "v_fma_f32 %3, %3, v175, v140\n\t" \
    "v_mul_f32 v137, v206, v198\n\t" \
    "v_mul_f32 v138, v206, v199\n\t" \
    "v_mul_f32 v139, v206, v200\n\t" \
    "v_mul_f32 v140, v206, v201\n\t" \
    "v_mul_f32 v145, %0, v186\n\t" \
    "v_mul_f32 v146, %1, v187\n\t" \
    "v_fma_f32 v145, %2, v188, v145\n\t" \
    "v_fma_f32 v146, %3, v189, v146\n\t" \
    "v_add_f32 v145, v145, v146\n\t" \
    "ds_read_b128 v[230:233], %6 offset:35328\n\t" \
    "ds_read_b128 v[234:237], %6 offset:35584\n\t" \
    "ds_read_b128 v[238:241], %6 offset:35840\n\t" \
    "ds_read_b128 v[242:245], %6 offset:36096\n\t" \
    "ds_read_b128 v[246:249], %6 offset:36352\n\t" \
    "ds_read_b32 v250, %7 offset:35328\n\t" \
    "s_waitcnt lgkmcnt(6)\n\t" \
    "v_add_f32_dpp v145, v145, v145 quad_perm:[1,0,3,2] row_mask:0xf bank_mask:0xf bound_ctrl:1\n\t" \
    "v_mul_f32 v152, %0, v180\n\t" \
    "v_mul_f32 v146, %1, v181\n\t" \
    "v_add_f32_dpp v145, v145, v145 quad_perm:[2,3,0,1] row_mask:0xf bank_mask:0xf bound_ctrl:1\n\t" \
    "v_fma_f32 v152, %2, v182, v152\n\t" \
    "v_fma_f32 v146, %3, v183, v146\n\t" \
    "v_add_f32_dpp v145, v145, v145 row_half_mirror row_mask:0xf bank_mask:0xf bound_ctrl:1\n\t" \
    "v_add_f32 v152, v152, v146\n\t" \
    "s_nop 0\n\t" \
    "v_add_f32_dpp v145, v145, v145 row_mirror row_mask:0xf bank_mask:0xf bound_ctrl:1\n\t" \
    "v_fma_f32 v137, -v145, v190, v137\n\t" \
    "v_fma_f32 v138, -v145, v191, v138\n\t" \
    "v_fma_f32 v139, -v145, v192, v139\n\t" \
    "v_fma_f32 v140, -v145, v193, v140\n\t" \
    "v_fma_f32 %0, %0, v194, v137\n\t" \
    "v_fma_f32 %1, %1, v195, v138\n\t" \
    "v_fma_f32 %2, %2, v196, v139\n\t" \
    "v_fma_f32 %3, %3, v197, v140\n\t" \
    "v_mul_f32 v137, v228, v220\n\t" \
    "v_mul_f32 v138, v228, v221\n\t" \
    "v_mul_f32 v139, v228, v222\n\t" \
    "v_mul_f32 v140, v228, v223\n\t" \
    "v_mul_f32 v145, %0, v208\n\t" \
    "v_mul_f32 v146, %1, v209\n\t" \
    "v_fma_f32 v145, %2, v210, v145\n\t" \
    "v_fma_f32 v146, %3, v211, v146\n\t" \
    "v_add_f32 v145, v145, v146\n\t" \
    "ds_read_b128 v[164:167], %6 offset:36864\n\t" \
    "ds_read_b128 v[168:171], %6 offset:37120\n\t" \
    "ds_read_b128 v[172:175], %6 offset:37376\n\t" \
    "ds_read_b128 v[176:179], %6 offset:37632\n\t" \
    "ds_read_b128 v[180:183], %6 offset:37888\n\t" \
    "ds_read_b32 v184, %7 offset:36864\n\t" \
    "s_waitcnt lgkmcnt(6)\n\t" \
    "v_add_f32_dpp v145, v145, v145 quad_perm:[1,0,3,2] row_mask:0xf bank_mask:0xf bound_ctrl:1\n\t" \
    "v_mul_f32 v153, %0, v202\n\t" \
    "v_mul_f32 v146, %1, v203\n\t" \
    "v_add_f32_dpp v145, v145, v145 quad_perm:[2,3,0,1] row_mask:0xf bank_mask:0xf bound_ctrl:1\n\t" \
    "v_fma_f32 v153, %2, v204, v153\n\t" \
    "v_fma_f32 v146, %3, v205, v146\n\t" \
    "v_add_f32_dpp v145, v145, v145 row_half_mirror row_mask:0xf bank_mask:0xf bound_ctrl:1\n\t" \
    "v_add_f32 v153, v153, v146\n\t" \
    "s_nop 0\n\t" \
    "v_add_f32_dpp v145, v145, v145 row_mirror row_mask:0xf bank_mask:0xf bound_ctrl:1\n\t" \
    "v_fma_f32 v137, -v145, v212, v137\n\t" \
    "v_fma_f32 v138, -v145, v213, v138\n\t" \
    "v_fma_f32 v139, -v145, v214, v139\n\t" \
    "v_fma_f32 v140, -v145, v215, v140\n\t" \
    "v_fma_f32 %0, %0, v216, v137\n\t" \
    "v_fma_f32 %1, %1, v217, v138\n\t" \
    "v_fma_f32 %2, %2, v218, v139\n\t" \
    "v_fma_f32 %3, %3, v219, v140\n\t" \
    "v_mul_f32 v137, v250, v242\n\t" \
    "v_mul_f32 v138, v250, v243\n\t" \
    "v_mul_f32 v139, v250, v244\n\t" \
    "v_mul_f32 v140, v250, v245\n\t" \
    "v_mul_f32 v145, %0, v230\n\t" \
    "v_mul_f32 v146, %1, v231\n\t" \
    "v_fma_f32 v145, %2, v232, v145\n\t" \
    "v_fma_f32 v146, %3, v233, v146\n\t" \
    "v_add_f32 v145, v145, v146\n\t" \
    "ds_read_b128 v[186:189], %6 offset:38400\n\t" \
    "ds_read_b128 v[190:193], %6 offset:38656\n\t" \
    "ds_read_b128 v[194:197], %6 offset:38912\n\t" \
    "ds_read_b128 v[198:201], %6 offset:39168\n\t" \
    "ds_read_b128 v[202:205], %6 offset:39424\n\t" \
    "ds_read_b32 v206, %7 offset:38400\n\t" \
    "s_waitcnt lgkmcnt(6)\n\t" \
    "v_add_f32_dpp v145, v145, v145 quad_perm:[1,0,3,2] row_mask:0xf bank_mask:0xf bound_ctrl:1\n\t" \
    "v_mul_f32 v154, %0, v224\n\t" \
    "v_mul_f32 v146, %1, v225\n\t" \
    "v_add_f32_dpp v145, v145, v145 quad_perm:[2,3,0,1] row_mask:0xf bank_mask:0xf bound_ctrl:1\n\t" \
    "v_fma_f32 v154, %2, v226, v154\n\t" \
    "v_fma_f32 v146, %3, v227, v146\n\t" \
    "v_add_f32_dpp v145, v145, v145 row_half_mirror row_mask:0xf bank_mask:0xf bound_ctrl:1\n\t" \
    "v_add_f32 v154, v154, v146\n\t" \
    "s_nop 0\n\t" \
    "v_add_f32_dpp v145, v145, v145 row_mirror row_mask:0xf bank_mask:0xf bound_ctrl:1\n\t" \
    "v_fma_f32 v137, -v145, v234, v137\n\t" \
    "v_fma_f32 v138, -v145, v235, v138\n\t" \
    "v_fma_f32 v139, -v145, v236, v139\n\t" \
    "v_fma_f32 v140, -v145, v237, v140\n\t" \
    "v_fma_f32 %0, %0, v238, v137\n\t" \
    "v_fma_f32 %1, %1, v239, v138\n\t" \
    "v_fma_f32 %2, %2, v240, v139\n\t" \
    "v_fma_f32 %3, %3, v241, v140\n\t" \
    "v_mul_f32 v137, v184, v176\n\t" \
    "v_mul_f32 v138, v184, v177\n\t" \
    "v_mul_f32 v139, v184, v178\n\t" \
    "v_mul_f32 v140, v184, v179\n\t" \
    "v_mul_f32 v145, %0, v164\n\t" \
    "v_mul_f32 v146, %1, v165\n\t" \
    "v_fma_f32 v145, %2, v166, v145\n\t" \
    "v_fma_f32 v146, %3, v167, v146\n\t" \
    "v_add_f32 v145, v145, v146\n\t" \
    "ds_read_b128 v[208:211], %6 offset:39936\n\t" \
    "ds_read_b128 v[212:215], %6 offset:40192\n\t" \
    "ds_read_b128 v[216:219], %6 offset:40448\n\t" \
    "ds_read_b128 v[220:223], %6 offset:40704\n\t" \
    "ds_read_b128 v[224:227], %6 offset:40960\n\t" \
    "ds_read_b32 v228, %7 offset:39936\n\t" \
    "s_waitcnt lgkmcnt(6)\n\t" \
    "v_add_f32_dpp v145, v145, v145 quad_perm:[1,0,3,2] row_mask:0xf bank_mask:0xf bound_ctrl:1\n\t" \
    "v_mul_f32 v155, %0, v246\n\t" \
    "v_mul_f32 v146, %1, v247\n\t" \
    "v_add_f32_dpp v145, v145, v145 quad_perm:[2,3,0,1] row_mask:0xf bank_mask:0xf bound_ctrl:1\n\t" \
    "v_fma_f32 v155, %2, v248, v155\n\t" \
    "v_fma_f32 v146, %3, v249, v146\n\t" \
    "v_add_f32_dpp v145, v145, v145 row_half_mirror row_mask:0xf bank_mask:0xf bound_ctrl:1\n\t" \
    "v_add_f32 v155, v155, v146\n\t" \
    "s_nop 0\n\t" \
    "v_add_f32_dpp v145, v145, v145 row_mirror row_mask:0xf bank_mask:0xf bound_ctrl:1\n\t" \
    "v_fma_f32 v137, -v145, v168, v137\n\t" \
    "v_fma_f32 v138, -v145, v169, v138\n\t" \
    "v_fma_f32 v139, -v145, v170, v139\n\t" \
    "v_fma_f32 v140, -v145, v171, v140\n\t" \
    "v_fma_f32 %0, %0, v172, v137\n\t" \
    "v_fma_f32 %1, %1, v173, v138\n\t" \
    "v_fma_f32 %2, %2, v174, v139\n\t" \
    "v_fma_f32 %3, %3, v175, v140\n\t" \
    "v_mul_f32 v137, v206, v198\n\t" \
    "v_mul_f32 v138, v206, v199\n\t" \
    "v_mul_f32 v139, v206, v200\n\t" \
    "v_mul_f32 v140, v206, v201\n\t" \
    "v_mul_f32 v145, %0, v186\n\t" \
    "v_mul_f32 v146, %1, v187\n\t" \
    "v_fma_f32 v145, %2, v188, v145\n\t" \
    "v_fma_f32 v146, %3, v189, v146\n\t" \
    "v_add_f32 v145, v145, v146\n\t" \
    "ds_read_b128 v[230:233], %6 offset:41472\n\t" \
    "ds_read_b128 v[234:237], %6 offset:41728\n\t" \
    "ds_read_b128 v[238:241], %6 offset:41984\n\t" \
    "ds_read_b128 v[242:245], %6 offset:42240\n\t" \
    "ds_read_b128 v[246:249], %6 offset:42496\n\t" \
    "ds_read_b32 v250, %7 offset:41472\n\t" \
    "s_waitcnt lgkmcnt(6)\n\t" \
    "v_add_f32_dpp v145, v145, v145 quad_perm:[1,0,3,2] row_mask:0xf bank_mask:0xf bound_ctrl:1\n\t" \
    "v_mul_f32 v156, %0, v180\n\t" \
    "v_mul_f32 v146, %1, v181\n\t" \
    "v_add_f32_dpp v145, v145, v145 quad_perm:[2,3,0,1] row_mask:0xf bank_mask:0xf bound_ctrl:1\n\t" \
    "v_fma_f32 v156, %2, v182, v156\n\t" \
    "v_fma_f32 v146, %3, v183, v146\n\t" \
    "v_add_f32_dpp v145, v145, v145 row_half_mirror row_mask:0xf bank_mask:0xf bound_ctrl:1\n\t" \
    "v_add_f32 v156, v156, v146\n\t" \
    "s_nop 0\n\t" \
    "v_add_f32_dpp v145, v145, v145 row_mirror row_mask:0xf bank_mask:0xf bound_ctrl:1\n\t" \
    "v_fma_f32 v137, -v145, v190, v137\n\t" \
    "v_fma_f32 v138, -v145, v191, v138\n\t" \
    "v_fma_f32 v139, -v145, v192, v139\n\t" \
    "v_fma_f32 v140, -v145, v193, v140\n\t" \
    "v_fma_f32 %0, %0, v194, v137\n\t" \
    "v_fma_f32 %1, %1, v195, v138\n\t" \
    "v_fma_f32 %2, %2, v196, v139\n\t" \
    "v_fma_f32 %3, %3, v197, v140\n\t" \
    "v_mul_f32 v137, v228, v220\n\t" \
    "v_mul_f32 v138, v228, v221\n\t" \
    "v_mul_f32 v139, v228, v222\n\t" \
    "v_mul_f32 v140, v228, v223\n\t" \
    "v_mul_f32 v145, %0, v208\n\t" \
    "v_mul_f32 v146, %1, v209\n\t" \
    "v_fma_f32 v145, %2, v210, v145\n\t" \
    "v_fma_f32 v146, %3, v211, v146\n\t" \
    "v_add_f32 v145, v145, v146\n\t" \
    "ds_read_b128 v[164:167], %6 offset:43008\n\t" \
    "ds_read_b128 v[168:171], %6 offset:43264\n\t" \
    "ds_read_b128 v[172:175], %6 offset:43520\n\t" \
    "ds_read_b128 v[176:179], %6 offset:43776\n\t" \
    "ds_read_b128 v[180:183], %6 offset:44032\n\t" \
    "ds_read_b32 v184, %7 offset:43008\n\t" \
    "s_waitcnt lgkmcnt(6)\n\t" \
    "v_add_f32_dpp v145, v145, v145 quad_perm:[1,0,3,2] row_mask:0xf bank_mask:0xf bound_ctrl:1\n\t" \
    "v_mul_f32 v157, %0, v202\n\t" \
    "v_mul_f32 v146, %1, v203\n\t" \
    "v_add_f32_dpp v145, v145, v145 quad_perm:[2,3,0,1] row_mask:0xf bank_mask:0xf bound_ctrl:1\n\t" \
    "v_fma_f32 v157, %2, v204, v157\n\t" \
    "v_fma_f32 v146, %3, v205, v146\n\t" \
    "v_add_f32_dpp v145, v145, v145 row_half_mirror row_mask:0xf bank_mask:0xf bound_ctrl:1\n\t" \
    "v_add_f32 v157, v157, v146\n\t" \
    "s_nop 0\n\t" \
    "v_add_f32_dpp v145, v145, v145 row_mirror row_mask:0xf bank_mask:0xf bound_ctrl:1\n\t" \
    "v_fma_f32 v137, -v145, v212, v137\n\t" \
    "v_fma_f32 v138, -v145, v213, v138\n\t" \
    "v_fma_f32 v139, -v145, v214, v139\n\t" \
    "v_fma_f32 v140, -v145, v215, v140\n\t" \
    "v_fma_f32 %0, %0, v216, v137\n\t" \
    "v_fma_f32 %1, %1, v217, v138\n\t" \
    "v_fma_f32 %2, %2, v218, v139\n\t" \
    "v_fma_f32 %3, %3, v219, v140\n\t" \
    "v_mul_f32 v137, v250, v242\n\t" \
    "v_mul_f32 v138, v250, v243\n\t" \
    "v_mul_f32 v139, v250, v244\n\t" \
    "v_mul_f32 v140, v250, v245\n\t" \
    "v_mul_f32 v145, %0, v230\n\t" \
    "v_mul_f32 v146, %1, v231\n\t" \
    "v_fma_f32 v145, %2, v232, v145\n\t" \
    "v_fma_f32 v146, %3, v233, v146\n\t" \
    "v_add_f32 v145, v145, v146\n\t" \
    "ds_read_b128 v[186:189], %6 offset:44544\n\t" \
    "ds_read_b128 v[190:193], %6 offset:44800\n\t" \
    "ds_read_b128 v[194:197], %6 offset:45056\n\t" \
    "ds_read_b128 v[198:201], %6 offset:45312\n\t" \
    "ds_read_b128 v[202:205], %6 offset:45568\n\t" \
    "ds_read_b32 v206, %7 offset:44544\n\t" \
    "s_waitcnt lgkmcnt(6)\n\t" \
    "v_add_f32_dpp v145, v145, v145 quad_perm:[1,0,3,2] row_mask:0xf bank_mask:0xf bound_ctrl:1\n\t" \
    "v_mul_f32 v158, %0, v224\n\t" \
    "v_mul_f32 v146, %1, v225\n\t" \
    "v_add_f32_dpp v145, v145, v145 quad_perm:[2,3,0,1] row_mask:0xf bank_mask:0xf bound_ctrl:1\n\t" \
    "v_fma_f32 v158, %2, v226, v158\n\t" \
    "v_fma_f32 v146, %3, v227, v146\n\t" \
    "v_add_f32_dpp v145, v145, v145 row_half_mirror row_mask:0xf bank_mask:0xf bound_ctrl:1\n\t" \
    "v_add_f32 v158, v158, v146\n\t" \
    "s_nop 0\n\t" \
    "v_add_f32_dpp v145, v145, v145 row_mirror row_mask:0xf bank_mask:0xf bound_ctrl:1\n\t" \
    "v_fma_f32 v137, -v145, v234, v137\n\t" \
    "v_fma_f32 v138, -v145, v235, v138\n\t" \
    "v_fma_f32 v139, -v145, v236, v139\n\t" \
    "v_fma_f32 v140, -v145, v237, v140\n\t" \
    "v_fma_f32 %0, %0, v238, v137\n\t" \
    "v_fma_f32 %1, %1, v239, v138\n\t" \
    "v_fma_f32 %2, %2, v240, v139\n\t" \
    "v_fma_f32 %3, %3, v241, v140\n\t" \
    "v_mul_f32 v137, v184, v176\n\t" \
    "v_mul_f32 v138, v184, v177\n\t" \
    "v_mul_f32 v139, v184, v178\n\t" \
    "v_mul_f32 v140, v184, v179\n\t" \
    "v_mul_f32 v145, %0, v164\n\t" \
    "v_mul_f32 v146, %1, v165\n\t" \
    "v_fma_f32 v145, %2, v166, v145\n\t" \
    "v_fma_f32 v146, %3, v167, v146\n\t" \
    "v_add_f32 v145, v145, v146\n\t" \
    "ds_read_b128 v[208:211], %6 offset:46080\n\t" \
    "ds_read_b128 v[212:215], %6 offset:46336\n\t" \
    "ds_read_b128 v[216:219], %6 offset:46592\n\t" \
    "ds_read_b128 v[220:223], %6 offset:46848\n\t" \
    "ds_read_b128 v[224:227], %6 offset:47104\n\t" \
    "ds_read_b32 v228, %7 offset:46080\n\t" \
    "s_waitcnt lgkmcnt(6)\n\t" \
    "v_add_f32_dpp v145, v145, v145 quad_perm:[1,0,3,2] row_mask:0xf bank_mask:0xf bound_ctrl:1\n\t" \
    "v_mul_f32 v159, %0, v246\n\t" \
    "v_mul_f32 v146, %1, v247\n\t" \
    "v_add_f32_dpp v145, v145, v145 quad_perm:[2,3,0,1] row_mask:0xf bank_mask:0xf bound_ctrl:1\n\t" \
    "v_fma_f32 v159, %2, v248, v159\n\t" \
    "v_fma_f32 v146, %3, v249, v146\n\t" \
    "v_add_f32_dpp v145, v145, v145 row_half_mirror row_mask:0xf bank_mask:0xf bound_ctrl:1\n\t" \
    "v_add_f32 v159, v159, v146\n\t" \
    "s_nop 0\n\t" \
    "v_add_f32_dpp v145, v145, v145 row_mirror row_mask:0xf bank_mask:0xf bound_ctrl:1\n\t" \
    "v_fma_f32 v137, -v145, v168, v137\n\t" \
    "v_fma_f32 v138, -v145, v169, v138\n\t" \
    "v_fma_f32 v139, -v145, v170, v139\n\t" \
    "v_fma_f32 v140, -v145, v171, v140\n\t" \
    "v_fma_f32 %0, %0, v172, v137\n\t" \
    "v_fma_f32 %1, %1, v173, v138\n\t" \
    "v_fma_f32 %2, %2, v174, v139\n\t" \
    "v_fma_f32 %3, %3, v175, v140\n\t" \
    "v_mul_f32 v137, v206, v198\n\t" \
    "v_mul_f32 v138, v206, v199\n\t" \
    "v_mul_f32 v139, v206, v200\n\t" \
    "v_mul_f32 v140, v206, v201\n\t" \
    "v_mul_f32 v145, %0, v186\n\t" \
    "v_mul_f32 v146, %1, v187\n\t" \
    "v_fma_f32 v145, %2, v188, v145\n\t" \
    "v_fma_f32 v146, %3, v189, v146\n\t" \
    "v_add_f32 v145, v145, v146\n\t" \
    "ds_read_b128 v[230:233], %6 offset:47616\n\t" \
    "ds_read_b128 v[234:237], %6 offset:47872\n\t" \
    "ds_read_b128 v[238:241], %6 offset:48128\n\t" \
    "ds_read_b128 v[242:245], %6 offset:48384\n\t" \
    "ds_read_b128 v[246:249], %6 offset:48640\n\t" \
    "ds_read_b32 v250, %7 offset:47616\n\t" \
    "s_waitcnt lgkmcnt(6)\n\t" \
    "v_add_f32_dpp v145, v145, v145 quad_perm:[1,0,3,2] row_mask:0xf bank_mask:0xf bound_ctrl:1\n\t" \
    "v_mul_f32 v160, %0, v180\n\t" \
    "v_mul_f32 v146, %1, v181\n\t" \
    "v_add_f32_dpp v145, v145, v145 quad_perm:[2,3,0,1] row_mask:0xf bank_mask:0xf bound_ctrl:1\n\t" \
    "v_fma_f32 v160, %2, v182, v160\n\t" \
    "v_fma_f32 v146, %3, v183, v146\n\t" \
    "v_add_f32_dpp v145, v145, v145 row_half_mirror row_mask:0xf bank_mask:0xf bound_ctrl:1\n\t" \
    "v_add_f32 v160, v160, v146\n\t" \
    "s_nop 0\n\t" \
    "v_add_f32_dpp v145, v145, v145 row_mirror row_mask:0xf bank_mask:0xf bound_ctrl:1\n\t" \
    "v_fma_f32 v137, -v145, v190, v137\n\t" \
    "v_fma_f32 v138, -v145, v191, v138\n\t" \
    "v_fma_f32 v139, -v145, v192, v139\n\t" \
    "v_fma_f32 v140, -v145, v193, v140\n\t" \
    "v_fma_f32 %0, %0, v194, v137\n\t" \
    "v_fma_f32 %1, %1, v195, v138\n\t" \
    "v_fma_f32 %2, %2, v196, v139\n\t" \
    "v_fma_f32 %3, %3, v197, v140\n\t" \
    "v_mul_f32 v137, v228, v220\n\t" \
    "v_mul_f32 v138, v228, v221\n\t" \
    "v_mul_f32 v139, v228, v222\n\t" \
    "v_mul_f32 v140, v228, v223\n\t" \
    "v_mul_f32 v145, %0, v208\n\t" \
    "v_mul_f32 v146, %1, v209\n\t" \
    "v_fma_f32 v145, %2, v210, v145\n\t" \
    "v_fma_f32 v146, %3, v211, v146\n\t" \
    "v_add_f32 v145, v145, v146\n\t" \
    "s_waitcnt lgkmcnt(0)\n\t" \
    "s_nop 1\n\t" \
    "v_add_f32_dpp v145, v145, v145 quad_perm:[1,0,3,2] row_mask:0xf bank_mask:0xf bound_ctrl:1\n\t" \
    "v_mul_f32 v161, %0, v202\n\t" \
    "v_mul_f32 v146, %1, v203\n\t" \
    "v_add_f32_dpp v145, v145, v145 quad_perm:[2,3,0,1] row_mask:0xf bank_mask:0xf bound_ctrl:1\n\t" \
    "v_fma_f32 v161, %2, v204, v161\n\t" \
    "v_fma_f32 v146, %3, v205, v146\n\t" \
    "v_add_f32_dpp v145, v145, v145 row_half_mirror row_mask:0xf bank_mask:0xf bound_ctrl:1\n\t" \
    "v_add_f32 v161, v161, v146\n\t" \
    "s_nop 0\n\t" \
    "v_add_f32_dpp v145, v145, v145 row_mirror row_mask:0xf bank_mask:0xf bound_ctrl:1\n\t" \
    "v_fma_f32 v137, -v145, v212, v137\n\t" \
    "v_fma_f32 v138, -v145, v213, v138\n\t" \
    "v_fma_f32 v139, -v145, v214, v139\n\t" \
    "v_fma_f32 v140, -v145, v215, v140\n\t" \
    "v_fma_f32 %0, %0, v216, v137\n\t" \
    "v_fma_f32 %1, %1, v217, v138\n\t" \
    "v_fma_f32 %2, %2, v218, v139\n\t" \
    "v_fma_f32 %3, %3, v219, v140\n\t" \
    "v_mul_f32 v137, v250, v242\n\t" \
    "v_mul_f32 v138, v250, v243\n\t" \
    "v_mul_f32 v139, v250, v244\n\t" \
    "v_mul_f32 v140, v250, v245\n\t" \
    "v_mul_f32 v145, %0, v230\n\t" \
    "v_mul_f32 v146, %1, v231\n\t" \
    "v_fma_f32 v145, %2, v232, v145\n\t" \
    "v_fma_f32 v146, %3, v233, v146\n\t" \
    "v_add_f32 v145, v145, v146\n\t" \
    "s_nop 1\n\t" \
    "v_add_f32_dpp v145, v145, v145 quad_perm:[1,0,3,2] row_mask:0xf bank_mask:0xf bound_ctrl:1\n\t" \
    "v_mul_f32 v162, %0, v224\n\t" \
    "v_mul_f32 v146, %1, v225\n\t" \
    "v_add_f32_dpp v145, v145, v145 quad_perm:[2,3,0,1] row_mask:0xf bank_mask:0xf bound_ctrl:1\n\t" \
    "v_fma_f32 v162, %2, v226, v162\n\t" \
    "v_fma_f32 v146, %3, v227, v146\n\t" \
    "v_add_f32_dpp v145, v145, v145 row_half_mirror row_mask:0xf bank_mask:0xf bound_ctrl:1\n\t" \
    "v_add_f32 v162, v162, v146\n\t" \
    "s_nop 0\n\t" \
    "v_add_f32_dpp v145, v145, v145 row_mirror row_mask:0xf bank_mask:0xf bound_ctrl:1\n\t" \
    "v_fma_f32 v137, -v145, v234, v137\n\t" \
    "v_fma_f32 v138, -v145, v235, v138\n\t" \
    "v_fma_f32 v139, -v145, v236, v139\n\t" \
    "v_fma_f32 v140, -v145, v237, v140\n\t" \
    "v_fma_f32 %0, %0, v238, v137\n\t" \
    "v_fma_f32 %1, %1, v239, v138\n\t" \
    "v_fma_f32 %2, %2, v240, v139\n\t" \
    "v_fma_f32 %3, %3, v241, v140\n\t" \
    "v_mul_f32 v163, %0, v246\n\t" \
    "v_mul_f32 v146, %1, v247\n\t" \
    "v_fma_f32 v163, %2, v248, v163\n\t" \
    "v_fma_f32 v146, %3, v249, v146\n\t" \
    "v_add_f32 v163, v163, v146\n\t" \
    "s_nop 0\n\t" \
    "v_and_b32 v244, 8, %8\n\t" \
    "v_cmp_ne_u32 vcc, 0, v244\n\t" \
    "v_cndmask_b32 v244, v156, v148, vcc\n\t" \
    "v_cndmask_b32 v245, v157, v149, vcc\n\t" \
    "v_cndmask_b32 v246, v158, v150, vcc\n\t" \
    "v_cndmask_b32 v247, v159, v151, vcc\n\t" \
    "v_cndmask_b32 v230, v148, v156, vcc\n\t" \
    "v_cndmask_b32 v231, v149, v157, vcc\n\t" \
    "v_cndmask_b32 v232, v150, v158, vcc\n\t" \
    "v_cndmask_b32 v233, v151, v159, vcc\n\t" \
    "v_add_f32_dpp v230, v244, v230 row_mirror row_mask:0xf bank_mask:0xf bound_ctrl:1\n\t" \
    "v_add_f32_dpp v231, v245, v231 row_mirror row_mask:0xf bank_mask:0xf bound_ctrl:1\n\t" \
    "v_add_f32_dpp v232, v246, v232 row_mirror row_mask:0xf bank_mask:0xf bound_ctrl:1\n\t" \
    "v_add_f32_dpp v233, v247, v233 row_mirror row_mask:0xf bank_mask:0xf bound_ctrl:1\n\t" \
    "v_cndmask_b32 v244, v160, v152, vcc\n\t" \
    "v_cndmask_b32 v245, v161, v153, vcc\n\t" \
    "v_cndmask_b32 v246, v162, v154, vcc\n\t" \
    "v_cndmask_b32 v247, v163, v155, vcc\n\t" \
    "v_cndmask_b32 v234, v152, v160, vcc\n\t" \
    "v_cndmask_b32 v235, v153, v161, vcc\n\t" \
    "v_cndmask_b32 v236, v154, v162, vcc\n\t" \
    "v_cndmask_b32 v237, v155, v163, vcc\n\t" \
    "v_add_f32_dpp v234, v244, v234 row_mirror row_mask:0xf bank_mask:0xf bound_ctrl:1\n\t" \
    "v_add_f32_dpp v235, v245, v235 row_mirror row_mask:0xf bank_mask:0xf bound_ctrl:1\n\t" \
    "v_add_f32_dpp v236, v246, v236 row_mirror row_mask:0xf bank_mask:0xf bound_ctrl:1\n\t" \
    "v_add_f32_dpp v237, v247, v237 row_mirror row_mask:0xf bank_mask:0xf bound_ctrl:1\n\t" \
    "v_and_b32 v244, 4, %8\n\t" \
    "v_cmp_ne_u32 vcc, 0, v244\n\t" \
    "v_cndmask_b32 v244, v234, v230, vcc\n\t" \
    "v_cndmask_b32 v245, v235, v231, vcc\n\t" \
    "v_cndmask_b32 v246, v236, v232, vcc\n\t" \
    "v_cndmask_b32 v247, v237, v233, vcc\n\t" \
    "v_cndmask_b32 v238, v230, v234, vcc\n\t" \
    "v_cndmask_b32 v239, v231, v235, vcc\n\t" \
    "v_cndmask_b32 v240, v232, v236, vcc\n\t" \
    "v_cndmask_b32 v241, v233, v237, vcc\n\t" \
    "v_add_f32_dpp v238, v244, v238 row_half_mirror row_mask:0xf bank_mask:0xf bound_ctrl:1\n\t" \
    "v_add_f32_dpp v239, v245, v239 row_half_mirror row_mask:0xf bank_mask:0xf bound_ctrl:1\n\t" \
    "v_add_f32_dpp v240, v246, v240 row_half_mirror row_mask:0xf bank_mask:0xf bound_ctrl:1\n\t" \
    "v_add_f32_dpp v241, v247, v241 row_half_mirror row_mask:0xf bank_mask:0xf bound_ctrl:1\n\t" \
    "v_and_b32 v244, 2, %8\n\t" \
    "v_cmp_ne_u32 vcc, 0, v244\n\t" \
    "v_cndmask_b32 v244, v240, v238, vcc\n\t" \
    "v_cndmask_b32 v245, v241, v239, vcc\n\t" \
    "v_cndmask_b32 v242, v238, v240, vcc\n\t" \
    "v_cndmask_b32 v243, v239, v241, vcc\n\t" \
    "v_add_f32_dpp v242, v244, v242 quad_perm:[2,3,0,1] row_mask:0xf bank_mask:0xf bound_ctrl:1\n\t" \
    "v_add_f32_dpp v243, v245, v243 quad_perm:[2,3,0,1] row_mask:0xf bank_mask:0xf bound_ctrl:1\n\t" \
    "v_and_b32 v244, 1, %8\n\t" \
    "v_cmp_ne_u32 vcc, 0, v244\n\t" \
    "v_cndmask_b32 v244, v243, v242, vcc\n\t" \
    "v_cndmask_b32 v245, v242, v243, vcc\n\t" \
    "s_nop 0\n\t" \
    "v_add_f32_dpp %5, v244, v245 quad_perm:[1,0,3,2] row_mask:0xf bank_mask:0xf bound_ctrl:1\n\t" \

#define SCAN_CHUNK_CLOBBERS "v137", "v138", "v139", "v140", "v145", "v146", "v148", "v149", "v150", "v151", "v152", "v153", "v154", "v155", "v156", "v157", "v158", "v159", "v160", "v161", "v162", "v163", "v164", "v165", "v166", "v167", "v168", "v169", "v170", "v171", "v172", "v173", "v174", "v175", "v176", "v177", "v178", "v179", "v180", "v181", "v182", "v183", "v184", "v186", "v187", "v188", "v189", "v190", "v191", "v192", "v193", "v194", "v195", "v196", "v197", "v198", "v199", "v200", "v201", "v202", "v203", "v204", "v205", "v206", "v208", "v209", "v210", "v211", "v212", "v213", "v214", "v215", "v216", "v217", "v218", "v219", "v220", "v221", "v222", "v223", "v224", "v225", "v226", "v227", "v228", "v230", "v231", "v232", "v233", "v234", "v235", "v236", "v237", "v238", "v239", "v240", "v241", "v242", "v243", "v244", "v245", "v246", "v247", "v248", "v249", "v250", "vcc"

__device__ __forceinline__ float a_mul(float a, float b) { float d; asm("v_mul_f32 %0, %1, %2" : "=v"(d) : "v"(a), "v"(b)); return d; }
__device__ __forceinline__ float a_fma(float a, float b, float c) { float d; asm("v_fma_f32 %0, %1, %2, %3" : "=v"(d) : "v"(a), "v"(b), "v"(c)); return d; }
__device__ __forceinline__ float a_nfma(float a, float b, float c) { float d; asm("v_fma_f32 %0, -%1, %2, %3" : "=v"(d) : "v"(a), "v"(b), "v"(c)); return d; }
__device__ __forceinline__ float a_add_nop(float a, float b) { float d; asm("v_add_f32 %0, %1, %2\n\ts_nop 1" : "=v"(d) : "v"(a), "v"(b)); return d; }
#define SCAN_BAR() asm volatile("s_barrier" ::: "memory")
__device__ __forceinline__ void scan_unit(const Ctx& C0, const float* scn, int T, int quarter, const float* S0, float* Sout, unsigned char* obase, int mode) {
    Ctx C = C0; C.tid = threadIdx.x; asm volatile("" : "+v"(C.tid)); asm volatile("" : "+s"(C.G), "+s"(C.bid)); C.lane = C.tid & 63; C.wave = __builtin_amdgcn_readfirstlane(C.tid >> 6);
    constexpr int SLOT_B = 32 * 1536;
    const bool comp = C.wave < 4;
    const int q = C.lane & 15, rr = C.lane >> 4, rl = (C.wave & 3) * 4 + rr, irow = quarter * 16 + rl;
    const int nch = T / 32;
    __syncthreads();
    if (!comp) {
        const int lw = C.wave - 4;
        unsigned goff[12];
#pragma unroll
        for (int i = 0; i < 12; ++i) { const int x = (lw * 12 + i) * 1024 + C.lane * 16; goff[i] = (unsigned)((x / 1536) * 12288 + (x % 1536)); }
        const unsigned char* sb = (const unsigned char*)scn;
#define SCAN_ISSUE(ch) do { const int _c = (ch) < nch ? (ch) : nch - 1; const unsigned char* _g = sb + (size_t)_c * (32 * 12288); const int _slot = (ch) & 1; \
        _Pragma("unroll") for (int _i = 0; _i < 12; ++_i) __builtin_amdgcn_global_load_lds((const unsigned*)(_g + goff[_i]), (LAS unsigned*)(C.lds + _slot * SLOT_B + (lw * 12 + _i) * 1024), 16, 0, 0); } while (0)
        if (mode != 1) SCAN_ISSUE(0);
        asm volatile("s_waitcnt vmcnt(0)" ::: "memory");
        SCAN_BAR();
        for (int k = 0; k < nch; ++k) {
            if (mode != 1) SCAN_ISSUE(k + 1);
            asm volatile("s_waitcnt vmcnt(0)" ::: "memory");
            SCAN_BAR();
        }
#undef SCAN_ISSUE
    } else {
        float S0x = 0.f, S1x = 0.f, S2x = 0.f, S3x = 0.f;
        if (S0) { const f32x4 t = *(const f32x4*)(S0 + irow * 64 + 4 * q); S0x = t.x; S1x = t.y; S2x = t.z; S3x = t.w; }
        SCAN_BAR();
        for (int k = 0; k < nch; ++k) {
            const unsigned aq = (unsigned)(size_t)(C.lds + (k & 1) * SLOT_B) + 16u * (unsigned)q, av = (unsigned)(size_t)(C.lds + (k & 1) * SLOT_B) + (320u + (unsigned)irow) * 4u;
            float osel0, osel1;
            asm volatile(SCAN_CHUNK_ASM : "+v"(S0x), "+v"(S1x), "+v"(S2x), "+v"(S3x), "=&v"(osel0), "=&v"(osel1) : "v"(aq), "v"(av), "v"(q) : SCAN_CHUNK_CLOBBERS, "memory");
            if (mode == 0) { *(float*)(obase + (size_t)(k * 32 + q) * UPITCH_B + rl * 4) = osel0; *(float*)(obase + (size_t)(k * 32 + 16 + q) * UPITCH_B + rl * 4) = osel1; }
            SCAN_BAR();
        }
        if (mode == 0) *(f32x4*)(Sout + irow * 64 + 4 * q) = (f32x4){S0x, S1x, S2x, S3x};
    }
    __syncthreads();
}

struct AttnU { int qrow0, nq, krow0, krow1, krow2, g; const float* ck; const float* cv; unsigned vmask; };
__device__ __forceinline__ void attn_unit(const Args& A, const Ctx& C0, int l, int u_qrow0, int u_nq, int u_krow0, int u_krow1, int u_krow2, int u_g, const float* u_ck, const float* u_cv, unsigned u_vmask) {
    Ctx C = C0; C.tid = threadIdx.x; asm volatile("" : "+v"(C.tid)); asm volatile("" : "+s"(C.G), "+s"(C.bid)); C.lane = C.tid & 63; C.wave = __builtin_amdgcn_readfirstlane(C.tid >> 6);
    WSB_DECL;
    AttnU u; u.qrow0 = u_qrow0; u.nq = u_nq; u.krow0 = u_krow0; u.krow1 = u_krow1; u.krow2 = u_krow2; u.g = u_g; u.ck = u_ck; u.cv = u_cv; u.vmask = u_vmask;
    constexpr int KP = 72, VP = 196;
    LAS bf16* Ks = (LAS bf16*)C.lds;
    LAS bf16* Vt = (LAS bf16*)(C.lds + 192 * KP * 2);
    LAS float* biasL = (LAS float*)(C.lds + 192 * KP * 2 + 64 * VP * 2);
    const bf16* U = WS_PTR(const bf16, WS_U); bf16* MIX = WS_PTR(bf16, WS_XN);
    const int hq = u.g * 8 + C.wave;
    for (int idx = C.lane; idx < 255; idx += 64) biasL[C.wave * 256 + idx] = WS_PTR(const float, WS_BIAS)[idx * 16 + hq];
    const int li = C.lane & 31, h = C.lane >> 5;
    bf16x8 qfa[2][4]; v2u gxa[2][2][4];
#pragma unroll
    for (int qt = 0; qt < 2; ++qt) { const int qi = (qt * 32 < u.nq ? qt * 32 : 0) + li; const size_t row = (size_t)(u.qrow0 + qi);
#pragma unroll
        for (int ks = 0; ks < 4; ++ks) qfa[qt][ks] = *(const bf16x8*)(U + row * DIN + C_Q + hq * 64 + ks * 16 + 8 * h);
#pragma unroll
        for (int dt = 0; dt < 2; ++dt)
#pragma unroll
            for (int rq = 0; rq < 4; ++rq) gxa[qt][dt][rq] = *(const v2u*)(U + row * DIN + C_GA + hq * 64 + dt * 32 + 8 * rq + 4 * h); }
    {
        v4u kx[3], vx[3];
#pragma unroll
        for (int it = 0; it < 3; ++it) { const int idx = C.tid + 512 * it; const int j = idx >> 3, part = idx & 7;
            kx[it] = (v4u){0u, 0u, 0u, 0u}; vx[it] = kx[it];
            if ((u.vmask >> (j >> 5)) & 1u) {
                if (u.ck && j < 128) { const float* pk = u.ck + (size_t)j * 128 + part * 8; const float* pv = u.cv + (size_t)j * 128 + part * 8;
                    const f32x4 a0 = *(const f32x4*)pk, a1 = *(const f32x4*)(pk + 4), b0 = *(const f32x4*)pv, b1 = *(const f32x4*)(pv + 4);
                    kx[it] = (v4u){pk2(a0.x, a0.y), pk2(a0.z, a0.w), pk2(a1.x, a1.y), pk2(a1.z, a1.w)}; vx[it] = (v4u){pk2(b0.x, b0.y), pk2(b0.z, b0.w), pk2(b1.x, b1.y), pk2(b1.z, b1.w)}; }
                else { const int ch = j >> 6; const int kr = (ch == 0 ? u.krow0 : (ch == 1 ? u.krow1 : u.krow2)) + (j & 63);
                    kx[it] = *(const v4u*)(U + (size_t)kr * DIN + C_K + u.g * 64 + part * 8); vx[it] = *(const v4u*)(U + (size_t)kr * DIN + C_V + u.g * 64 + part * 8); }
            } }
#pragma unroll
        for (int it = 0; it < 3; ++it) { const int idx = C.tid + 512 * it; const int j = idx >> 3, part = idx & 7;
            *(LAS v4u*)(Ks + j * KP + part * 8) = kx[it];
            LAS bf16* vd = Vt + (part * 8) * VP + j; const v4u v = vx[it];
            vd[0 * VP] = (bf16)(v.x & 0xffffu); vd[1 * VP] = (bf16)(v.x >> 16); vd[2 * VP] = (bf16)(v.y & 0xffffu); vd[3 * VP] = (bf16)(v.y >> 16);
            vd[4 * VP] = (bf16)(v.z & 0xffffu); vd[5 * VP] = (bf16)(v.z >> 16); vd[6 * VP] = (bf16)(v.w & 0xffffu); vd[7 * VP] = (bf16)(v.w >> 16); }
    }
    __syncthreads();
    const float sink = A.in[I_SINKS][l * 16 + hq];
    const LAS float* bL = biasL + C.wave * 256;
#pragma unroll
    for (int qt = 0; qt < 2; ++qt) { if (qt * 32 < u.nq) {
        const int qi = qt * 32 + li;
        bf16x8 qf[4];
#pragma unroll
        for (int ks = 0; ks < 4; ++ks) qf[ks] = qfa[qt][ks];
        f32x16 sacc[6];
#pragma unroll
        for (int kt = 0; kt < 6; ++kt) {
#pragma unroll
            for (int r = 0; r < 16; ++r) sacc[kt][r] = 0.f;
#pragma unroll
            for (int ks = 0; ks < 4; ++ks) { const bf16x8 kf = *(const LAS bf16x8*)(Ks + (kt * 32 + li) * KP + ks * 16 + 8 * h);
                sacc[kt] = __builtin_amdgcn_mfma_f32_32x32x16_bf16(kf, qf[ks], sacc[kt], 0, 0, 0); }
            asm volatile("" ::: "memory");
        }
        float mx = sink;
#pragma unroll
        for (int kt = 0; kt < 6; ++kt) { const bool valid = (u.vmask >> kt) & 1u;
#pragma unroll
            for (int r = 0; r < 16; ++r) { const int j = kt * 32 + (r & 3) + 8 * (r >> 2) + 4 * h;
                const float lg = valid ? sacc[kt][r] * 0.125f + bL[j - qi + 63] : -1e30f; sacc[kt][r] = lg; mx = fmaxf(mx, lg); }
            asm volatile("" ::: "memory"); }
        mx = fmaxf(mx, shflx(mx, 32, C.lane));
        float sum = 0.f;
#pragma unroll
        for (int kt = 0; kt < 6; ++kt)
#pragma unroll
            for (int r = 0; r < 16; ++r) { const float e = __expf(sacc[kt][r] - mx); sacc[kt][r] = e; sum += e; }
        sum += shflx(sum, 32, C.lane); sum += __expf(sink - mx);
        const float inv = 1.f / sum;
        f32x16 oacc[2];
#pragma unroll
        for (int dt = 0; dt < 2; ++dt)
#pragma unroll
            for (int r = 0; r < 16; ++r) oacc[dt][r] = 0.f;
#pragma unroll
        for (int kt = 0; kt < 6; ++kt) {
            if ((u.vmask >> kt) & 1u) {
#pragma unroll
                for (int s = 0; s < 2; ++s) {
                    union { bf16x8 v; unsigned w[4]; } pf;
#pragma unroll
                    for (int e = 0; e < 4; ++e) pf.w[e] = pk2(sacc[kt][8 * s + 2 * e] * inv, sacc[kt][8 * s + 2 * e + 1] * inv);
#pragma unroll
                    for (int dt = 0; dt < 2; ++dt) { const LAS bf16* vp = Vt + (dt * 32 + li) * VP + kt * 32 + 16 * s + 4 * h;
                        union { bf16x8 v; v2u w[2]; } vf; vf.w[0] = *(const LAS v2u*)vp; vf.w[1] = *(const LAS v2u*)(vp + 8);
                        oacc[dt] = __builtin_amdgcn_mfma_f32_32x32x16_bf16(vf.v, pf.v, oacc[dt], 0, 0, 0); }
                }
            }
            asm volatile("" ::: "memory");
        }
        const size_t row = (size_t)(u.qrow0 + qi);
#pragma unroll
        for (int dt = 0; dt < 2; ++dt)
#pragma unroll
            for (int rq = 0; rq < 4; ++rq) { const int d = dt * 32 + 8 * rq + 4 * h;
                const v2u gx = gxa[qt][dt][rq];
                const float o0 = oacc[dt][4 * rq] * silu(bflo(gx.x)), o1 = oacc[dt][4 * rq + 1] * silu(bfhi(gx.x)), o2 = oacc[dt][4 * rq + 2] * silu(bflo(gx.y)), o3 = oacc[dt][4 * rq + 3] * silu(bfhi(gx.y));
                v2u o; o.x = pk2(o0, o1); o.y = pk2(o2, o3);
                *(v2u*)(MIX + row * D + 512 + hq * 64 + d) = o; }
    } }
    __syncthreads();
}

__device__ __forceinline__ void pool_item(const Args& A, const Ctx& C0, int l, int row0, int t0, int pos0, const float* hist, float* outpool) {
    Ctx C = C0; C.tid = threadIdx.x; asm volatile("" : "+v"(C.tid)); asm volatile("" : "+s"(C.G), "+s"(C.bid)); C.lane = C.tid & 63; C.wave = __builtin_amdgcn_readfirstlane(C.tid >> 6);
    WSB_DECL;
    constexpr int PP = 520;
    LAS bf16* P = (LAS bf16*)C.lds;
    const bf16* U = WS_PTR(const bf16, WS_U); bf16* MIX = WS_PTR(bf16, WS_XN);
    {
        v4u xs[6];
#pragma unroll
        for (int it = 0; it < 6; ++it) { const int idx = C.tid + 512 * it; const int rr = idx >> 6, v = idx & 63;
            xs[it] = (v4u){0u, 0u, 0u, 0u};
            if (idx < 47 * 64) {
                if (rr < 15 && t0 == 0) { if (hist) { const f32x4 a0 = *(const f32x4*)(hist + rr * 512 + v * 8), a1 = *(const f32x4*)(hist + rr * 512 + v * 8 + 4);
                        xs[it] = (v4u){pk2(a0.x, a0.y), pk2(a0.z, a0.w), pk2(a1.x, a1.y), pk2(a1.z, a1.w)}; } }
                else xs[it] = *(const v4u*)(U + (size_t)(row0 - 15 + rr) * DIN + C_P + v * 8); } }
#pragma unroll
        for (int it = 0; it < 6; ++it) { const int idx = C.tid + 512 * it; const int rr = idx >> 6, v = idx & 63; if (idx < 47 * 64) *(LAS v4u*)(P + rr * PP + v * 8) = xs[it]; }
    }
    __syncthreads();
    LAS bf16* Dm = P + 47 * PP;
    { const int c = C.tid, gc = c >> 7, wdc = 2 << gc;
      float s = 0.f;
      for (int i = 0; i < wdc; ++i) s += bf1(P[(15 - i) * PP + c]);
#pragma unroll 4
      for (int t = 0; t < 32; ++t) { const int pos = pos0 + t; const float inv = 1.f / (float)((pos + 1) < wdc ? (pos + 1) : wdc);
          const float cur = bf1(P[(15 + t) * PP + c]);
          Dm[t * PP + c] = (bf16)f2bf(s * inv - cur);
          s += bf1(P[(16 + t) * PP + c]) - bf1(P[(16 + t - wdc) * PP + c]); } }
    __syncthreads();
    const int g = C.wave & 3, ddh = C.wave >> 2, tk = C.lane & 31, h = C.lane >> 5;
    const bf16* PW = WS_PTR(const bf16, WS_PWT) + (size_t)(l * 4 + g) * 128 * 128;
    f32x16 acc[2];
#pragma unroll
    for (int dt = 0; dt < 2; ++dt)
#pragma unroll
        for (int r = 0; r < 16; ++r) acc[dt][r] = 0.f;
#pragma unroll
    for (int ks = 0; ks < 8; ++ks) { const bf16x8 df = *(const LAS bf16x8*)(Dm + tk * PP + g * 128 + ks * 16 + 8 * h);
#pragma unroll
        for (int dt = 0; dt < 2; ++dt) { const bf16x8 af = *(const bf16x8*)(PW + (size_t)(ddh * 64 + dt * 32 + tk) * 128 + ks * 16 + 8 * h);
            acc[dt] = __builtin_amdgcn_mfma_f32_32x32x16_bf16(af, df, acc[dt], 0, 0, 0); }
    }
    const size_t row = (size_t)(row0 + tk);
    const float* psc = A.in[I_POOLS] + l * 512;
#pragma unroll
    for (int dt = 0; dt < 2; ++dt)
#pragma unroll
        for (int rq = 0; rq < 4; ++rq) { const int cc = g * 128 + ddh * 64 + dt * 32 + 8 * rq + 4 * h;
            const v2u gx = *(const v2u*)(U + row * DIN + C_GP + cc); const f32x4 sc = *(const f32x4*)(psc + cc);
            const float o0 = acc[dt][4 * rq] * sc.x * silu(bflo(gx.x)), o1 = acc[dt][4 * rq + 1] * sc.y * silu(bfhi(gx.x)), o2 = acc[dt][4 * rq + 2] * sc.z * silu(bflo(gx.y)), o3 = acc[dt][4 * rq + 3] * sc.w * silu(bfhi(gx.y));
            v2u o; o.x = pk2(o0, o1); o.y = pk2(o2, o3);
            *(v2u*)(MIX + row * D + cc) = o; }
    if (outpool) for (int idx = C.tid; idx < 15 * 512; idx += 512) { const int rr = idx >> 9, cc = idx & 511; outpool[idx] = bf1(P[(32 + rr) * PP + cc]); }
    __syncthreads();
}

#ifndef UN_MASK
#define UN_MASK 7
#endif
__device__ __forceinline__ void mixer_item(const Args& A, const Ctx& C, int l, int it, int unmask) {
    WSB_DECL;
    const float* SCN = WS_PTR(const float, WS_SCN); unsigned char* Ub = A.ws + WS_U;
    constexpr int N_PSCAN = BATCH * 8 * 4, N_SSCAN = DECB * 8 * 4, N_PATT = BATCH * (SEQ / 64) * 2, N_SATT = DECB * 2, N_PPOOL = MP / 32, N_SPOOL = DECB;
    if (it < N_PSCAN + N_SSCAN) {
        const bool smp = it >= N_PSCAN; const int i2 = smp ? it - N_PSCAN : it;
        int b, hd, qd;
        if (smp) { b = i2 >> 5; hd = (i2 >> 2) & 7; qd = i2 & 3; }
        else { const int xg = i2 & 7, idx = i2 >> 3, pair = xg * 4 + (idx >> 2); qd = idx & 3; b = pair >> 3; hd = pair & 7; }
        const size_t row0 = smp ? (size_t)MP + b * DECS : (size_t)b * SEQ;
        const float* S0 = smp ? A.in[I_SWKV] + ((size_t)(l * DECB + b) * 8 + hd) * 4096 : nullptr;
        float* So = smp ? A.out + O_WKVS + ((size_t)(l * DECB + b) * 8 + hd) * 4096 : A.out + O_WKVP + ((size_t)(l * BATCH + b) * 8 + hd) * 4096;
        if (unmask & UN_MASK & 1) scan_unit(C, SCN + row0 * 3072 + hd * 384, smp ? DECS : SEQ, qd, S0, So, Ub + row0 * UPITCH_B + UXC_B + (hd * 64 + qd * 16) * 4, (unmask >> 4) & 3);
        return; }
    it -= N_PSCAN + N_SSCAN;
    if (it < N_PATT + N_SATT) { int qrow0, nq, krow0, krow1, g; const float* ck; const float* cv; unsigned vmask;
        if (it < N_PATT) { const int c = (it >> 1) & 127, b = it >> 8; g = it & 1; nq = 64; qrow0 = b * SEQ + c * 64; ck = nullptr; cv = nullptr;
            krow0 = b * SEQ + (c - 2) * 64; krow1 = b * SEQ + (c - 1) * 64; vmask = (c >= 2 ? 3u : 0u) | (c >= 1 ? 12u : 0u) | 48u; }
        else { const int i2 = it - N_PATT; const int b = i2 >> 1; g = i2 & 1; nq = 32; qrow0 = MP + b * DECS; krow0 = 0; krow1 = 0; vmask = 31u;
            ck = A.in[I_CK] + ((size_t)(l * DECB + b) * 128) * 128 + g * 64; cv = A.in[I_CV] + ((size_t)(l * DECB + b) * 128) * 128 + g * 64; }
        if (unmask & UN_MASK & 2) attn_unit(A, C, l, qrow0, nq, krow0, krow1, qrow0, g, ck, cv, vmask);
        return; }
    it -= N_PATT + N_SATT;
    { int row0, t0, pos0; const float* hist; float* outp;
      if (it < N_PPOOL) { row0 = it * 32; t0 = row0 % SEQ; pos0 = t0; hist = nullptr; outp = (t0 == SEQ - 32) ? A.out + O_POOLP + (size_t)(l * BATCH + row0 / SEQ) * 15 * 512 : nullptr; }
      else { const int b = it - N_PPOOL; row0 = MP + b * DECS; t0 = 0; pos0 = 1024; hist = A.in[I_SPOOL] + (size_t)(l * DECB + b) * 15 * 512; outp = A.out + O_POOLS + (size_t)(l * DECB + b) * 15 * 512; }
      if (unmask & UN_MASK & 4) pool_item(A, C, l, row0, t0, pos0, hist, outp); }
}
__device__ __forceinline__ void sub_barrier(unsigned* cnt, unsigned n) {
    asm volatile("s_waitcnt vmcnt(0)" ::: "memory");
    __syncthreads();
    if (threadIdx.x == 0) {
        __builtin_amdgcn_fence(__ATOMIC_RELEASE, "agent");
        asm volatile("s_waitcnt vmcnt(0)" ::: "memory");
        __hip_atomic_fetch_add(cnt, 1u, __ATOMIC_RELAXED, __HIP_MEMORY_SCOPE_AGENT);
        unsigned sp = 0;
        while (__hip_atomic_load(cnt, __ATOMIC_RELAXED, __HIP_MEMORY_SCOPE_AGENT) < n) { __builtin_amdgcn_s_sleep(2); if (++sp > (1u << 24)) break; }
        __builtin_amdgcn_fence(__ATOMIC_ACQUIRE, "agent");
        asm volatile("s_waitcnt vmcnt(0)" ::: "memory");
    }
    __syncthreads();
}
__device__ __forceinline__ bool phase_mixers(const Args& A, const Ctx& C0, int l, int unmask) {
    Ctx C = C0; C.tid = threadIdx.x; asm volatile("" : "+v"(C.tid)); asm volatile("" : "+s"(C.G), "+s"(C.bid)); C.lane = C.tid & 63; C.wave = __builtin_amdgcn_readfirstlane(C.tid >> 6);
    WSB_DECL;
    constexpr int N_PSCAN = BATCH * 8 * 4;
    constexpr int NI = N_PSCAN + DECB * 8 * 4 + BATCH * (SEQ / 64) * 2 + DECB * 2 + MP / 32 + DECB;
    if (C.G >= N_PSCAN + 64) {
        if (C.bid < N_PSCAN) mixer_item(A, C, l, C.bid, unmask);
        else {
            const int no = C.G - N_PSCAN;
            for (int it = N_PSCAN + (C.bid - N_PSCAN); it < NI; it += no) mixer_item(A, C, l, it, unmask);
            if (unmask == 7) { sub_barrier((unsigned*)(A.ws + WS_CTL) + CW_SUB + 64 * l, (unsigned)no); return true; }
        }
    } else {
        for (int it = C.bid; it < NI; it += C.G) mixer_item(A, C, l, it, unmask);
    }
    return false;
}

__device__ __forceinline__ void phase_post(const Args& A, const Ctx& C0, int l, int nskip) {
    Ctx C = C0; C.tid = threadIdx.x; asm volatile("" : "+v"(C.tid)); asm volatile("" : "+s"(C.G), "+s"(C.bid)); C.lane = C.tid & 63; C.wave = __builtin_amdgcn_readfirstlane(C.tid >> 6);
    WSB_DECL;
    const bf16* U = WS_PTR(const bf16, WS_U); bf16* MIX = WS_PTR(bf16, WS_XN); const unsigned char* Ub = A.ws + WS_U;
    const float* SCN = WS_PTR(const float, WS_SCN); const float* RKB = WS_PTR(const float, WS_RK);
    const int hd = C.wave, c = hd * 64 + C.lane;
    const float lw = A.in[I_LNXW][l * 512 + c], lb = A.in[I_LNXB][l * 512 + c];
    if (C.bid >= nskip)
    for (int row0 = (C.bid - nskip) * 8; row0 < M; row0 += (C.G - nskip) * 8) {
        float o[8], v[8], gr[8], rk[8];
#pragma unroll
        for (int i = 0; i < 8; ++i) { const size_t row = (size_t)(row0 + i);
            o[i] = ((const float*)(Ub + row * UPITCH_B + UXC_B))[c]; v[i] = SCN[row * 3072 + hd * 384 + 320 + C.lane];
            gr[i] = bf1(U[row * DIN + C_GR + c]); rk[i] = RKB[row * 8 + hd]; }
#pragma unroll
        for (int i = 0; i < 8; ++i) { const size_t row = (size_t)(row0 + i);
            const float mean = wave_sum_l(o[i], C.lane) * (1.f / 64.f); const float dd = o[i] - mean; const float var = wave_sum_l(dd * dd, C.lane) * (1.f / 64.f);
            const float y = dd * (1.f / sqrtf(var + LNX_EPS)) * lw + lb + rk[i] * v[i];
            MIX[row * D + 1536 + c] = (bf16)f2bf(y * silu(gr[i])); }
    }
}
__device__ __forceinline__ void phase_norm(const Args& A, const Ctx& C0, int l) {
    Ctx C = C0; C.tid = threadIdx.x; asm volatile("" : "+v"(C.tid)); asm volatile("" : "+s"(C.G), "+s"(C.bid)); C.lane = C.tid & 63; C.wave = __builtin_amdgcn_readfirstlane(C.tid >> 6);
    WSB_DECL;
    const int gw = C.bid * NWAVES + C.wave, NGW = C.G * NWAVES;
    if (l + 1 < DEPTH) { for (int m = gw; m < M; m += NGW) norm_row(A.out + (size_t)m * D, A.in[I_NORMW] + (size_t)(l + 1) * D, WS_PTR(bf16, WS_XN) + (size_t)m * D, nullptr, nullptr, C.lane); }
    else {
        const f32x4* wr = (const f32x4*)A.in[I_FNW] + C.lane;
        for (int m = gw; m < M; m += 4 * NGW) {
            f32x4* p[4]; f32x4 v[4][8]; float s[4]; bool ok[4];
#pragma unroll
            for (int r = 0; r < 4; ++r) { const int mr = m + r * NGW; ok[r] = mr < M; p[r] = (f32x4*)(A.out + (size_t)(ok[r] ? mr : m) * D) + C.lane; }
#pragma unroll
            for (int r = 0; r < 4; ++r)
#pragma unroll
                for (int j = 0; j < 8; ++j) v[r][j] = p[r][64 * j];
#pragma unroll
            for (int r = 0; r < 4; ++r) { float t = 0.f;
#pragma unroll
                for (int j = 0; j < 8; ++j) t += (v[r][j].x * v[r][j].x + v[r][j].y * v[r][j].y) + (v[r][j].z * v[r][j].z + v[r][j].w * v[r][j].w);
                s[r] = 1.f / sqrtf(wave_sum_l(t, C.lane) * (1.f / D) + NORM_EPS); }
#pragma unroll
            for (int j = 0; j < 8; ++j) { const f32x4 ww = wr[64 * j];
#pragma unroll
                for (int r = 0; r < 4; ++r) if (ok[r]) p[r][64 * j] = v[r][j] * s[r] * ww; } } }
}

constexpr int N_PHASES = 1 + 6 * DEPTH;
#ifndef EN_MASK
#define EN_MASK 0x7f
#endif
#define EN(k) ((EN_MASK >> (k)) & 1)
#ifndef G1_ALIGN
#define G1_ALIGN true
#endif
#ifndef G1_SP2
#define G1_SP2 true
#endif
#ifndef G2_ALIGN
#define G2_ALIGN true
#endif
#ifndef DUP_UN
#define DUP_UN 7
#endif
#ifndef DUP_MASK
#define DUP_MASK 0
#endif
__global__ void __launch_bounds__(NWAVES * 64, 2) hybrid_fwd(Args A) {
    extern __shared__ __attribute__((aligned(16))) unsigned char lds_raw[];
    Ctx C; C.lds = (LAS unsigned char*)lds_raw; C.tid = threadIdx.x; C.lane = C.tid & 63; C.wave = __builtin_amdgcn_readfirstlane(C.tid >> 6); C.G = gridDim.x; C.bid = blockIdx.x;
    for (int u = C.tid; u < (LDS_BYTES - LDSCTL_OFF) / 4; u += NWAVES * 64) ((LAS unsigned*)(C.lds + LDSCTL_OFF))[u] = 0u;
    __syncthreads();
    gu32* ctl = (gu32*)(A.ws + WS_CTL);
    XcdBarrier bar; bar.bar = (unsigned*)(ctl + CW_BAR); bar.x = 0; bar.st = nullptr;
    if (A.coop) bar = xcd_barrier_post((unsigned*)(ctl + CW_BAR), (volatile LAS unsigned*)(C.lds + MISC_OFF) + 8);
    const int lo = A.ph_lo, hi = A.ph_hi;
    for (int ph = lo; ph < hi; ++ph) {
      const int l = (ph - 1) / 6, s = (ph == 0) ? -1 : (ph - 1) % 6;
      WSB_DECL;
      const int reps = ((ph > 0 && ((DUP_MASK >> s) & 1) && !(s == 5 && l == DEPTH - 1)) || (ph == 0 && (DUP_MASK & 64))) ? 2 : 1;
      for (int rep = 0; rep < reps; ++rep) {
        if (rep) { if (ph == 0) cg::this_grid().sync(); else xcd_barrier(bar); }
        if (ph == 0) { if (EN(0)) phase_prologue(A, C); }
        else {
            if (s == 0 && EN(1)) { pg8::Gemm g{WS_PTR(const bf16, WS_HB), WS_PTR(const bf16, WS_WINT) + (size_t)l * DINP * D, M, DINP, D, D}; pg8::StaticOrder S; S.init(M, DINP, C.G, C.bid);
                pg8::EpiU E{WS_PTR(bf16, WS_U), WS_PTR(const float, WS_SS) + (size_t)l * M};
                pg8::gemm_phase<pg8::EpiU, pg8::StaticOrder, G1_ALIGN, G1_SP2>(C.lds, g, S, E); }
            else if (s == 1 && EN(2)) phase_prep(A, C, l);
            else if ((s == 2 && EN(3)) || (s == 3 && EN(4)) || (s == 4 && EN(5))) {
                const bool split = C.G >= 192; bool go = (s == 4); int k0 = split ? KSPLIT : 0, kl = D - k0, gg = C.G, cc = C.bid, mrows = M; size_t roff = 0;
                if (s == 2) { go = phase_mixers(A, C, l, rep ? DUP_UN : 7); k0 = 0; kl = KSPLIT; gg = C.G - 128; cc = C.bid - 128; mrows = MP; }
                if (s == 3) { phase_post(A, C, l, split ? 8 : 0); go = split && C.bid < 8 && !rep; k0 = 0; kl = KSPLIT; gg = 8; cc = C.bid; mrows = MS; roff = (size_t)MP * D; }
                if (go) { pg8::Gemm g{WS_PTR(const bf16, WS_XN) + roff + k0, WS_PTR(const bf16, WS_WOUTT) + (size_t)l * D * D + k0, mrows, D, kl, D}; pg8::StaticOrder S; S.init(mrows, D, gg, cc);
                    const bool first = (l == 0) && (s != 4 || !split);
                    float* Hout = ((rep && s == 4) ? WS_PTR(float, WS_U) : A.out) + roff;
                    pg8::EpiResN E{Hout, first ? (s == 3 ? A.in[I_XS] : A.in[I_XP]) : Hout, first ? A.in[I_XS] - (size_t)MP * D : Hout, WS_PTR(bf16, WS_HB), WS_PTR(float, WS_SS) + (size_t)(l + 1) * M, s == 4 && !rep};
                    pg8::gemm_phase<pg8::EpiResN, pg8::StaticOrder, G2_ALIGN, true>(C.lds, g, S, E); }
            }
            else if (s == 5 && EN(6) && l == DEPTH - 1) phase_norm(A, C, l);
        }
      }
        if (ph + 1 < hi && !(s == 5 && l < DEPTH - 1)) {
            if (A.coop == 2) cg::this_grid().sync();
            else xcd_barrier(bar);
        }
    }
}

#ifndef MK_MULTI
#define MK_MULTI 0
#endif
extern "C" void kernel_launch(void* const* d_in, const int* in_sizes, int n_in, void* d_out, int out_size, void* d_ws, size_t ws_size, hipStream_t stream) {
    static int grid = 0;
    if (grid == 0) {
        if (n_in != 25 || (size_t)out_size != O_END || ws_size < WS_END) { fprintf(stderr, "kernel_launch: unexpected sizes: n_in %d out %d ws %zu (need %zu)\n", n_in, out_size, ws_size, (size_t)WS_END); grid = -1; return; }
        int dev = 0, cus = 0, per_cu = 0;
        if (hipGetDevice(&dev) != hipSuccess || hipDeviceGetAttribute(&cus, hipDeviceAttributeMultiprocessorCount, dev) != hipSuccess) { grid = -1; return; }
        if (hipFuncSetAttribute((const void*)hybrid_fwd, hipFuncAttributeMaxDynamicSharedMemorySize, LDS_BYTES) != hipSuccess) { fprintf(stderr, "kernel_launch: hipFuncSetAttribute failed\n"); grid = -1; return; }
        if (hipOccupancyMaxActiveBlocksPerMultiprocessor(&per_cu, (const void*)hybrid_fwd, NWAVES * 64, LDS_BYTES) != hipSuccess || per_cu < 1) { fprintf(stderr, "kernel_launch: occupancy query gives %d\n", per_cu); per_cu = 1; }
        (void)hipGetLastError();
        grid = cus;
    }
    if (grid < 0) return;
    (void)hipMemsetAsync((char*)d_ws + WS_CTL, 0, CTL_ZERO_BYTES, stream);
    Args a{};
    for (int i = 0; i < 25; ++i) a.in[i] = (const float*)d_in[i];
    a.out = (float*)d_out; a.ws = (unsigned char*)d_ws;
#if MK_MULTI
    for (int ph = 0; ph < N_PHASES; ++ph) { a.ph_lo = ph; a.ph_hi = ph + 1; a.coop = 0;
        hipLaunchKernelGGL(hybrid_fwd, dim3(grid), dim3(NWAVES * 64), LDS_BYTES, stream, a); }
#else
    a.ph_lo = 0; a.ph_hi = N_PHASES; a.coop = 1;
    void* args[] = {&a};
    hipError_t e = hipLaunchCooperativeKernel((const void*)hybrid_fwd, dim3(grid), dim3(NWAVES * 64), args, LDS_BYTES, stream);
    if (e != hipSuccess) fprintf(stderr, "kernel_launch: cooperative launch failed: %s (grid %d)\n", hipGetErrorString(e), grid);
#endif
}
```

```cpp
#include <hip/hip_runtime.h>
#include <hip/hip_cooperative_groups.h>
#include <cstdio>
#include <cstdint>
namespace cg = cooperative_groups;
namespace pg8 {
#define PG8_LAS __attribute__((address_space(3)))
typedef unsigned short bf16_t;
typedef short bf16x8 __attribute__((ext_vector_type(8)));
typedef float f32x4 __attribute__((ext_vector_type(4)));
typedef unsigned u32x4 __attribute__((ext_vector_type(4)));
constexpr int BM = 256, BK = 64, HALF = 128, HTB = HALF * BK * 2  , STAGE_BYTES = 8 * HTB, NXCD = 8, WGM = 8;

__host__ __device__ __forceinline__ int lds_byte(int r, int c) { const int st = (r >> 4) * 2 + (c >> 5), rr = r & 15, cc = c & 31, ob = rr * 64 + cc * 2; return st * 1024 + (ob ^ (((ob >> 9) & 1) << 5)); }
__host__ __device__ __forceinline__ void stage_rc(int b, int& R, int& C) { const int st = b / 1024, sb = b % 1024, swz = sb ^ (((sb >> 9) & 1) << 5); R = (st >> 1) * 16 + swz / 64; C = (st & 1) * 32 + (swz % 64) / 2; }
__host__ __device__ __forceinline__ int perm32(int rho) { const int n = rho >> 4, i = rho & 15; return 8 * (i >> 2) + 4 * n + (i & 3); }

struct Unit { int pm, pn; };
struct Gemm { const bf16_t* A; const bf16_t* Bt; int M, N, K, ld; };

struct StaticOrder {
    int nM, nN, nwg, G, c;
    __host__ __device__ void init(int M, int N, int G_, int c_) { nM = M / BM; nN = N / BM; nwg = nM * nN; G = G_; c = c_; }
    __host__ __device__ bool next(int i, Unit& u) const {
        const long L = (long)i * G + c; if (L >= nwg) return false;
        int wgid = (int)L; { const int q = nwg / NXCD, r = nwg % NXCD, xcd = wgid % NXCD, off = wgid / NXCD; wgid = (xcd < r ? xcd * (q + 1) : r * (q + 1) + (xcd - r) * q) + off; }
        const int nig = WGM * nN, gid = wgid / nig, fm = gid * WGM, gsz = (nM - fm) < WGM ? (nM - fm) : WGM;
        u.pm = fm + ((wgid % nig) % gsz); u.pn = (wgid % nig) / gsz; return true;
    }
    __device__ __forceinline__ void a_ready(const Unit&) const {}
    __device__ __forceinline__ void done(const Unit&) const {}
};
__device__ __forceinline__ unsigned cvt_pk_bf16(float lo, float hi) { unsigned r; asm volatile("v_cvt_pk_bf16_f32 %0, %1, %2" : "=v"(r) : "v"(lo), "v"(hi)); return r; }
typedef float f32x2 __attribute__((ext_vector_type(2)));
struct EpiU {
    static constexpr bool PERM = true, AFTER_DRAIN = false;
    bf16_t* O; const float* SS;
    __device__ __forceinline__ void operator()(const f32x4 (&acc)[2][2][4][2], const Unit& u, int wr, int wc, int fr, int fq) const {
        const int row0 = u.pm * BM + wr * 64 + fr; const int col0 = u.pn * BM + wc * 32 + 8 * fq;
#pragma unroll
        for (int ai = 0; ai < 2; ++ai)
#pragma unroll
            for (int m = 0; m < 4; ++m) { bf16_t* rowp = O + (size_t)(row0 + ai * HALF + m * 16) * 5504 + col0;
                const float rs = 1.0f / sqrtf(SS[row0 + ai * HALF + m * 16] * (1.0f / 2048.0f) + 1e-5f);
#pragma unroll
                for (int bj = 0; bj < 2; ++bj) { if (u.pn * BM + bj * HALF < 5504) { const f32x4 v0 = acc[ai][bj][m][0] * rs, v1 = acc[ai][bj][m][1] * rs;
                    u32x4 w; w.x = cvt_pk_bf16(v0[0], v0[1]); w.y = cvt_pk_bf16(v0[2], v0[3]); w.z = cvt_pk_bf16(v1[0], v1[1]); w.w = cvt_pk_bf16(v1[2], v1[3]);
                    *(u32x4*)(rowp + bj * HALF) = w; } } }
    }
};
struct EpiRes {
    static constexpr bool PERM = false, AFTER_DRAIN = false;
    float* H;
    __device__ __forceinline__ void operator()(const f32x4 (&acc)[2][2][4][2], const Unit& u, int wr, int wc, int fr, int fq) const {
        const int col0 = u.pn * BM + wc * 32 + 4 * fq;
#pragma unroll
        for (int ai = 0; ai < 2; ++ai)
#pragma unroll
            for (int m = 0; m < 4; ++m) { float* rowp = H + (size_t)(u.pm * BM + ai * HALF + wr * 64 + m * 16 + fr) * 2048 + col0;
#pragma unroll
                for (int bj = 0; bj < 2; ++bj)
#pragma unroll
                    for (int n = 0; n < 2; ++n) { f32x4* p = (f32x4*)(rowp + bj * HALF + n * 16); *p = *p + acc[ai][bj][m][n]; } }
    }
};

struct EpiResN {
    static constexpr bool PERM = true, AFTER_DRAIN = false;
    float* H; const float* HinP; const float* HinS; bf16_t* HB; float* SSn; bool fin;
    __device__ __forceinline__ void operator()(const f32x4 (&acc)[2][2][4][2], const Unit& u, int wr, int wc, int fr, int fq) const {
        const int col0 = u.pn * BM + wc * 32 + 8 * fq;
#pragma unroll
        for (int ai = 0; ai < 2; ++ai)
#pragma unroll
            for (int m = 0; m < 4; ++m) { const int row = u.pm * BM + ai * HALF + wr * 64 + m * 16 + fr; float* rowp = H + (size_t)row * 2048 + col0; bf16_t* hbp = HB + (size_t)row * 2048 + col0;
                const float* inp = (u.pm < 128 ? HinP : HinS) + (size_t)row * 2048 + col0;
                float ss = 0.f;
#pragma unroll
                for (int bj = 0; bj < 2; ++bj) { const f32x4 h0 = *(const f32x4*)(inp + bj * HALF) + acc[ai][bj][m][0], h1 = *(const f32x4*)(inp + bj * HALF + 4) + acc[ai][bj][m][1];
                    *(f32x4*)(rowp + bj * HALF) = h0; *(f32x4*)(rowp + bj * HALF + 4) = h1;
                    if (fin) { ss += ((h0[0] * h0[0] + h0[1] * h0[1]) + (h0[2] * h0[2] + h0[3] * h0[3])) + ((h1[0] * h1[0] + h1[1] * h1[1]) + (h1[2] * h1[2] + h1[3] * h1[3]));
                        u32x4 w; w.x = cvt_pk_bf16(h0[0], h0[1]); w.y = cvt_pk_bf16(h0[2], h0[3]); w.z = cvt_pk_bf16(h1[0], h1[1]); w.w = cvt_pk_bf16(h1[2], h1[3]);
                        *(u32x4*)(hbp + bj * HALF) = w; } }
                if (fin) { { const int ln = fr + 16 * fq; ss += __int_as_float(__builtin_amdgcn_ds_bpermute((ln ^ 16) << 2, __float_as_int(ss))); ss += __int_as_float(__builtin_amdgcn_ds_bpermute((ln ^ 32) << 2, __float_as_int(ss))); }
                    if (fq == 0) atomicAdd(SSn + row, ss); } }
    }
};
template <class Epi, class Sched, bool ALIGN_EPI = false, bool SP2 = false>
__device__ __forceinline__ void gemm_phase(PG8_LAS unsigned char* lds, const Gemm g, const Sched& S, const Epi& E) {
    int tid_l = threadIdx.x; asm volatile("" : "+v"(tid_l));
    const int tid = tid_l, wid = __builtin_amdgcn_readfirstlane(tid >> 6), lane = tid & 63, wr = wid >> 2, wc = wid & 3, fr = lane & 15, fq = lane >> 4;
    const int K = g.ld, nt = g.K / BK;
    unsigned voffA[2], voffB[2];
#pragma unroll
    for (int i = 0; i < 2; ++i) { int R, C; stage_rc(tid * 16 + i * 8192, R, C); const int Rb = Epi::PERM ? ((R & ~31) + perm32(R & 31)) : R;
        voffA[i] = (unsigned)(R * K + C) * 2u; voffB[i] = (unsigned)(Rb * K + C) * 2u; }
    const size_t kstep = (size_t)(BK * 2);
    const size_t hstep = (size_t)HALF * K * 2;
    const size_t tstep = 2 * hstep;
    const unsigned ldsw = (unsigned)wid * 1024u;
    const int aoff = lds_byte(wr * 64 + fr, fq * 8), boff = lds_byte(wc * 32 + fr, fq * 8);
#define PG8_SA(b, h) (((b) * 2 + (h)) * HTB)
#define PG8_SB(b, h) ((4 + (b) * 2 + (h)) * HTB)
#define PG8_STAGE(bufoff, gbase, voff) do { _Pragma("unroll") for (int _i = 0; _i < 2; ++_i) \
        __builtin_amdgcn_global_load_lds((const unsigned*)((const char*)(gbase) + (voff)[_i]), (PG8_LAS unsigned*)(lds + (bufoff) + ldsw + _i * 8192), 16, 0, 0); } while (0)
#define PG8_LDA(dst, b, h) do { _Pragma("unroll") for (int m = 0; m < 4; ++m) _Pragma("unroll") for (int k = 0; k < 2; ++k) dst[m][k] = *(const PG8_LAS bf16x8*)(lds + PG8_SA(b, h) + aoff + m * 2048 + k * 1024); } while (0)
#define PG8_LDB(dst, b, h) do { _Pragma("unroll") for (int n = 0; n < 2; ++n) _Pragma("unroll") for (int k = 0; k < 2; ++k) dst[n][k] = *(const PG8_LAS bf16x8*)(lds + PG8_SB(b, h) + boff + n * 2048 + k * 1024); } while (0)
#define PG8_MMA(ai, bj, At, Bt) do { __builtin_amdgcn_s_setprio(1); _Pragma("unroll") for (int m = 0; m < 4; ++m) _Pragma("unroll") for (int n = 0; n < 2; ++n) _Pragma("unroll") for (int k = 0; k < 2; ++k) \
        acc[ai][bj][m][n] = __builtin_amdgcn_mfma_f32_16x16x32_bf16(Bt[n][k], At[m][k], acc[ai][bj][m][n], 0, 0, 0); __builtin_amdgcn_s_setprio(0); } while (0)
#define PG8_WAIT_V(n) asm volatile("s_waitcnt vmcnt(" #n ")" ::: "memory")
#define PG8_WAIT_L(n) asm volatile("s_waitcnt lgkmcnt(" #n ")" ::: "memory")
#define PG8_BAR __builtin_amdgcn_s_barrier()
#define PG8_SCHED __builtin_amdgcn_sched_barrier(0)
    Unit cur, nxt; int ui = 0;
    if (!S.next(0, cur)) return;
    f32x4 acc[2][2][4][2];
#pragma unroll
    for (int a = 0; a < 2; ++a)
#pragma unroll
        for (int b = 0; b < 2; ++b)
#pragma unroll
            for (int m = 0; m < 4; ++m)
#pragma unroll
                for (int n = 0; n < 2; ++n) acc[a][b][m][n] = (f32x4){0.f, 0.f, 0.f, 0.f};
    bf16x8 At[4][2], B0[2][2], B1[2][2];
    const char* cA = (const char*)g.A + (size_t)cur.pm * tstep; const char* cB = (const char*)g.Bt + (size_t)cur.pn * tstep;
    S.a_ready(cur);
    if constexpr (SP2) {
        PG8_STAGE(PG8_SB(0, 0), cB, voffB); PG8_STAGE(PG8_SB(0, 1), cB + hstep, voffB); PG8_STAGE(PG8_SA(0, 0), cA, voffA); PG8_STAGE(PG8_SA(0, 1), cA + hstep, voffA);
        if (wr == 1) PG8_BAR;
        PG8_WAIT_V(2); PG8_BAR;
        PG8_STAGE(PG8_SB(1, 0), cB + kstep, voffB); PG8_STAGE(PG8_SA(1, 0), cA + kstep, voffA); PG8_STAGE(PG8_SB(1, 1), cB + hstep + kstep, voffB);
        PG8_WAIT_V(6); PG8_BAR;
    } else {
        PG8_STAGE(PG8_SB(0, 0), cB, voffB); PG8_STAGE(PG8_SA(0, 0), cA, voffA); PG8_STAGE(PG8_SB(0, 1), cB + hstep, voffB); PG8_STAGE(PG8_SA(0, 1), cA + hstep, voffA);
        if (wr == 1) PG8_BAR;
        PG8_WAIT_V(4); PG8_BAR;
        PG8_STAGE(PG8_SB(1, 0), cB + kstep, voffB); PG8_STAGE(PG8_SA(1, 0), cA + kstep, voffA); PG8_STAGE(PG8_SB(1, 1), cB + hstep + kstep, voffB);
        PG8_WAIT_V(6); PG8_BAR;
    }
    for (;;) {
        const bool has_next = S.next(ui + 1, nxt);
        const char* nA = has_next ? (const char*)g.A + (size_t)nxt.pm * tstep : cA; const char* nB = has_next ? (const char*)g.Bt + (size_t)nxt.pn * tstep : cB;
        for (int t = 0; t < nt; t += 2) {
            const bool last = (t == nt - 2);
            const char* a1 = cA + (size_t)(t + 1) * kstep;
            const char* a2 = last ? nA : cA + (size_t)(t + 2) * kstep; const char* b2 = last ? nB : cB + (size_t)(t + 2) * kstep;
            const char* a3 = a2 + kstep; const char* b3 = b2 + kstep;
            if (last && has_next) S.a_ready(nxt);
            if constexpr (SP2) {
            PG8_LDB(B0, 0, 0); PG8_LDB(B1, 0, 1); PG8_SCHED; PG8_LDA(At, 0, 0); PG8_STAGE(PG8_SA(1, 1), a1 + hstep, voffA);
            PG8_WAIT_V(8); PG8_WAIT_L(0); PG8_BAR; PG8_MMA(0, 0, At, B0); PG8_MMA(0, 1, At, B1); PG8_BAR; PG8_SCHED;
            PG8_LDA(At, 0, 1); PG8_STAGE(PG8_SB(0, 0), b2, voffB); PG8_STAGE(PG8_SB(0, 1), b2 + hstep, voffB); PG8_STAGE(PG8_SA(0, 0), a2, voffA);
            PG8_WAIT_V(8); PG8_WAIT_L(0); PG8_BAR; PG8_MMA(1, 0, At, B0); PG8_MMA(1, 1, At, B1); PG8_BAR; PG8_SCHED;
            PG8_LDB(B0, 1, 0); PG8_LDB(B1, 1, 1); PG8_SCHED; PG8_LDA(At, 1, 0); PG8_STAGE(PG8_SA(0, 1), a2 + hstep, voffA);
            PG8_WAIT_V(8); PG8_WAIT_L(0); PG8_BAR; PG8_MMA(0, 0, At, B0); PG8_MMA(0, 1, At, B1); PG8_BAR; PG8_SCHED;
            PG8_LDA(At, 1, 1); PG8_STAGE(PG8_SB(1, 0), b3, voffB); PG8_STAGE(PG8_SB(1, 1), b3 + hstep, voffB); PG8_STAGE(PG8_SA(1, 0), a3, voffA);
            PG8_WAIT_V(8); PG8_WAIT_L(0); PG8_BAR; PG8_MMA(1, 0, At, B0); PG8_MMA(1, 1, At, B1); PG8_BAR; PG8_SCHED;
            } else {
            PG8_LDB(B0, 0, 0); PG8_SCHED; PG8_LDA(At, 0, 0); PG8_STAGE(PG8_SA(1, 1), a1 + hstep, voffA);
            PG8_WAIT_L(8); PG8_BAR; PG8_WAIT_L(0); PG8_MMA(0, 0, At, B0); PG8_BAR; PG8_SCHED;
            PG8_LDB(B1, 0, 1); PG8_STAGE(PG8_SB(0, 0), b2, voffB);
            PG8_BAR; PG8_WAIT_L(0); PG8_MMA(0, 1, At, B1); PG8_BAR;
            PG8_LDA(At, 0, 1); PG8_STAGE(PG8_SA(0, 0), a2, voffA);
            PG8_BAR; PG8_WAIT_L(0); PG8_MMA(1, 0, At, B0); PG8_BAR; PG8_SCHED;
            PG8_STAGE(PG8_SB(0, 1), b2 + hstep, voffB);
            PG8_WAIT_V(6); PG8_BAR; PG8_MMA(1, 1, At, B1); PG8_BAR;
            PG8_LDB(B0, 1, 0); PG8_SCHED; PG8_LDA(At, 1, 0); PG8_STAGE(PG8_SA(0, 1), a2 + hstep, voffA);
            PG8_WAIT_L(8); PG8_BAR; PG8_WAIT_L(0); PG8_MMA(0, 0, At, B0); PG8_BAR; PG8_SCHED;
            PG8_LDB(B1, 1, 1); PG8_STAGE(PG8_SB(1, 0), b3, voffB);
            PG8_BAR; PG8_WAIT_L(0); PG8_MMA(0, 1, At, B1); PG8_BAR;
            PG8_LDA(At, 1, 1); PG8_STAGE(PG8_SA(1, 0), a3, voffA);
            PG8_BAR; PG8_WAIT_L(0); PG8_MMA(1, 0, At, B0); PG8_BAR; PG8_SCHED;
            PG8_STAGE(PG8_SB(1, 1), b3 + hstep, voffB);
            PG8_WAIT_V(6); PG8_BAR; PG8_MMA(1, 1, At, B1); PG8_BAR;
            }
        }
        if constexpr (ALIGN_EPI) { if (wr == 0) PG8_BAR; }
        if constexpr (!Epi::AFTER_DRAIN) { E(acc, cur, wr, wc, fr, fq); S.done(cur); }
        if (!has_next) break;
#pragma unroll
        for (int a = 0; a < 2; ++a)
#pragma unroll
            for (int b = 0; b < 2; ++b)
#pragma unroll
                for (int m = 0; m < 4; ++m)
#pragma unroll
                    for (int n = 0; n < 2; ++n) acc[a][b][m][n] = (f32x4){0.f, 0.f, 0.f, 0.f};
        cur = nxt; cA = nA; cB = nB; ++ui;
        if constexpr (ALIGN_EPI) { if (wr == 1) PG8_BAR; }
    }
    PG8_WAIT_V(0);
    if constexpr (!ALIGN_EPI) { if (wr == 0) PG8_BAR; }
    PG8_BAR;
    if constexpr (Epi::AFTER_DRAIN) { E.fused(acc, cur, wr, wc, fr, fq, lds, wid, lane); S.done(cur); }
#undef PG8_SA
#undef PG8_SB
#undef PG8_STAGE
#undef PG8_LDA
#undef PG8_LDB
#undef PG8_MMA
#undef PG8_WAIT_V
#undef PG8_WAIT_L
#undef PG8_BAR
#undef PG8_SCHED
}
}

constexpr int NWAVES = 8;
constexpr int D = 2048, BATCH = 4, SEQ = 8192, DEPTH = 4, DECB = 8, DECS = 32;
constexpr int MP = BATCH * SEQ, MS = DECB * DECS, M = MP + MS;
constexpr int DIN = 5504, DINP = 5632;
constexpr int C_P = 0, C_GP = 512, C_Q = 1024, C_K = 2048, C_V = 2176, C_GA = 2304, C_XC = 3328, C_GR = 4992;
constexpr int DSH = 1664;
constexpr float NORM_EPS = 1e-5f, LNX_EPS = 1e-5f * 64.f;
constexpr size_t UPITCH_B = (size_t)DIN * 2;
constexpr size_t UXC_B = (size_t)C_XC * 2;
constexpr size_t O_YP = 0, O_YS = (size_t)MP * D, O_POOLP = O_YS + (size_t)MS * D;
constexpr size_t O_KP = O_POOLP + (size_t)DEPTH * BATCH * 15 * 512, O_VP = O_KP + (size_t)DEPTH * BATCH * 128 * 128;
constexpr size_t O_SHP = O_VP + (size_t)DEPTH * BATCH * 128 * 128, O_WKVP = O_SHP + (size_t)DEPTH * BATCH * DSH;
constexpr size_t O_POOLS = O_WKVP + (size_t)DEPTH * BATCH * 8 * 4096, O_KS = O_POOLS + (size_t)DEPTH * DECB * 15 * 512;
constexpr size_t O_VS = O_KS + (size_t)DEPTH * DECB * 128 * 128, O_SHS = O_VS + (size_t)DEPTH * DECB * 128 * 128;
constexpr size_t O_WKVS = O_SHS + (size_t)DEPTH * DECB * DSH, O_END = O_WKVS + (size_t)DEPTH * DECB * 8 * 4096;
constexpr size_t MiB = 1u << 20;
constexpr size_t WS_CTL = 0, CTL_ZERO_BYTES = 1 * MiB;
constexpr size_t WS_WINT = 1 * MiB;
constexpr size_t WS_WOUTT = WS_WINT + (size_t)DEPTH * DINP * D * 2;
constexpr size_t WS_PWT = WS_WOUTT + (size_t)DEPTH * D * D * 2;
constexpr size_t WS_BIAS = WS_PWT + (size_t)DEPTH * 4 * 128 * 128 * 2;
constexpr size_t WS_RK = WS_BIAS + 256 * 16 * 4;
constexpr size_t WS_SS = WS_RK + (size_t)M * 8 * 4;
constexpr size_t WS_XN = WS_SS + (size_t)5 * M * 4 + 1280;
constexpr size_t WS_U = WS_XN + (size_t)M * D * 2;
constexpr size_t WS_SCN = WS_U + (size_t)M * DIN * 2;
constexpr size_t WS_END = WS_SCN + (size_t)M * 3072 * 4;
static_assert(WS_END <= (size_t)1024 * MiB, "workspace map exceeds 1 GiB");
static_assert(WS_XN % 256 == 0 && WS_U % 256 == 0 && WS_SCN % 256 == 0 && WS_RK % 256 == 0 && WS_SS % 256 == 0, "alignment");
constexpr size_t WS_HB = WS_SCN;
constexpr int KSPLIT = 1280;
constexpr int CW_BAR = 4096, CW_SUB = 8192;
constexpr int RING_BYTES = 131072, LDSCTL_OFF = RING_BYTES, MISC_OFF = LDSCTL_OFF + 320, LDS_BYTES = 147456;

#define GAS __attribute__((address_space(1)))
#define LAS __attribute__((address_space(3)))
typedef unsigned short bf16;
typedef unsigned v4u __attribute__((ext_vector_type(4)));
typedef unsigned v2u __attribute__((ext_vector_type(2)));
typedef float f32x4 __attribute__((ext_vector_type(4)));
typedef float f32x16 __attribute__((ext_vector_type(16)));
typedef short bf16x8 __attribute__((ext_vector_type(8)));
typedef GAS unsigned gu32;
#define RLX_AGENT __ATOMIC_RELAXED, __HIP_MEMORY_SCOPE_AGENT
#define LDS_WAIT() asm volatile("s_waitcnt lgkmcnt(0)" ::: "memory")
#define VM_WAIT() asm volatile("s_waitcnt vmcnt(0)" ::: "memory")
__device__ __forceinline__ unsigned f2bf(float f) { unsigned u = __builtin_bit_cast(unsigned, f); return (u + 0x7fffu + ((u >> 16) & 1u)) >> 16; }
__device__ __forceinline__ unsigned pk2(float lo, float hi) { return f2bf(lo) | (f2bf(hi) << 16); }
__device__ __forceinline__ float bflo(unsigned w) { return __uint_as_float(w << 16); }
__device__ __forceinline__ float bfhi(unsigned w) { return __uint_as_float(w & 0xffff0000u); }
__device__ __forceinline__ float bf1(bf16 h) { return __uint_as_float(((unsigned)h) << 16); }
__device__ __forceinline__ float silu(float x) { return x / (1.f + __expf(-x)); }
__device__ __forceinline__ float shflx(float v, int mask, int lane) { return __int_as_float(__builtin_amdgcn_ds_bpermute((lane ^ mask) << 2, __float_as_int(v))); }
template <int CTRL> __device__ __forceinline__ float dpp_add(float x) {
    const int y = __builtin_amdgcn_update_dpp(0, __float_as_int(x), CTRL, 0xf, 0xf, true);
    return x + __int_as_float(y);
}
__device__ __forceinline__ float row16_sum(float x) {
    x = dpp_add<0xB1>(x);
    x = dpp_add<0x4E>(x);
    x = dpp_add<0x141>(x);
    x = dpp_add<0x140>(x);
    return x;
}
__device__ __forceinline__ float wave_sum_l(float v, int) {
    v = row16_sum(v);
    const int iv = __float_as_int(v);
    return (__int_as_float(__builtin_amdgcn_readlane(iv, 0)) + __int_as_float(__builtin_amdgcn_readlane(iv, 16))) + (__int_as_float(__builtin_amdgcn_readlane(iv, 32)) + __int_as_float(__builtin_amdgcn_readlane(iv, 48)));
}
#define XB_TMO      128
#define XB_XCNT(j)  (256  + 64 * (j))
#define XB_XSUB(j)  (1280 + 64 * (j))
#define XB_XGEN(j)  (2304 + 64 * (j))
#define XB_TOP      3328
#define XB_TOPGEN   3392
#define XCD_BAR_WORDS 3456
#define XB_SPIN_CAP (1u << 18)

__device__ __forceinline__ unsigned xb_ld(unsigned* p)              { return __hip_atomic_load(p, __ATOMIC_RELAXED, __HIP_MEMORY_SCOPE_AGENT); }
__device__ __forceinline__ unsigned xb_add(unsigned* p, unsigned v) { return __hip_atomic_fetch_add(p, v, __ATOMIC_RELAXED, __HIP_MEMORY_SCOPE_AGENT); }
__device__ __forceinline__ unsigned xb_xcc_id() { return (unsigned)__builtin_amdgcn_s_getreg((3 << 11) | 20) & 0xFu; }
#define XB_SPIN(cond, bar) do { unsigned _sp = 0; while (cond) { __builtin_amdgcn_s_sleep(1); \
    if ((++_sp & 255u) == 0u) { if (xb_ld(&(bar)[XB_TMO])) break; if (_sp > XB_SPIN_CAP) { atomicAdd(&(bar)[XB_TMO], 1u); break; } } } } while (0)

struct XcdBarrier {
    unsigned* bar; unsigned x;
    volatile LAS unsigned* st;
};

__device__ __forceinline__ XcdBarrier xcd_barrier_post(unsigned* bar, volatile LAS unsigned* st) {
    XcdBarrier b; b.bar = bar; b.x = xb_xcc_id(); b.st = st;
    if (threadIdx.x == 0) (void)xb_add(&bar[XB_XCNT(b.x)], 1u);
    return b;
}
__device__ __forceinline__ void xcd_barrier_complete(unsigned* bar, unsigned x, unsigned& nloc, unsigned& nx) {
    const unsigned G = gridDim.x * gridDim.y * gridDim.z;
    unsigned sum, cnt, mine, sp = 0u;
    for (;;) {
        sum = 0u; cnt = 0u; mine = 0u;
#pragma unroll
        for (unsigned j = 0; j < 16; ++j) { const unsigned c = xb_ld(&bar[XB_XCNT(j)]); sum += c; cnt += (c > 0u) ? 1u : 0u; mine = (j == x) ? c : mine; }
        if (sum == G) break;
        __builtin_amdgcn_s_sleep(1);
        if ((++sp & 255u) == 0u) { if (xb_ld(&bar[XB_TMO])) break; if (sp > XB_SPIN_CAP) { atomicAdd(&bar[XB_TMO], 1u); break; } }
    }
    nloc = mine > 0u ? mine : 1u; nx = cnt > 0u ? cnt : 1u;
}

__device__ __forceinline__ void xcd_barrier(const XcdBarrier& b) {
    asm volatile("s_waitcnt vmcnt(0)" ::: "memory");
    __syncthreads();
    if (threadIdx.x == 0) {
        unsigned* bar = b.bar;
        __builtin_amdgcn_s_waitcnt(0);
        unsigned nloc = b.st[0], nx = b.st[1];
        if (nloc == 0u) { xcd_barrier_complete(bar, b.x, nloc, nx); b.st[0] = nloc; b.st[1] = nx; }
        const unsigned old = xb_add(&bar[XB_XSUB(b.x)], 1u);
        const unsigned gen = old / nloc;
        if (old + 1u == (gen + 1u) * nloc) {
            __builtin_amdgcn_fence(__ATOMIC_RELEASE, "agent");
            asm volatile("s_waitcnt vmcnt(0)" ::: "memory");
            const unsigned og = xb_add(&bar[XB_TOP], 1u);
            const unsigned tg = og / nx;
            if (og + 1u == (tg + 1u) * nx) xb_add(&bar[XB_TOPGEN], 1u);
            else XB_SPIN(xb_ld(&bar[XB_TOPGEN]) == tg, bar);
            __builtin_amdgcn_fence(__ATOMIC_ACQUIRE, "agent");
            xb_add(&bar[XB_XGEN(b.x)], 1u);
            asm volatile("s_waitcnt vmcnt(0)" ::: "memory");
        } else {
            XB_SPIN(xb_ld(&bar[XB_XGEN(b.x)]) == gen, bar);
            __builtin_amdgcn_fence(__ATOMIC_ACQUIRE, "agent");
            asm volatile("s_waitcnt vmcnt(0)" ::: "memory");
        }
    }
    __syncthreads();
}

struct Args { const float* in[25]; float* out; unsigned char* ws; int ph_lo, ph_hi, coop, pad; };
struct Ctx { LAS unsigned char* lds; int tid, lane, wave, G, bid; };
enum { I_XP = 0, I_XS, I_SPOOL, I_CK, I_CV, I_SSHIFT, I_SWKV, I_NORMW, I_WIN, I_WOUT, I_POOLW, I_POOLS, I_SINKS, I_RELB, I_MU, I_W0, I_WUP, I_A0, I_AUP, I_KK, I_KA, I_RK, I_LNXW, I_LNXB, I_FNW };

#define WS_PTR(T, off) ((T*)(wsb + (off)))
#define WSB_DECL unsigned char* wsb = A.ws; asm volatile("" : "+s"(wsb))

__device__ __forceinline__ void transpose_item(const float* W, int K, int N, bf16* WT, LAS float* scr, int item, int lane, const float* kscale = nullptr) {
    const int nblk = N / 32, kb = item / nblk, nb = item % nblk, k0 = 64 * kb, n0 = 32 * nb;
    { f32x4 t[8]; float sc[8];
#pragma unroll
      for (int i = 0; i < 8; ++i) { const int kk = 8 * i + (lane >> 3); t[i] = *(const f32x4*)(W + (size_t)(k0 + kk) * N + n0 + 4 * (lane & 7)); sc[i] = kscale ? kscale[k0 + kk] : 1.0f; }
#pragma unroll
      for (int i = 0; i < 8; ++i) { const int kk = 8 * i + (lane >> 3); LAS float* d = scr + kk * 33 + 4 * (lane & 7); d[0] = t[i].x * sc[i]; d[1] = t[i].y * sc[i]; d[2] = t[i].z * sc[i]; d[3] = t[i].w * sc[i]; } }
    LDS_WAIT(); asm volatile("" ::: "memory");
    const int c = lane & 7;
#pragma unroll
    for (int j = 0; j < 4; ++j) { const int n = (lane >> 3) + 8 * j; const LAS float* s = scr + (8 * c) * 33 + n;
        v4u o; o.x = pk2(s[0 * 33], s[1 * 33]); o.y = pk2(s[2 * 33], s[3 * 33]); o.z = pk2(s[4 * 33], s[5 * 33]); o.w = pk2(s[6 * 33], s[7 * 33]);
        *(v4u*)(WT + (size_t)(n0 + n) * K + k0 + 8 * c) = o; }
    LDS_WAIT(); asm volatile("" ::: "memory");
}
__device__ __forceinline__ void norm_row(const float* src, const float* w, bf16* xn, float* hcopy, float* y, int lane) {
    const f32x4* xr = (const f32x4*)src + lane;
    f32x4 v[8]; float s = 0.f;
#pragma unroll
    for (int j = 0; j < 8; ++j) { v[j] = xr[64 * j]; s += (v[j].x * v[j].x + v[j].y * v[j].y) + (v[j].z * v[j].z + v[j].w * v[j].w); }
    const float rstd = 1.f / sqrtf(wave_sum_l(s, lane) * (1.f / D) + NORM_EPS);
    if (hcopy) {
#pragma unroll
        for (int j = 0; j < 8; ++j) ((f32x4*)hcopy + lane)[64 * j] = v[j];
    }
    const f32x4* wr = (const f32x4*)w + lane;
#pragma unroll
    for (int j = 0; j < 8; ++j) { const f32x4 ww = wr[64 * j]; const f32x4 o = v[j] * rstd * ww;
        if (xn) { v2u p; p.x = pk2(o.x, o.y); p.y = pk2(o.z, o.w); ((v2u*)xn + lane)[64 * j] = p; }
        if (y) ((f32x4*)y + lane)[64 * j] = o; }
}
__device__ __forceinline__ int t5_bucket(int rel) {
    const int n = rel < 0 ? -rel : rel; int v;
    if (n < 8) v = n; else v = 8 + (n >= 12) + (n >= 16) + (n >= 23) + (n >= 32) + (n >= 46) + (n >= 64) + (n >= 91);
    return (rel > 0 ? 16 : 0) + v;
}

__device__ __forceinline__ void phase_prologue(const Args& A, const Ctx& C0) {
    Ctx C = C0; C.tid = threadIdx.x; asm volatile("" : "+v"(C.tid)); asm volatile("" : "+s"(C.G), "+s"(C.bid)); C.lane = C.tid & 63; C.wave = __builtin_amdgcn_readfirstlane(C.tid >> 6);
    WSB_DECL;
    LAS float* scr = (LAS float*)(C.lds + C.wave * 16384);
    const int gw = C.bid * NWAVES + C.wave, NGW = C.G * NWAVES;
    constexpr int I_IN = (D / 64) * (DIN / 32), I_OUT = (D / 64) * (D / 32), I_PW = 4 * 8, PER_L = I_IN + I_OUT + I_PW;
    for (int it = gw; it < DEPTH * PER_L; it += NGW) {
        const int l = it / PER_L; int r = it % PER_L;
        if (r < I_IN) { transpose_item(A.in[I_WIN] + (size_t)l * D * DIN, D, DIN, WS_PTR(bf16, WS_WINT) + (size_t)l * DINP * D, scr, r, C.lane, A.in[I_NORMW] + (size_t)l * D); continue; } r -= I_IN;
        if (r < I_OUT) { transpose_item(A.in[I_WOUT] + (size_t)l * D * D, D, D, WS_PTR(bf16, WS_WOUTT) + (size_t)l * D * D, scr, r, C.lane); continue; } r -= I_OUT;
        { const int g = r >> 3; transpose_item(A.in[I_POOLW] + (size_t)(l * 4 + g) * 128 * 128, 128, 128, WS_PTR(bf16, WS_PWT) + (size_t)(l * 4 + g) * 128 * 128, scr, r & 7, C.lane); }
    }
    { const int gt = C.bid * 512 + C.tid, NGT = C.G * 512; constexpr int PER = (DINP - DIN) * D * 2 / 16;
      for (int i = gt; i < DEPTH * PER; i += NGT) { const int l = i / PER, r = i % PER; ((v4u*)(WS_PTR(bf16, WS_WINT) + (size_t)l * DINP * D + (size_t)DIN * D))[r] = (v4u){0u, 0u, 0u, 0u}; } }
    if (C.bid == 0) { float* B = WS_PTR(float, WS_BIAS);
        for (int i = C.tid; i < 256 * 16; i += 512) { const int ri = i >> 4, h = i & 15; const int rel = ri - 191; B[i] = (ri < 255) ? A.in[I_RELB][t5_bucket(rel) * 16 + h] : 0.f; } }
    { float* SS = WS_PTR(float, WS_SS); bf16* HB = WS_PTR(bf16, WS_HB);
      for (int m = gw; m < M; m += 2 * NGW) { const int m2 = (m + NGW < M) ? m + NGW : m;
          const float* srca = m < MP ? A.in[I_XP] + (size_t)m * D : A.in[I_XS] + (size_t)(m - MP) * D; const float* srcb = m2 < MP ? A.in[I_XP] + (size_t)m2 * D : A.in[I_XS] + (size_t)(m2 - MP) * D;
          const f32x4* xa = (const f32x4*)srca + C.lane; const f32x4* xb = (const f32x4*)srcb + C.lane; f32x4 va[8], vb[8]; float sa = 0.f, sb = 0.f;
#pragma unroll
          for (int j = 0; j < 8; ++j) { va[j] = xa[64 * j]; vb[j] = xb[64 * j]; }
#pragma unroll
          for (int j = 0; j < 8; ++j) { sa += (va[j].x * va[j].x + va[j].y * va[j].y) + (va[j].z * va[j].z + va[j].w * va[j].w); sb += (vb[j].x * vb[j].x + vb[j].y * vb[j].y) + (vb[j].z * vb[j].z + vb[j].w * vb[j].w); }
          sa = wave_sum_l(sa, C.lane); sb = wave_sum_l(sb, C.lane);
#pragma unroll
          for (int j = 0; j < 8; ++j) { v2u p; p.x = pk2(va[j].x, va[j].y); p.y = pk2(va[j].z, va[j].w); ((v2u*)(HB + (size_t)m * D) + C.lane)[64 * j] = p;
              if (m2 != m) { v2u q; q.x = pk2(vb[j].x, vb[j].y); q.y = pk2(vb[j].z, vb[j].w); ((v2u*)(HB + (size_t)m2 * D) + C.lane)[64 * j] = q; } }
          if (C.lane == 0) { SS[m] = sa; if (m2 != m) SS[m2] = sb; } }
      const int gt = C.bid * 512 + C.tid, NGT = C.G * 512;
      for (int i = gt; i < 4 * M; i += NGT) SS[M + i] = 0.f; }
}

__device__ __forceinline__ void phase_prep(const Args& A, const Ctx& C0, int l) {
    Ctx C = C0; C.tid = threadIdx.x; asm volatile("" : "+v"(C.tid)); asm volatile("" : "+s"(C.G), "+s"(C.bid)); C.lane = C.tid & 63; C.wave = __builtin_amdgcn_readfirstlane(C.tid >> 6);
    WSB_DECL;
    LAS float* raw = (LAS float*)C.lds;
    const bf16* U = WS_PTR(const bf16, WS_U);
    float* SCN = WS_PTR(float, WS_SCN); float* RKB = WS_PTR(float, WS_RK);
    const int c = C.tid, head = C.wave;
    bf16x8 wfr[2][4][2];
    { const int fr = C.lane & 15, fq = C.lane >> 4;
#pragma unroll
      for (int mat = 0; mat < 2; ++mat) { const float* W = A.in[mat ? I_AUP : I_WUP] + (size_t)l * 64 * 512 + head * 64 + fr;
#pragma unroll
          for (int ct = 0; ct < 4; ++ct)
#pragma unroll
              for (int ks = 0; ks < 2; ++ks) { const float* p = W + (size_t)(ks * 32 + 8 * fq) * 512 + ct * 16;
                  union { bf16x8 v; unsigned w[4]; } f;
#pragma unroll
                  for (int e = 0; e < 4; ++e) f.w[e] = pk2(p[(2 * e) * 512], p[(2 * e + 1) * 512]);
                  wfr[mat][ct][ks] = f.v; } } }
    LAS bf16* lob = (LAS bf16*)(C.lds + 9 * DSH * 4);
    LAS float* outw = (LAS float*)(C.lds + 9 * DSH * 4 + 16 * 136 * 2);
    LAS float* outa = outw + 8 * 512;
    const float w0 = A.in[I_W0][l * 512 + c], a0 = A.in[I_A0][l * 512 + c], kkc = A.in[I_KK][l * 512 + c], kac = A.in[I_KA][l * 512 + c], rkc = A.in[I_RK][l * 512 + c];
    const float* mul = A.in[I_MU] + (size_t)l * DSH;
    const float mu_r = mul[c], mu_k = mul[512 + c], mu_v = mul[1024 + c];
    v4u px[4];
#define PREP_FETCH(tl) do { const int _r0 = (tl) * 8; const bool _ss = _r0 < MP ? (_r0 % SEQ) == 0 : ((_r0 - MP) % DECS) == 0; \
        _Pragma("unroll") for (int _it = 0; _it < 4; ++_it) { const int _idx = C.tid + 512 * _it; const int _rr = _idx / 208, _v = _idx % 208; px[_it] = (v4u){0u, 0u, 0u, 0u}; \
            if (_idx < 9 * 208 && !(_rr == 0 && _ss)) px[_it] = *(const v4u*)(U + (size_t)(_r0 - 1 + _rr) * DIN + C_XC + _v * 8); } } while (0)
    if (C.bid < M / 8) PREP_FETCH(C.bid);
    for (int tile = C.bid; tile < M / 8; tile += C.G) {
        const int row0 = tile * 8;
        bool seq_start; const float* shiftp = nullptr;
        if (row0 < MP) seq_start = (row0 % SEQ) == 0; else { const int rs = row0 - MP; seq_start = (rs % DECS) == 0; shiftp = A.in[I_SSHIFT] + (size_t)(l * DECB + rs / DECS) * DSH; }
#pragma unroll
        for (int it = 0; it < 4; ++it) { const int idx = C.tid + 512 * it; const int rr = idx / 208, v = idx % 208;
            if (idx < 9 * 208) { const v4u x = px[it];
                f32x4 f0 = (f32x4){bflo(x.x), bfhi(x.x), bflo(x.y), bfhi(x.y)}, f1 = (f32x4){bflo(x.z), bfhi(x.z), bflo(x.w), bfhi(x.w)};
                if (rr == 0 && seq_start && shiftp) { f0 = *(const f32x4*)(shiftp + v * 8); f1 = *(const f32x4*)(shiftp + v * 8 + 4); }
                *(LAS f32x4*)(raw + rr * DSH + v * 8) = f0; *(LAS f32x4*)(raw + rr * DSH + v * 8 + 4) = f1; } }
        if (tile + C.G < M / 8) PREP_FETCH(tile + C.G);
        __syncthreads();
#pragma unroll
        for (int k = 0; k < 2; ++k) { const int idx = C.tid + 512 * k, tt = idx >> 7, j = idx & 127, i = 1536 + j;
            const float cur = raw[(tt + 1) * DSH + i], prev = raw[tt * DSH + i]; const float xs = cur + (prev - cur) * mul[i];
            float o = xs; if (j < 64) { const float e = __expf(2.f * xs); o = 1.f - 2.f / (e + 1.f); }
            lob[tt * 136 + j] = (bf16)f2bf(o); }
        __syncthreads();
        { const int fr = C.lane & 15, fq = C.lane >> 4;
#pragma unroll
          for (int mat = 0; mat < 2; ++mat) { bf16x8 af[2];
#pragma unroll
              for (int ks = 0; ks < 2; ++ks) af[ks] = *(const LAS bf16x8*)(lob + fr * 136 + mat * 64 + ks * 32 + 8 * fq);
#pragma unroll
              for (int ct = 0; ct < 4; ++ct) { f32x4 acc = (f32x4){0.f, 0.f, 0.f, 0.f};
#pragma unroll
                  for (int ks = 0; ks < 2; ++ks) acc = __builtin_amdgcn_mfma_f32_16x16x32_bf16(af[ks], wfr[mat][ct][ks], acc, 0, 0, 0);
                  if (fq < 2) { LAS float* o = (mat ? outa : outw) + (4 * fq) * 512 + head * 64 + ct * 16 + fr;
                      o[0] = acc[0]; o[512] = acc[1]; o[1024] = acc[2]; o[1536] = acc[3]; } } } }
        __syncthreads();
#pragma unroll 2
        for (int tt = 0; tt < 8; ++tt) {
            const float aw = outw[tt * 512 + c], aa = outa[tt * 512 + c];
            const int row = row0 + tt;
            const LAS float* cu = raw + (tt + 1) * DSH; const LAS float* pv = raw + tt * DSH;
            const float r = cu[c] + (pv[c] - cu[c]) * mu_r, k = cu[512 + c] + (pv[512 + c] - cu[512 + c]) * mu_k, v = cu[1024 + c] + (pv[1024 + c] - cu[1024 + c]) * mu_v;
            const float lw = w0 + aw; const float z = -lw;
            const float sp = fmaxf(z, 0.f) + logf(1.f + expf(-fabsf(z)));
            const float wraw = -sp - 0.5f; const float decay = expf(-expf(wraw));
            const float ai = 1.f / (1.f + expf(-(a0 + aa)));
            const float kkr = k * kkc; const float ss = wave_sum_l(kkr * kkr, C.lane);
            const float kk = kkr / fmaxf(sqrtf(ss), 1e-12f);
            const float k2 = k * (1.f + (ai - 1.f) * kac); const float b = kk * ai;
            const float rk = wave_sum_l(r * k2 * rkc, C.lane);
            float* s = SCN + (size_t)row * 3072 + head * 384 + C.lane;
            __builtin_nontemporal_store(kk, s); __builtin_nontemporal_store(b, s + 64); __builtin_nontemporal_store(decay, s + 128); __builtin_nontemporal_store(k2, s + 192); __builtin_nontemporal_store(r, s + 256); __builtin_nontemporal_store(v, s + 320);
            if (C.lane == 0) RKB[row * 8 + head] = rk;
        }
        { const int lastrow = row0 + 7; bool is_last; float* dst;
          if (lastrow < MP) { is_last = (lastrow % SEQ) == SEQ - 1; dst = A.out + O_SHP + (size_t)(l * BATCH + lastrow / SEQ) * DSH; }
          else { const int rs = lastrow - MP; is_last = (rs % DECS) == DECS - 1; dst = A.out + O_SHS + (size_t)(l * DECB + rs / DECS) * DSH; }
          if (is_last) for (int i = C.tid; i < DSH; i += 512) dst[i] = raw[8 * DSH + i]; }
        __syncthreads();
    }
    { const int gt = C.bid * 512 + C.tid, NGT = C.G * 512;
      constexpr int NP = BATCH * 128 * 2 * 32, NS = DECB * 128 * 2 * 32;
      for (int i = gt; i < NP + NS; i += NGT) {
          if (i < NP) { const int q4 = i & 31, kv = (i >> 5) & 1, j = (i >> 6) & 127, b = i >> 13;
              const v2u x = *(const v2u*)(U + (size_t)(b * SEQ + SEQ - 128 + j) * DIN + (kv ? C_V : C_K) + q4 * 4);
              float* dst = A.out + (kv ? O_VP : O_KP) + ((size_t)(l * BATCH + b) * 128 + j) * 128 + q4 * 4;
              *(f32x4*)dst = (f32x4){bflo(x.x), bfhi(x.x), bflo(x.y), bfhi(x.y)}; }
          else { const int ii = i - NP; const int q4 = ii & 31, kv = (ii >> 5) & 1, j = (ii >> 6) & 127, b = ii >> 13;
              float* dst = A.out + (kv ? O_VS : O_KS) + ((size_t)(l * DECB + b) * 128 + j) * 128 + q4 * 4;
              if (j < 96) *(f32x4*)dst = *(const f32x4*)(A.in[kv ? I_CV : I_CK] + ((size_t)(l * DECB + b) * 128 + j + 32) * 128 + q4 * 4);
              else { const v2u x = *(const v2u*)(U + (size_t)(MP + b * DECS + j - 96) * DIN + (kv ? C_V : C_K) + q4 * 4);
                  *(f32x4*)dst = (f32x4){bflo(x.x), bfhi(x.x), bflo(x.y), bfhi(x.y)}; } }
      } }
}
#define SCAN_CHUNK_ASM \
    "ds_read_b128 v[164:167], %6 offset:0\n\t" \
    "ds_read_b128 v[168:171], %6 offset:256\n\t" \
    "ds_read_b128 v[172:175], %6 offset:512\n\t" \
    "ds_read_b128 v[176:179], %6 offset:768\n\t" \
    "ds_read_b128 v[180:183], %6 offset:1024\n\t" \
    "ds_read_b32 v184, %7 offset:0\n\t" \
    "ds_read_b128 v[186:189], %6 offset:1536\n\t" \
    "ds_read_b128 v[190:193], %6 offset:1792\n\t" \
    "ds_read_b128 v[194:197], %6 offset:2048\n\t" \
    "ds_read_b128 v[198:201], %6 offset:2304\n\t" \
    "ds_read_b128 v[202:205], %6 offset:2560\n\t" \
    "ds_read_b32 v206, %7 offset:1536\n\t" \
    "s_waitcnt lgkmcnt(0)\n\t" \
    "v_mul_f32 v137, v184, v176\n\t" \
    "v_mul_f32 v138, v184, v177\n\t" \
    "v_mul_f32 v139, v184, v178\n\t" \
    "v_mul_f32 v140, v184, v179\n\t" \
    "v_mul_f32 v145, %0, v164\n\t" \
    "v_mul_f32 v146, %1, v165\n\t" \
    "v_fma_f32 v145, %2, v166, v145\n\t" \
    "v_fma_f32 v146, %3, v167, v146\n\t" \
    "v_add_f32 v145, v145, v146\n\t" \
    "ds_read_b128 v[208:211], %6 offset:3072\n\t" \
    "ds_read_b128 v[212:215], %6 offset:3328\n\t" \
    "ds_read_b128 v[216:219], %6 offset:3584\n\t" \
    "ds_read_b128 v[220:223], %6 offset:3840\n\t" \
    "ds_read_b128 v[224:227], %6 offset:4096\n\t" \
    "ds_read_b32 v228, %7 offset:3072\n\t" \
    "s_waitcnt lgkmcnt(6)\n\t" \
    "v_add_f32_dpp v145, v145, v145 quad_perm:[1,0,3,2] row_mask:0xf bank_mask:0xf bound_ctrl:1\n\t" \
    "s_nop 0\n\t" \
    "s_nop 0\n\t" \
    "v_add_f32_dpp v145, v145, v145 quad_perm:[2,3,0,1] row_mask:0xf bank_mask:0xf bound_ctrl:1\n\t" \
    "s_nop 0\n\t" \
    "s_nop 0\n\t" \
    "v_add_f32_dpp v145, v145, v145 row_half_mirror row_mask:0xf bank_mask:0xf bound_ctrl:1\n\t" \
    "s_nop 0\n\t" \
    "s_nop 0\n\t" \
    "v_add_f32_dpp v145, v145, v145 row_mirror row_mask:0xf bank_mask:0xf bound_ctrl:1\n\t" \
    "v_fma_f32 v137, -v145, v168, v137\n\t" \
    "v_fma_f32 v138, -v145, v169, v138\n\t" \
    "v_fma_f32 v139, -v145, v170, v139\n\t" \
    "v_fma_f32 v140, -v145, v171, v140\n\t" \
    "v_fma_f32 %0, %0, v172, v137\n\t" \
    "v_fma_f32 %1, %1, v173, v138\n\t" \
    "v_fma_f32 %2, %2, v174, v139\n\t" \
    "v_fma_f32 %3, %3, v175, v140\n\t" \
    "v_mul_f32 v137, v206, v198\n\t" \
    "v_mul_f32 v138, v206, v199\n\t" \
    "v_mul_f32 v139, v206, v200\n\t" \
    "v_mul_f32 v140, v206, v201\n\t" \
    "v_mul_f32 v145, %0, v186\n\t" \
    "v_mul_f32 v146, %1, v187\n\t" \
    "v_fma_f32 v145, %2, v188, v145\n\t" \
    "v_fma_f32 v146, %3, v189, v146\n\t" \
    "v_add_f32 v145, v145, v146\n\t" \
    "ds_read_b128 v[230:233], %6 offset:4608\n\t" \
    "ds_read_b128 v[234:237], %6 offset:4864\n\t" \
    "ds_read_b128 v[238:241], %6 offset:5120\n\t" \
    "ds_read_b128 v[242:245], %6 offset:5376\n\t" \
    "ds_read_b128 v[246:249], %6 offset:5632\n\t" \
    "ds_read_b32 v250, %7 offset:4608\n\t" \
    "s_waitcnt lgkmcnt(6)\n\t" \
    "v_add_f32_dpp v145, v145, v145 quad_perm:[1,0,3,2] row_mask:0xf bank_mask:0xf bound_ctrl:1\n\t" \
    "v_mul_f32 v148, %0, v180\n\t" \
    "v_mul_f32 v146, %1, v181\n\t" \
    "v_add_f32_dpp v145, v145, v145 quad_perm:[2,3,0,1] row_mask:0xf bank_mask:0xf bound_ctrl:1\n\t" \
    "v_fma_f32 v148, %2, v182, v148\n\t" \
    "v_fma_f32 v146, %3, v183, v146\n\t" \
    "v_add_f32_dpp v145, v145, v145 row_half_mirror row_mask:0xf bank_mask:0xf bound_ctrl:1\n\t" \
    "v_add_f32 v148, v148, v146\n\t" \
    "s_nop 0\n\t" \
    "v_add_f32_dpp v145, v145, v145 row_mirror row_mask:0xf bank_mask:0xf bound_ctrl:1\n\t" \
    "v_fma_f32 v137, -v145, v190, v137\n\t" \
    "v_fma_f32 v138, -v145, v191, v138\n\t" \
    "v_fma_f32 v139, -v145, v192, v139\n\t" \
    "v_fma_f32 v140, -v145, v193, v140\n\t" \
    "v_fma_f32 %0, %0, v194, v137\n\t" \
    "v_fma_f32 %1, %1, v195, v138\n\t" \
    "v_fma_f32 %2, %2, v196, v139\n\t" \
    "v_fma_f32 %3, %3, v197, v140\n\t" \
    "v_mul_f32 v137, v228, v220\n\t" \
    "v_mul_f32 v138, v228, v221\n\t" \
    "v_mul_f32 v139, v228, v222\n\t" \
    "v_mul_f32 v140, v228, v223\n\t" \
    "v_mul_f32 v145, %0, v208\n\t" \
    "v_mul_f32 v146, %1, v209\n\t" \
    "v_fma_f32 v145, %2, v210, v145\n\t" \
    "v_fma_f32 v146, %3, v211, v146\n\t" \
    "v_add_f32 v145, v145, v146\n\t" \
    "ds_read_b128 v[164:167], %6 offset:6144\n\t" \
    "ds_read_b128 v[168:171], %6 offset:6400\n\t" \
    "ds_read_b128 v[172:175], %6 offset:6656\n\t" \
    "ds_read_b128 v[176:179], %6 offset:6912\n\t" \
    "ds_read_b128 v[180:183], %6 offset:7168\n\t" \
    "ds_read_b32 v184, %7 offset:6144\n\t" \
    "s_waitcnt lgkmcnt(6)\n\t" \
    "v_add_f32_dpp v145, v145, v145 quad_perm:[1,0,3,2] row_mask:0xf bank_mask:0xf bound_ctrl:1\n\t" \
    "v_mul_f32 v149, %0, v202\n\t" \
    "v_mul_f32 v146, %1, v203\n\t" \
    "v_add_f32_dpp v145, v145, v145 quad_perm:[2,3,0,1] row_mask:0xf bank_mask:0xf bound_ctrl:1\n\t" \
    "v_fma_f32 v149, %2, v204, v149\n\t" \
    "v_fma_f32 v146, %3, v205, v146\n\t" \
    "v_add_f32_dpp v145, v145, v145 row_half_mirror row_mask:0xf bank_mask:0xf bound_ctrl:1\n\t" \
    "v_add_f32 v149, v149, v146\n\t" \
    "s_nop 0\n\t" \
    "v_add_f32_dpp v145, v145, v145 row_mirror row_mask:0xf bank_mask:0xf bound_ctrl:1\n\t" \
    "v_fma_f32 v137, -v145, v212, v137\n\t" \
    "v_fma_f32 v138, -v145, v213, v138\n\t" \
    "v_fma_f32 v139, -v145, v214, v139\n\t" \
    "v_fma_f32 v140, -v145, v215, v140\n\t" \
    "v_fma_f32 %0, %0, v216, v137\n\t" \
    "v_fma_f32 %1, %1, v217, v138\n\t" \
    "v_fma_f32 %2, %2, v218, v139\n\t" \
    "v_fma_f32 %3, %3, v219, v140\n\t" \
    "v_mul_f32 v137, v250, v242\n\t" \
    "v_mul_f32 v138, v250, v243\n\t" \
    "v_mul_f32 v139, v250, v244\n\t" \
    "v_mul_f32 v140, v250, v245\n\t" \
    "v_mul_f32 v145, %0, v230\n\t" \
    "v_mul_f32 v146, %1, v231\n\t" \
    "v_fma_f32 v145, %2, v232, v145\n\t" \
    "v_fma_f32 v146, %3, v233, v146\n\t" \
    "v_add_f32 v145, v145, v146\n\t" \
    "ds_read_b128 v[186:189], %6 offset:7680\n\t" \
    "ds_read_b128 v[190:193], %6 offset:7936\n\t" \
    "ds_read_b128 v[194:197], %6 offset:8192\n\t" \
    "ds_read_b128 v[198:201], %6 offset:8448\n\t" \
    "ds_read_b128 v[202:205], %6 offset:8704\n\t" \
    "ds_read_b32 v206, %7 offset:7680\n\t" \
    "s_waitcnt lgkmcnt(6)\n\t" \
    "v_add_f32_dpp v145, v145, v145 quad_perm:[1,0,3,2] row_mask:0xf bank_mask:0xf bound_ctrl:1\n\t" \
    "v_mul_f32 v150, %0, v224\n\t" \
    "v_mul_f32 v146, %1, v225\n\t" \
    "v_add_f32_dpp v145, v145, v145 quad_perm:[2,3,0,1] row_mask:0xf bank_mask:0xf bound_ctrl:1\n\t" \
    "v_fma_f32 v150, %2, v226, v150\n\t" \
    "v_fma_f32 v146, %3, v227, v146\n\t" \
    "v_add_f32_dpp v145, v145, v145 row_half_mirror row_mask:0xf bank_mask:0xf bound_ctrl:1\n\t" \
    "v_add_f32 v150, v150, v146\n\t" \
    "s_nop 0\n\t" \
    "v_add_f32_dpp v145, v145, v145 row_mirror row_mask:0xf bank_mask:0xf bound_ctrl:1\n\t" \
    "v_fma_f32 v137, -v145, v234, v137\n\t" \
    "v_fma_f32 v138, -v145, v235, v138\n\t" \
    "v_fma_f32 v139, -v145, v236, v139\n\t" \
    "v_fma_f32 v140, -v145, v237, v140\n\t" \
    "v_fma_f32 %0, %0, v238, v137\n\t" \
    "v_fma_f32 %1, %1, v239, v138\n\t" \
    "v_fma_f32 %2, %2, v240, v139\n\t" \
    "v_fma_f32 %3, %3, v241, v140\n\t" \
    "v_mul_f32 v137, v184, v176\n\t" \
    "v_mul_f32 v138, v184, v177\n\t" \
    "v_mul_f32 v139, v184, v178\n\t" \
    "v_mul_f32 v140, v184, v179\n\t" \
    "v_mul_f32 v145, %0, v164\n\t" \
    "v_mul_f32 v146, %1, v165\n\t" \
    "v_fma_f32 v145, %2, v166, v145\n\t" \
    "v_fma_f32 v146, %3, v167, v146\n\t" \
    "v_add_f32 v145, v145, v146\n\t" \
    "ds_read_b128 v[208:211], %6 offset:9216\n\t" \
    "ds_read_b128 v[212:215], %6 offset:9472\n\t" \
    "ds_read_b128 v[216:219], %6 offset:9728\n\t" \
    "ds_read_b128 v[220:223], %6 offset:9984\n\t" \
    "ds_read_b128 v[224:227], %6 offset:10240\n\t" \
    "ds_read_b32 v228, %7 offset:9216\n\t" \
    "s_waitcnt lgkmcnt(6)\n\t" \
    "v_add_f32_dpp v145, v145, v145 quad_perm:[1,0,3,2] row_mask:0xf bank_mask:0xf bound_ctrl:1\n\t" \
    "v_mul_f32 v151, %0, v246\n\t" \
    "v_mul_f32 v146, %1, v247\n\t" \
    "v_add_f32_dpp v145, v145, v145 quad_perm:[2,3,0,1] row_mask:0xf bank_mask:0xf bound_ctrl:1\n\t" \
    "v_fma_f32 v151, %2, v248, v151\n\t" \
    "v_fma_f32 v146, %3, v249, v146\n\t" \
    "v_add_f32_dpp v145, v145, v145 row_half_mirror row_mask:0xf bank_mask:0xf bound_ctrl:1\n\t" \
    "v_add_f32 v151, v151, v146\n\t" \
    "s_nop 0\n\t" \
    "v_add_f32_dpp v145, v145, v145 row_mirror row_mask:0xf bank_mask:0xf bound_ctrl:1\n\t" \
    "v_fma_f32 v137, -v145, v168, v137\n\t" \
    "v_fma_f32 v138, -v145, v169, v138\n\t" \
    "v_fma_f32 v139, -v145, v170, v139\n\t" \
    "v_fma_f32 v140, -v145, v171, v140\n\t" \
    "v_fma_f32 %0, %0, v172, v137\n\t" \
    "v_fma_f32 %1, %1, v173, v138\n\t" \
    "v_fma_f32 %2, %2, v174, v139\n\t" \
    "v_fma_f32 %3, %3, v175, v140\n\t" \
    "v_mul_f32 v137, v206, v198\n\t" \
    "v_mul_f32 v138, v206, v199\n\t" \
    "v_mul_f32 v139, v206, v200\n\t" \
    "v_mul_f32 v140, v206, v201\n\t" \
    "v_mul_f32 v145, %0, v186\n\t" \
    "v_mul_f32 v146, %1, v187\n\t" \
    "v_fma_f32 v145, %2, v188, v145\n\t" \
    "v_fma_f32 v146, %3, v189, v146\n\t" \
    "v_add_f32 v145, v145, v146\n\t" \
    "ds_read_b128 v[230:233], %6 offset:10752\n\t" \
    "ds_read_b128 v[234:237], %6 offset:11008\n\t" \
    "ds_read_b128 v[238:241], %6 offset:11264\n\t" \
    "ds_read_b128 v[242:245], %6 offset:11520\n\t" \
    "ds_read_b128 v[246:249], %6 offset:11776\n\t" \
    "ds_read_b32 v250, %7 offset:10752\n\t" \
    "s_waitcnt lgkmcnt(6)\n\t" \
    "v_add_f32_dpp v145, v145, v145 quad_perm:[1,0,3,2] row_mask:0xf bank_mask:0xf bound_ctrl:1\n\t" \
    "v_mul_f32 v152, %0, v180\n\t" \
    "v_mul_f32 v146, %1, v181\n\t" \
    "v_add_f32_dpp v145, v145, v145 quad_perm:[2,3,0,1] row_mask:0xf bank_mask:0xf bound_ctrl:1\n\t" \
    "v_fma_f32 v152, %2, v182, v152\n\t" \
    "v_fma_f32 v146, %3, v183, v146\n\t" \
    "v_add_f32_dpp v145, v145, v145 row_half_mirror row_mask:0xf bank_mask:0xf bound_ctrl:1\n\t" \
    "v_add_f32 v152, v152, v146\n\t" \
    "s_nop 0\n\t" \
    "v_add_f32_dpp v145, v145, v145 row_mirror row_mask:0xf bank_mask:0xf bound_ctrl:1\n\t" \
    "v_fma_f32 v137, -v145, v190, v137\n\t" \
    "v_fma_f32 v138, -v145, v191, v138\n\t" \
    "v_fma_f32 v139, -v145, v192, v139\n\t" \
    "v_fma_f32 v140, -v145, v193, v140\n\t" \
    "v_fma_f32 %0, %0, v194, v137\n\t" \
    "v_fma_f32 %1, %1, v195, v138\n\t" \
    "v_fma_f32 %2, %2, v196, v139\n\t" \
    "v_fma_f32 %3, %3, v197, v140\n\t" \
    "v_mul_f32 v137, v228, v220\n\t" \
    "v_mul_f32 v138, v228, v221\n\t" \
    "v_mul_f32 v139, v228, v222\n\t" \
    "v_mul_f32 v140, v228, v223\n\t" \
    "v_mul_f32 v145, %0, v208\n\t" \
    "v_mul_f32 v146, %1, v209\n\t" \
    "v_fma_f32 v145, %2, v210, v145\n\t" \
    "v_fma_f32 v146, %3, v211, v146\n\t" \
    "v_add_f32 v145, v145, v146\n\t" \
    "ds_read_b128 v[164:167], %6 offset:12288\n\t" \
    "ds_read_b128 v[168:171], %6 offset:12544\n\t" \
    "ds_read_b128 v[172:175], %6 offset:12800\n\t" \
    "ds_read_b128 v[176:179], %6 offset:13056\n\t" \
    "ds_read_b128 v[180:183], %6 offset:13312\n\t" \
    "ds_read_b32 v184, %7 offset:12288\n\t" \
    "s_waitcnt lgkmcnt(6)\n\t" \
    "v_add_f32_dpp v145, v145, v145 quad_perm:[1,0,3,2] row_mask:0xf bank_mask:0xf bound_ctrl:1\n\t" \
    "v_mul_f32 v153, %0, v202\n\t" \
    "v_mul_f32 v146, %1, v203\n\t" \
    "v_add_f32_dpp v145, v145, v145 quad_perm:[2,3,0,1] row_mask:0xf bank_mask:0xf bound_ctrl:1\n\t" \
    "v_fma_f32 v153, %2, v204, v153\n\t" \
    "v_fma_f32 v146, %3, v205, v146\n\t" \
    "v_add_f32_dpp v145, v145, v145 row_half_mirror row_mask:0xf bank_mask:0xf bound_ctrl:1\n\t" \
    "v_add_f32 v153, v153, v146\n\t" \
    "s_nop 0\n\t" \
    "v_add_f32_dpp v145, v145, v145 row_mirror row_mask:0xf bank_mask:0xf bound_ctrl:1\n\t" \
    "v_fma_f32 v137, -v145, v212, v137\n\t" \
    "v_fma_f32 v138, -v145, v213, v138\n\t" \
    "v_fma_f32 v139, -v145, v214, v139\n\t" \
    "v_fma_f32 v140, -v145, v215, v140\n\t" \
    "v_fma_f32 %0, %0, v216, v137\n\t" \
    "v_fma_f32 %1, %1, v217, v138\n\t" \
    "v_fma_f32 %2, %2, v218, v139\n\t" \
    "v_fma_f32 %3, %3, v219, v140\n\t" \
    "v_mul_f32 v137, v250, v242\n\t" \
    "v_mul_f32 v138, v250, v243\n\t" \
    "v_mul_f32 v139, v250, v244\n\t" \
    "v_mul_f32 v140, v250, v245\n\t" \
    "v_mul_f32 v145, %0, v230\n\t" \
    "v_mul_f32 v146, %1, v231\n\t" \
    "v_fma_f32 v145, %2, v232, v145\n\t" \
    "v_fma_f32 v146, %3, v233, v146\n\t" \
    "v_add_f32 v145, v145, v146\n\t" \
    "ds_read_b128 v[186:189], %6 offset:13824\n\t" \
    "ds_read_b128 v[190:193], %6 offset:14080\n\t" \
    "ds_read_b128 v[194:197], %6 offset:14336\n\t" \
    "ds_read_b128 v[198:201], %6 offset:14592\n\t" \
    "ds_read_b128 v[202:205], %6 offset:14848\n\t" \
    "ds_read_b32 v206, %7 offset:13824\n\t" \
    "s_waitcnt lgkmcnt(6)\n\t" \
    "v_add_f32_dpp v145, v145, v145 quad_perm:[1,0,3,2] row_mask:0xf bank_mask:0xf bound_ctrl:1\n\t" \
    "v_mul_f32 v154, %0, v224\n\t" \
    "v_mul_f32 v146, %1, v225\n\t" \
    "v_add_f32_dpp v145, v145, v145 quad_perm:[2,3,0,1] row_mask:0xf bank_mask:0xf bound_ctrl:1\n\t" \
    "v_fma_f32 v154, %2, v226, v154\n\t" \
    "v_fma_f32 v146, %3, v227, v146\n\t" \
    "v_add_f32_dpp v145, v145, v145 row_half_mirror row_mask:0xf bank_mask:0xf bound_ctrl:1\n\t" \
    "v_add_f32 v154, v154, v146\n\t" \
    "s_nop 0\n\t" \
    "v_add_f32_dpp v145, v145, v145 row_mirror row_mask:0xf bank_mask:0xf bound_ctrl:1\n\t" \
    "v_fma_f32 v137, -v145, v234, v137\n\t" \
    "v_fma_f32 v138, -v145, v235, v138\n\t" \
    "v_fma_f32 v139, -v145, v236, v139\n\t" \
    "v_fma_f32 v140, -v145, v237, v140\n\t" \
    "v_fma_f32 %0, %0, v238, v137\n\t" \
    "v_fma_f32 %1, %1, v239, v138\n\t" \
    "v_fma_f32 %2, %2, v240, v139\n\t" \
    "v_fma_f32 %3, %3, v241, v140\n\t" \
    "v_mul_f32 v137, v184, v176\n\t" \
    "v_mul_f32 v138, v184, v177\n\t" \
    "v_mul_f32 v139, v184, v178\n\t" \
    "v_mul_f32 v140, v184, v179\n\t" \
    "v_mul_f32 v145, %0, v164\n\t" \
    "v_mul_f32 v146, %1, v165\n\t" \
    "v_fma_f32 v145, %2, v166, v145\n\t" \
    "v_fma_f32 v146, %3, v167, v146\n\t" \
    "v_add_f32 v145, v145, v146\n\t" \
    "ds_read_b128 v[208:211], %6 offset:15360\n\t" \
    "ds_read_b128 v[212:215], %6 offset:15616\n\t" \
    "ds_read_b128 v[216:219], %6 offset:15872\n\t" \
    "ds_read_b128 v[220:223], %6 offset:16128\n\t" \
    "ds_read_b128 v[224:227], %6 offset:16384\n\t" \
    "ds_read_b32 v228, %7 offset:15360\n\t" \
    "s_waitcnt lgkmcnt(6)\n\t" \
    "v_add_f32_dpp v145, v145, v145 quad_perm:[1,0,3,2] row_mask:0xf bank_mask:0xf bound_ctrl:1\n\t" \
    "v_mul_f32 v155, %0, v246\n\t" \
    "v_mul_f32 v146, %1, v247\n\t" \
    "v_add_f32_dpp v145, v145, v145 quad_perm:[2,3,0,1] row_mask:0xf bank_mask:0xf bound_ctrl:1\n\t" \
    "v_fma_f32 v155, %2, v248, v155\n\t" \
    "v_fma_f32 v146, %3, v249, v146\n\t" \
    "v_add_f32_dpp v145, v145, v145 row_half_mirror row_mask:0xf bank_mask:0xf bound_ctrl:1\n\t" \
    "v_add_f32 v155, v155, v146\n\t" \
    "s_nop 0\n\t" \
    "v_add_f32_dpp v145, v145, v145 row_mirror row_mask:0xf bank_mask:0xf bound_ctrl:1\n\t" \
    "v_fma_f32 v137, -v145, v168, v137\n\t" \
    "v_fma_f32 v138, -v145, v169, v138\n\t" \
    "v_fma_f32 v139, -v145, v170, v139\n\t" \
    "v_fma_f32 v140, -v145, v171, v140\n\t" \
    "v_fma_f32 %0, %0, v172, v137\n\t" \
    "v_fma_f32 %1, %1, v173, v138\n\t" \
    "v_fma_f32 %2, %2, v174, v139\n\t" \
    "v_fma_f32 %3, %3, v175, v140\n\t" \
    "v_mul_f32 v137, v206, v198\n\t" \
    "v_mul_f32 v138, v206, v199\n\t" \
    "v_mul_f32 v139, v206, v200\n\t" \
    "v_mul_f32 v140, v206, v201\n\t" \
    "v_mul_f32 v145, %0, v186\n\t" \
    "v_mul_f32 v146, %1, v187\n\t" \
    "v_fma_f32 v145, %2, v188, v145\n\t" \
    "v_fma_f32 v146, %3, v189, v146\n\t" \
    "v_add_f32 v145, v145, v146\n\t" \
    "ds_read_b128 v[230:233], %6 offset:16896\n\t" \
    "ds_read_b128 v[234:237], %6 offset:17152\n\t" \
    "ds_read_b128 v[238:241], %6 offset:17408\n\t" \
    "ds_read_b128 v[242:245], %6 offset:17664\n\t" \
    "ds_read_b128 v[246:249], %6 offset:17920\n\t" \
    "ds_read_b32 v250, %7 offset:16896\n\t" \
    "s_waitcnt lgkmcnt(6)\n\t" \
    "v_add_f32_dpp v145, v145, v145 quad_perm:[1,0,3,2] row_mask:0xf bank_mask:0xf bound_ctrl:1\n\t" \
    "v_mul_f32 v156, %0, v180\n\t" \
    "v_mul_f32 v146, %1, v181\n\t" \
    "v_add_f32_dpp v145, v145, v145 quad_perm:[2,3,0,1] row_mask:0xf bank_mask:0xf bound_ctrl:1\n\t" \
    "v_fma_f32 v156, %2, v182, v156\n\t" \
    "v_fma_f32 v146, %3, v183, v146\n\t" \
    "v_add_f32_dpp v145, v145, v145 row_half_mirror row_mask:0xf bank_mask:0xf bound_ctrl:1\n\t" \
    "v_add_f32 v156, v156, v146\n\t" \
    "s_nop 0\n\t" \
    "v_add_f32_dpp v145, v145, v145 row_mirror row_mask:0xf bank_mask:0xf bound_ctrl:1\n\t" \
    "v_fma_f32 v137, -v145, v190, v137\n\t" \
    "v_fma_f32 v138, -v145, v191, v138\n\t" \
    "v_fma_f32 v139, -v145, v192, v139\n\t" \
    "v_fma_f32 v140, -v145, v193, v140\n\t" \
    "v_fma_f32 %0, %0, v194, v137\n\t" \
    "v_fma_f32 %1, %1, v195, v138\n\t" \
    "v_fma_f32 %2, %2, v196, v139\n\t" \
    "v_fma_f32 %3, %3, v197, v140\n\t" \
    "v_mul_f32 v137, v228, v220\n\t" \
    "v_mul_f32 v138, v228, v221\n\t" \
    "v_mul_f32 v139, v228, v222\n\t" \
    "v_mul_f32 v140, v228, v223\n\t" \
    "v_mul_f32 v145, %0, v208\n\t" \
    "v_mul_f32 v146, %1, v209\n\t" \
    "v_fma_f32 v145, %2, v210, v145\n\t" \
    "v_fma_f32 v146, %3, v211, v146\n\t" \
    "v_add_f32 v145, v145, v146\n\t" \
    "ds_read_b128 v[164:167], %6 offset:18432\n\t" \
    "ds_read_b128 v[168:171], %6 offset:18688\n\t" \
    "ds_read_b128 v[172:175], %6 offset:18944\n\t" \
    "ds_read_b128 v[176:179], %6 offset:19200\n\t" \
    "ds_read_b128 v[180:183], %6 offset:19456\n\t" \
    "ds_read_b32 v184, %7 offset:18432\n\t" \
    "s_waitcnt lgkmcnt(6)\n\t" \
    "v_add_f32_dpp v145, v145, v145 quad_perm:[1,0,3,2] row_mask:0xf bank_mask:0xf bound_ctrl:1\n\t" \
    "v_mul_f32 v157, %0, v202\n\t" \
    "v_mul_f32 v146, %1, v203\n\t" \
    "v_add_f32_dpp v145, v145, v145 quad_perm:[2,3,0,1] row_mask:0xf bank_mask:0xf bound_ctrl:1\n\t" \
    "v_fma_f32 v157, %2, v204, v157\n\t" \
    "v_fma_f32 v146, %3, v205, v146\n\t" \
    "v_add_f32_dpp v145, v145, v145 row_half_mirror row_mask:0xf bank_mask:0xf bound_ctrl:1\n\t" \
    "v_add_f32 v157, v157, v146\n\t" \
    "s_nop 0\n\t" \
    "v_add_f32_dpp v145, v145, v145 row_mirror row_mask:0xf bank_mask:0xf bound_ctrl:1\n\t" \
    "v_fma_f32 v137, -v145, v212, v137\n\t" \
    "v_fma_f32 v138, -v145, v213, v138\n\t" \
    "v_fma_f32 v139, -v145, v214, v139\n\t" \
    "v_fma_f32 v140, -v145, v215, v140\n\t" \
    "v_fma_f32 %0, %0, v216, v137\n\t" \
    "v_fma_f32 %1, %1, v217, v138\n\t" \
    "v_fma_f32 %2, %2, v218, v139\n\t" \
    "v_fma_f32 %3, %3, v219, v140\n\t" \
    "v_mul_f32 v137, v250, v242\n\t" \
    "v_mul_f32 v138, v250, v243\n\t" \
    "v_mul_f32 v139, v250, v244\n\t" \
    "v_mul_f32 v140, v250, v245\n\t" \
    "v_mul_f32 v145, %0, v230\n\t" \
    "v_mul_f32 v146, %1, v231\n\t" \
    "v_fma_f32 v145, %2, v232, v145\n\t" \
    "v_fma_f32 v146, %3, v233, v146\n\t" \
    "v_add_f32 v145, v145, v146\n\t" \
    "ds_read_b128 v[186:189], %6 offset:19968\n\t" \
    "ds_read_b128 v[190:193], %6 offset:20224\n\t" \
    "ds_read_b128 v[194:197], %6 offset:20480\n\t" \
    "ds_read_b128 v[198:201], %6 offset:20736\n\t" \
    "ds_read_b128 v[202:205], %6 offset:20992\n\t" \
    "ds_read_b32 v206, %7 offset:19968\n\t" \
    "s_waitcnt lgkmcnt(6)\n\t" \
    "v_add_f32_dpp v145, v145, v145 quad_perm:[1,0,3,2] row_mask:0xf bank_mask:0xf bound_ctrl:1\n\t" \
    "v_mul_f32 v158, %0, v224\n\t" \
    "v_mul_f32 v146, %1, v225\n\t" \
    "v_add_f32_dpp v145, v145, v145 quad_perm:[2,3,0,1] row_mask:0xf bank_mask:0xf bound_ctrl:1\n\t" \
    "v_fma_f32 v158, %2, v226, v158\n\t" \
    "v_fma_f32 v146, %3, v227, v146\n\t" \
    "v_add_f32_dpp v145, v145, v145 row_half_mirror row_mask:0xf bank_mask:0xf bound_ctrl:1\n\t" \
    "v_add_f32 v158, v158, v146\n\t" \
    "s_nop 0\n\t" \
    "v_add_f32_dpp v145, v145, v145 row_mirror row_mask:0xf bank_mask:0xf bound_ctrl:1\n\t" \
    "v_fma_f32 v137, -v145, v234, v137\n\t" \
    "v_fma_f32 v138, -v145, v235, v138\n\t" \
    "v_fma_f32 v139, -v145, v236, v139\n\t" \
    "v_fma_f32 v140, -v145, v237, v140\n\t" \
    "v_fma_f32 %0, %0, v238, v137\n\t" \
    "v_fma_f32 %1, %1, v239, v138\n\t" \
    "v_fma_f32 %2, %2, v240, v139\n\t" \
    "v_fma_f32 %3, %3, v241, v140\n\t" \
    "v_mul_f32 v137, v184, v176\n\t" \
    "v_mul_f32 v138, v184, v177\n\t" \
    "v_mul_f32 v139, v184, v178\n\t" \
    "v_mul_f32 v140, v184, v179\n\t" \
    "v_mul_f32 v145, %0, v164\n\t" \
    "v_mul_f32 v146, %1, v165\n\t" \
    "v_fma_f32 v145, %2, v166, v145\n\t" \
    "v_fma_f32 v146, %3, v167, v146\n\t" \
    "v_add_f32 v145, v145, v146\n\t" \
    "ds_read_b128 v[208:211], %6 offset:21504\n\t" \
    "ds_read_b128 v[212:215], %6 offset:21760\n\t" \
    "ds_read_b128 v[216:219], %6 offset:22016\n\t" \
    "ds_read_b128 v[220:223], %6 offset:22272\n\t" \
    "ds_read_b128 v[224:227], %6 offset:22528\n\t" \
    "ds_read_b32 v228, %7 offset:21504\n\t" \
    "s_waitcnt lgkmcnt(6)\n\t" \
    "v_add_f32_dpp v145, v145, v145 quad_perm:[1,0,3,2] row_mask:0xf bank_mask:0xf bound_ctrl:1\n\t" \
    "v_mul_f32 v159, %0, v246\n\t" \
    "v_mul_f32 v146, %1, v247\n\t" \
    "v_add_f32_dpp v145, v145, v145 quad_perm:[2,3,0,1] row_mask:0xf bank_mask:0xf bound_ctrl:1\n\t" \
    "v_fma_f32 v159, %2, v248, v159\n\t" \
    "v_fma_f32 v146, %3, v249, v146\n\t" \
    "v_add_f32_dpp v145, v145, v145 row_half_mirror row_mask:0xf bank_mask:0xf bound_ctrl:1\n\t" \
    "v_add_f32 v159, v159, v146\n\t" \
    "s_nop 0\n\t" \
    "v_add_f32_dpp v145, v145, v145 row_mirror row_mask:0xf bank_mask:0xf bound_ctrl:1\n\t" \
    "v_fma_f32 v137, -v145, v168, v137\n\t" \
    "v_fma_f32 v138, -v145, v169, v138\n\t" \
    "v_fma_f32 v139, -v145, v170, v139\n\t" \
    "v_fma_f32 v140, -v145, v171, v140\n\t" \
    "v_fma_f32 %0, %0, v172, v137\n\t" \
    "v_fma_f32 %1, %1, v173, v138\n\t" \
    "v_fma_f32 %2, %2, v174, v139\n\t" \
    "v_fma_f32 %3, %3, v175, v140\n\t" \
    "v_mul_f32 v137, v206, v198\n\t" \
    "v_mul_f32 v138, v206, v199\n\t" \
    "v_mul_f32 v139, v206, v200\n\t" \
    "v_mul_f32 v140, v206, v201\n\t" \
    "v_mul_f32 v145, %0, v186\n\t" \
    "v_mul_f32 v146, %1, v187\n\t" \
    "v_fma_f32 v145, %2, v188, v145\n\t" \
    "v_fma_f32 v146, %3, v189, v146\n\t" \
    "v_add_f32 v145, v145, v146\n\t" \
    "ds_read_b128 v[230:233], %6 offset:23040\n\t" \
    "ds_read_b128 v[234:237], %6 offset:23296\n\t" \
    "ds_read_b128 v[238:241], %6 offset:23552\n\t" \
    "ds_read_b128 v[242:245], %6 offset:23808\n\t" \
    "ds_read_b128 v[246:249], %6 offset:24064\n\t" \
    "ds_read_b32 v250, %7 offset:23040\n\t" \
    "s_waitcnt lgkmcnt(6)\n\t" \
    "v_add_f32_dpp v145, v145, v145 quad_perm:[1,0,3,2] row_mask:0xf bank_mask:0xf bound_ctrl:1\n\t" \
    "v_mul_f32 v160, %0, v180\n\t" \
    "v_mul_f32 v146, %1, v181\n\t" \
    "v_add_f32_dpp v145, v145, v145 quad_perm:[2,3,0,1] row_mask:0xf bank_mask:0xf bound_ctrl:1\n\t" \
    "v_fma_f32 v160, %2, v182, v160\n\t" \
    "v_fma_f32 v146, %3, v183, v146\n\t" \
    "v_add_f32_dpp v145, v145, v145 row_half_mirror row_mask:0xf bank_mask:0xf bound_ctrl:1\n\t" \
    "v_add_f32 v160, v160, v146\n\t" \
    "s_nop 0\n\t" \
    "v_add_f32_dpp v145, v145, v145 row_mirror row_mask:0xf bank_mask:0xf bound_ctrl:1\n\t" \
    "v_fma_f32 v137, -v145, v190, v137\n\t" \
    "v_fma_f32 v138, -v145, v191, v138\n\t" \
    "v_fma_f32 v139, -v145, v192, v139\n\t" \
    "v_fma_f32 v140, -v145, v193, v140\n\t" \
    "v_fma_f32 %0, %0, v194, v137\n\t" \
    "v_fma_f32 %1, %1, v195, v138\n\t" \
    "v_fma_f32 %2, %2, v196, v139\n\t" \
    "v_fma_f32 %3, %3, v197, v140\n\t" \
    "v_mul_f32 v137, v228, v220\n\t" \
    "v_mul_f32 v138, v228, v221\n\t" \
    "v_mul_f32 v139, v228, v222\n\t" \
    "v_mul_f32 v140, v228, v223\n\t" \
    "v_mul_f32 v145, %0, v208\n\t" \
    "v_mul_f32 v146, %1, v209\n\t" \
    "v_fma_f32 v145, %2, v210, v145\n\t" \
    "v_fma_f32 v146, %3, v211, v146\n\t" \
    "v_add_f32 v145, v145, v146\n\t" \
    "ds_read_b128 v[164:167], %6 offset:24576\n\t" \
    "ds_read_b128 v[168:171], %6 offset:24832\n\t" \
    "ds_read_b128 v[172:175], %6 offset:25088\n\t" \
    "ds_read_b128 v[176:179], %6 offset:25344\n\t" \
    "ds_read_b128 v[180:183], %6 offset:25600\n\t" \
    "ds_read_b32 v184, %7 offset:24576\n\t" \
    "s_waitcnt lgkmcnt(6)\n\t" \
    "v_add_f32_dpp v145, v145, v145 quad_perm:[1,0,3,2] row_mask:0xf bank_mask:0xf bound_ctrl:1\n\t" \
    "v_mul_f32 v161, %0, v202\n\t" \
    "v_mul_f32 v146, %1, v203\n\t" \
    "v_add_f32_dpp v145, v145, v145 quad_perm:[2,3,0,1] row_mask:0xf bank_mask:0xf bound_ctrl:1\n\t" \
    "v_fma_f32 v161, %2, v204, v161\n\t" \
    "v_fma_f32 v146, %3, v205, v146\n\t" \
    "v_add_f32_dpp v145, v145, v145 row_half_mirror row_mask:0xf bank_mask:0xf bound_ctrl:1\n\t" \
    "v_add_f32 v161, v161, v146\n\t" \
    "s_nop 0\n\t" \
    "v_add_f32_dpp v145, v145, v145 row_mirror row_mask:0xf bank_mask:0xf bound_ctrl:1\n\t" \
    "v_fma_f32 v137, -v145, v212, v137\n\t" \
    "v_fma_f32 v138, -v145, v213, v138\n\t" \
    "v_fma_f32 v139, -v145, v214, v139\n\t" \
    "v_fma_f32 v140, -v145, v215, v140\n\t" \
    "v_fma_f32 %0, %0, v216, v137\n\t" \
    "v_fma_f32 %1, %1, v217, v138\n\t" \
    "v_fma_f32 %2, %2, v218, v139\n\t" \
    "v_fma_f32 %3, %3, v219, v140\n\t" \
    "v_mul_f32 v137, v250, v242\n\t" \
    "v_mul_f32 v138, v250, v243\n\t" \
    "v_mul_f32 v139, v250, v244\n\t" \
    "v_mul_f32 v140, v250, v245\n\t" \
    "v_mul_f32 v145, %0, v230\n\t" \
    "v_mul_f32 v146, %1, v231\n\t" \
    "v_fma_f32 v145, %2, v232, v145\n\t" \
    "v_fma_f32 v146, %3, v233, v146\n\t" \
    "v_add_f32 v145, v145, v146\n\t" \
    "ds_read_b128 v[186:189], %6 offset:26112\n\t" \
    "ds_read_b128 v[190:193], %6 offset:26368\n\t" \
    "ds_read_b128 v[194:197], %6 offset:26624\n\t" \
    "ds_read_b128 v[198:201], %6 offset:26880\n\t" \
    "ds_read_b128 v[202:205], %6 offset:27136\n\t" \
    "ds_read_b32 v206, %7 offset:26112\n\t" \
    "s_waitcnt lgkmcnt(6)\n\t" \
    "v_add_f32_dpp v145, v145, v145 quad_perm:[1,0,3,2] row_mask:0xf bank_mask:0xf bound_ctrl:1\n\t" \
    "v_mul_f32 v162, %0, v224\n\t" \
    "v_mul_f32 v146, %1, v225\n\t" \
    "v_add_f32_dpp v145, v145, v145 quad_perm:[2,3,0,1] row_mask:0xf bank_mask:0xf bound_ctrl:1\n\t" \
    "v_fma_f32 v162, %2, v226, v162\n\t" \
    "v_fma_f32 v146, %3, v227, v146\n\t" \
    "v_add_f32_dpp v145, v145, v145 row_half_mirror row_mask:0xf bank_mask:0xf bound_ctrl:1\n\t" \
    "v_add_f32 v162, v162, v146\n\t" \
    "s_nop 0\n\t" \
    "v_add_f32_dpp v145, v145, v145 row_mirror row_mask:0xf bank_mask:0xf bound_ctrl:1\n\t" \
    "v_fma_f32 v137, -v145, v234, v137\n\t" \
    "v_fma_f32 v138, -v145, v235, v138\n\t" \
    "v_fma_f32 v139, -v145, v236, v139\n\t" \
    "v_fma_f32 v140, -v145, v237, v140\n\t" \
    "v_fma_f32 %0, %0, v238, v137\n\t" \
    "v_fma_f32 %1, %1, v239, v138\n\t" \
    "v_fma_f32 %2, %2, v240, v139\n\t" \
    "v_fma_f32 %3, %3, v241, v140\n\t" \
    "v_mul_f32 v137, v184, v176\n\t" \
    "v_mul_f32 v138, v184, v177\n\t" \
    "v_mul_f32 v139, v184, v178\n\t" \
    "v_mul_f32 v140, v184, v179\n\t" \
    "v_mul_f32 v145, %0, v164\n\t" \
    "v_mul_f32 v146, %1, v165\n\t" \
    "v_fma_f32 v145, %2, v166, v145\n\t" \
    "v_fma_f32 v146, %3, v167, v146\n\t" \
    "v_add_f32 v145, v145, v146\n\t" \
    "ds_read_b128 v[208:211], %6 offset:27648\n\t" \
    "ds_read_b128 v[212:215], %6 offset:27904\n\t" \
    "ds_read_b128 v[216:219], %6 offset:28160\n\t" \
    "ds_read_b128 v[220:223], %6 offset:28416\n\t" \
    "ds_read_b128 v[224:227], %6 offset:28672\n\t" \
    "ds_read_b32 v228, %7 offset:27648\n\t" \
    "s_waitcnt lgkmcnt(6)\n\t" \
    "v_add_f32_dpp v145, v145, v145 quad_perm:[1,0,3,2] row_mask:0xf bank_mask:0xf bound_ctrl:1\n\t" \
    "v_mul_f32 v163, %0, v246\n\t" \
    "v_mul_f32 v146, %1, v247\n\t" \
    "v_add_f32_dpp v145, v145, v145 quad_perm:[2,3,0,1] row_mask:0xf bank_mask:0xf bound_ctrl:1\n\t" \
    "v_fma_f32 v163, %2, v248, v163\n\t" \
    "v_fma_f32 v146, %3, v249, v146\n\t" \
    "v_add_f32_dpp v145, v145, v145 row_half_mirror row_mask:0xf bank_mask:0xf bound_ctrl:1\n\t" \
    "v_add_f32 v163, v163, v146\n\t" \
    "s_nop 0\n\t" \
    "v_add_f32_dpp v145, v145, v145 row_mirror row_mask:0xf bank_mask:0xf bound_ctrl:1\n\t" \
    "v_fma_f32 v137, -v145, v168, v137\n\t" \
    "v_fma_f32 v138, -v145, v169, v138\n\t" \
    "v_fma_f32 v139, -v145, v170, v139\n\t" \
    "v_fma_f32 v140, -v145, v171, v140\n\t" \
    "v_fma_f32 %0, %0, v172, v137\n\t" \
    "v_fma_f32 %1, %1, v173, v138\n\t" \
    "v_fma_f32 %2, %2, v174, v139\n\t" \
    "v_fma_f32 %3, %3, v175, v140\n\t" \
    "v_mul_f32 v137, v206, v198\n\t" \
    "v_mul_f32 v138, v206, v199\n\t" \
    "v_mul_f32 v139, v206, v200\n\t" \
    "v_mul_f32 v140, v206, v201\n\t" \
    "v_mul_f32 v145, %0, v186\n\t" \
    "v_mul_f32 v146, %1, v187\n\t" \
    "v_fma_f32 v145, %2, v188, v145\n\t" \
    "v_fma_f32 v146, %3, v189, v146\n\t" \
    "v_add_f32 v145, v145, v146\n\t" \
    "v_and_b32 v244, 8, %8\n\t" \
    "v_cmp_ne_u32 vcc, 0, v244\n\t" \
    "v_cndmask_b32 v244, v156, v148, vcc\n\t" \
    "v_cndmask_b32 v245, v157, v149, vcc\n\t" \
    "v_cndmask_b32 v246, v158, v150, vcc\n\t" \
    "v_cndmask_b32 v247, v159, v151, vcc\n\t" \
    "v_cndmask_b32 v230, v148, v156, vcc\n\t" \
    "v_cndmask_b32 v231, v149, v157, vcc\n\t" \
    "v_cndmask_b32 v232, v150, v158, vcc\n\t" \
    "v_cndmask_b32 v233, v151, v159, vcc\n\t" \
    "v_add_f32_dpp v230, v244, v230 row_mirror row_mask:0xf bank_mask:0xf bound_ctrl:1\n\t" \
    "v_add_f32_dpp v231, v245, v231 row_mirror row_mask:0xf bank_mask:0xf bound_ctrl:1\n\t" \
    "v_add_f32_dpp v232, v246, v232 row_mirror row_mask:0xf bank_mask:0xf bound_ctrl:1\n\t" \
    "v_add_f32_dpp v233, v247, v233 row_mirror row_mask:0xf bank_mask:0xf bound_ctrl:1\n\t" \
    "v_cndmask_b32 v244, v160, v152, vcc\n\t" \
    "v_cndmask_b32 v245, v161, v153, vcc\n\t" \
    "v_cndmask_b32 v246, v162, v154, vcc\n\t" \
    "v_cndmask_b32 v247, v163, v155, vcc\n\t" \
    "v_cndmask_b32 v234, v152, v160, vcc\n\t" \
    "v_cndmask_b32 v235, v153, v161, vcc\n\t" \
    "v_cndmask_b32 v236, v154, v162, vcc\n\t" \
    "v_cndmask_b32 v237, v155, v163, vcc\n\t" \
    "v_add_f32_dpp v234, v244, v234 row_mirror row_mask:0xf bank_mask:0xf bound_ctrl:1\n\t" \
    "v_add_f32_dpp v235, v245, v235 row_mirror row_mask:0xf bank_mask:0xf bound_ctrl:1\n\t" \
    "v_add_f32_dpp v236, v246, v236 row_mirror row_mask:0xf bank_mask:0xf bound_ctrl:1\n\t" \
    "v_add_f32_dpp v237, v247, v237 row_mirror row_mask:0xf bank_mask:0xf bound_ctrl:1\n\t" \
    "v_and_b32 v244, 4, %8\n\t" \
    "v_cmp_ne_u32 vcc, 0, v244\n\t" \
    "v_cndmask_b32 v244, v234, v230, vcc\n\t" \
    "v_cndmask_b32 v245, v235, v231, vcc\n\t" \
    "v_cndmask_b32 v246, v236, v232, vcc\n\t" \
    "v_cndmask_b32 v247, v237, v233, vcc\n\t" \
    "v_cndmask_b32 v238, v230, v234, vcc\n\t" \
    "v_cndmask_b32 v239, v231, v235, vcc\n\t" \
    "v_cndmask_b32 v240, v232, v236, vcc\n\t" \
    "v_cndmask_b32 v241, v233, v237, vcc\n\t" \
    "v_add_f32_dpp v238, v244, v238 row_half_mirror row_mask:0xf bank_mask:0xf bound_ctrl:1\n\t" \
    "v_add_f32_dpp v239, v245, v239 row_half_mirror row_mask:0xf bank_mask:0xf bound_ctrl:1\n\t" \
    "v_add_f32_dpp v240, v246, v240 row_half_mirror row_mask:0xf bank_mask:0xf bound_ctrl:1\n\t" \
    "v_add_f32_dpp v241, v247, v241 row_half_mirror row_mask:0xf bank_mask:0xf bound_ctrl:1\n\t" \
    "v_and_b32 v244, 2, %8\n\t" \
    "v_cmp_ne_u32 vcc, 0, v244\n\t" \
    "v_cndmask_b32 v244, v240, v238, vcc\n\t" \
    "v_cndmask_b32 v245, v241, v239, vcc\n\t" \
    "v_cndmask_b32 v242, v238, v240, vcc\n\t" \
    "v_cndmask_b32 v243, v239, v241, vcc\n\t" \
    "v_add_f32_dpp v242, v244, v242 quad_perm:[2,3,0,1] row_mask:0xf bank_mask:0xf bound_ctrl:1\n\t" \
    "v_add_f32_dpp v243, v245, v243 quad_perm:[2,3,0,1] row_mask:0xf bank_mask:0xf bound_ctrl:1\n\t" \
    "v_and_b32 v244, 1, %8\n\t" \
    "v_cmp_ne_u32 vcc, 0, v244\n\t" \
    "v_cndmask_b32 v244, v243, v242, vcc\n\t" \
    "v_cndmask_b32 v245, v242, v243, vcc\n\t" \
    "s_nop 0\n\t" \
    "v_add_f32_dpp %4, v244, v245 quad_perm:[1,0,3,2] row_mask:0xf bank_mask:0xf bound_ctrl:1\n\t" \
    "ds_read_b128 v[230:233], %6 offset:29184\n\t" \
    "ds_read_b128 v[234:237], %6 offset:29440\n\t" \
    "ds_read_b128 v[238:241], %6 offset:29696\n\t" \
    "ds_read_b128 v[242:245], %6 offset:29952\n\t" \
    "ds_read_b128 v[246:249], %6 offset:30208\n\t" \
    "ds_read_b32 v250, %7 offset:29184\n\t" \
    "s_waitcnt lgkmcnt(6)\n\t" \
    "v_add_f32_dpp v145, v145, v145 quad_perm:[1,0,3,2] row_mask:0xf bank_mask:0xf bound_ctrl:1\n\t" \
    "v_mul_f32 v148, %0, v180\n\t" \
    "v_mul_f32 v146, %1, v181\n\t" \
    "v_add_f32_dpp v145, v145, v145 quad_perm:[2,3,0,1] row_mask:0xf bank_mask:0xf bound_ctrl:1\n\t" \
    "v_fma_f32 v148, %2, v182, v148\n\t" \
    "v_fma_f32 v146, %3, v183, v146\n\t" \
    "v_add_f32_dpp v145, v145, v145 row_half_mirror row_mask:0xf bank_mask:0xf bound_ctrl:1\n\t" \
    "v_add_f32 v148, v148, v146\n\t" \
    "s_nop 0\n\t" \
    "v_add_f32_dpp v145, v145, v145 row_mirror row_mask:0xf bank_mask:0xf bound_ctrl:1\n\t" \
    "v_fma_f32 v137, -v145, v190, v137\n\t" \
    "v_fma_f32 v138, -v145, v191, v138\n\t" \
    "v_fma_f32 v139, -v145, v192, v139\n\t" \
    "v_fma_f32 v140, -v145, v193, v140\n\t" \
    "v_fma_f32 %0, %0, v194, v137\n\t" \
    "v_fma_f32 %1, %1, v195, v138\n\t" \
    "v_fma_f32 %2, %2, v196, v139\n\t" \
    "v_fma_f32 %3, %3, v197, v140\n\t" \
    "v_mul_f32 v137, v228, v220\n\t" \
    "v_mul_f32 v138, v228, v221\n\t" \
    "v_mul_f32 v139, v228, v222\n\t" \
    "v_mul_f32 v140, v228, v223\n\t" \
    "v_mul_f32 v145, %0, v208\n\t" \
    "v_mul_f32 v146, %1, v209\n\t" \
    "v_fma_f32 v145, %2, v210, v145\n\t" \
    "v_fma_f32 v146, %3, v211, v146\n\t" \
    "v_add_f32 v145, v145, v146\n\t" \
    "ds_read_b128 v[164:167], %6 offset:30720\n\t" \
    "ds_read_b128 v[168:171], %6 offset:30976\n\t" \
    "ds_read_b128 v[172:175], %6 offset:31232\n\t" \
    "ds_read_b128 v[176:179], %6 offset:31488\n\t" \
    "ds_read_b128 v[180:183], %6 offset:31744\n\t" \
    "ds_read_b32 v184, %7 offset:30720\n\t" \
    "s_waitcnt lgkmcnt(6)\n\t" \
    "v_add_f32_dpp v145, v145, v145 quad_perm:[1,0,3,2] row_mask:0xf bank_mask:0xf bound_ctrl:1\n\t" \
    "v_mul_f32 v149, %0, v202\n\t" \
    "v_mul_f32 v146, %1, v203\n\t" \
    "v_add_f32_dpp v145, v145, v145 quad_perm:[2,3,0,1] row_mask:0xf bank_mask:0xf bound_ctrl:1\n\t" \
    "v_fma_f32 v149, %2, v204, v149\n\t" \
    "v_fma_f32 v146, %3, v205, v146\n\t" \
    "v_add_f32_dpp v145, v145, v145 row_half_mirror row_mask:0xf bank_mask:0xf bound_ctrl:1\n\t" \
    "v_add_f32 v149, v149, v146\n\t" \
    "s_nop 0\n\t" \
    "v_add_f32_dpp v145, v145, v145 row_mirror row_mask:0xf bank_mask:0xf bound_ctrl:1\n\t" \
    "v_fma_f32 v137, -v145, v212, v137\n\t" \
    "v_fma_f32 v138, -v145, v213, v138\n\t" \
    "v_fma_f32 v139, -v145, v214, v139\n\t" \
    "v_fma_f32 v140, -v145, v215, v140\n\t" \
    "v_fma_f32 %0, %0, v216, v137\n\t" \
    "v_fma_f32 %1, %1, v217, v138\n\t" \
    "v_fma_f32 %2, %2, v218, v139\n\t" \
    "v_fma_f32 %3, %3, v219, v140\n\t" \
    "v_mul_f32 v137, v250, v242\n\t" \
    "v_mul_f32 v138, v250, v243\n\t" \
    "v_mul_f32 v139, v250, v244\n\t" \
    "v_mul_f32 v140, v250, v245\n\t" \
    "v_mul_f32 v145, %0, v230\n\t" \
    "v_mul_f32 v146, %1, v231\n\t" \
    "v_fma_f32 v145, %2, v232, v145\n\t" \
    "v_fma_f32 v146, %3, v233, v146\n\t" \
    "v_add_f32 v145, v145, v146\n\t" \
    "ds_read_b128 v[186:189], %6 offset:32256\n\t" \
    "ds_read_b128 v[190:193], %6 offset:32512\n\t" \
    "ds_read_b128 v[194:197], %6 offset:32768\n\t" \
    "ds_read_b128 v[198:201], %6 offset:33024\n\t" \
    "ds_read_b128 v[202:205], %6 offset:33280\n\t" \
    "ds_read_b32 v206, %7 offset:32256\n\t" \
    "s_waitcnt lgkmcnt(6)\n\t" \
    "v_add_f32_dpp v145, v145, v145 quad_perm:[1,0,3,2] row_mask:0xf bank_mask:0xf bound_ctrl:1\n\t" \
    "v_mul_f32 v150, %0, v224\n\t" \
    "v_mul_f32 v146, %1, v225\n\t" \
    "v_add_f32_dpp v145, v145, v145 quad_perm:[2,3,0,1] row_mask:0xf bank_mask:0xf bound_ctrl:1\n\t" \
    "v_fma_f32 v150, %2, v226, v150\n\t" \
    "v_fma_f32 v146, %3, v227, v146\n\t" \
    "v_add_f32_dpp v145, v145, v145 row_half_mirror row_mask:0xf bank_mask:0xf bound_ctrl:1\n\t" \
    "v_add_f32 v150, v150, v146\n\t" \
    "s_nop 0\n\t" \
    "v_add_f32_dpp v145, v145, v145 row_mirror row_mask:0xf bank_mask:0xf bound_ctrl:1\n\t" \
    "v_fma_f32 v137, -v145, v234, v137\n\t" \
    "v_fma_f32 v138, -v145, v235, v138\n\t" \
    "v_fma_f32 v139, -v145, v236, v139\n\t" \
    "v_fma_f32 v140, -v145, v237, v140\n\t" \
    "v_fma_f32 %0, %0, v238, v137\n\t" \
    "v_fma_f32 %1, %1, v239, v138\n\t" \
    "v_fma_f32 %2, %2, v240, v139\n\t" \
    "v_fma_f32 %3, %3, v241, v140\n\t" \
    "v_mul_f32 v137, v184, v176\n\t" \
    "v_mul_f32 v138, v184, v177\n\t" \
    "v_mul_f32 v139, v184, v178\n\t" \
    "v_mul_f32 v140, v184, v179\n\t" \
    "v_mul_f32 v145, %0, v164\n\t" \
    "v_mul_f32 v146, %1, v165\n\t" \
    "v_fma_f32 v145, %2, v166, v145\n\t" \
    "v_fma_f32 v146, %3, v167, v146\n\t" \
    "v_add_f32 v145, v145, v146\n\t" \
    "ds_read_b128 v[208:211], %6 offset:33792\n\t" \
    "ds_read_b128 v[212:215], %6 offset:34048\n\t" \
    "ds_read_b128 v[216:219], %6 offset:34304\n\t" \
    "ds_read_b128 v[220:223], %6 offset:34560\n\t" \
    "ds_read_b128 v[224:227], %6 offset:34816\n\t" \
    "ds_read_b32 v228, %7 offset:33792\n\t" \
    "s_waitcnt lgkmcnt(6)\n\t" \
    "v_add_f32_dpp v145, v145, v145 quad_perm:[1,0,3,2] row_mask:0xf bank_mask:0xf bound_ctrl:1\n\t" \
    "v_mul_f32 v151, %0, v246\n\t" \
    "v_mul_f32 v146, %1, v247\n\t" \
    "v_add_f32_dpp v145, v145, v145 quad_perm:[2,3,0,1] row_mask:0xf bank_mask:0xf bound_ctrl:1\n\t" \
    "v_fma_f32 v151, %2, v248, v151\n\t" \
    "v_fma_f32 v146, %3, v249, v146\n\t" \
    "v_add_f32_dpp v145, v145, v145 row_half_mirror row_mask:0xf bank_mask:0xf bound_ctrl:1\n\t" \
    "v_add_f32 v151, v151, v146\n\t" \
    "s_nop 0\n\t" \
    "v_add_f32_dpp v145, v145, v145 row_mirror row_mask:0xf bank_mask:0xf bound_ctrl:1\n\t" \
    "v_fma_f32 v137, -v145, v168, v137\n\t" \
    "v_fma_f32 v138, -v145, v169, v138\n\t" \
    "v_fma_f32 v139, -v145, v170, v139\n\t" \
    "v_fma_f32 v140, -v145, v171, v140\n\t" \
    "v_fma_f32 %0, %0, v172, v137\n\t" \
    "v_fma_f32 %1, %1, v173, v138\n\t" \
    "v_fma_f32 %2, %2, v174, v139\n\t" \
    "v_fma_f32 %3, %3, v175, v140\n\t" \
    "v_mul_f32 v137, v206, v198\n\t" \
    "v_mul_f32 v138, v206, v199\n\t" \
    "v_mul_f32 v139, v206, v200\n\t" \
    "v_mul_f32 v140, v206, v201\n\t" \
    "v_mul_f32 v145, %0, v186\n\t" \
    "v_mul_f32 v146, %1, v187\n\t" \
    "v_fma_f32 v145, %2, v188, v145\n\t" \
    "v_fma_f32 v146, %3, v189, v146\n\t" \
    "v_add_f32 v145, v145, v146\n\t" \
    "ds_read_b128 v[230:233], %6 offset:35328\n\t" \
    "ds_read_b128 v[234:237], %6 offset:35584\n\t" \
    "ds_read_b128 v[238:241], %6 offset:35840\n\t" \
    "ds_read_b128 v[242:245], %6 offset:36096\n\t" \
    "ds_read_b128 v[246:249], %6 offset:36352\n\t" \
    "ds_read_b32 v250, %7 offset:35328\n\t" \
    "s_waitcnt lgkmcnt(6)\n\t" \
    "v_add_f32_dpp v145, v145, v145 quad_perm:[1,0,3,2] row_mask:0xf bank_mask:0xf bound_ctrl:1\n\t" \
    "v_mul_f32 v152, %0, v180\n\t" \
    "v_mul_f32 v146, %1, v181\n\t" \
    "v_add_f32_dpp v145, v145, v145 quad_perm:[2,3,0,1] row_mask:0xf bank_mask:0xf bound_ctrl:1\n\t" \
    "v_fma_f32 v152, %2, v182, v152\n\t" \
    "v_fma_f32 v146, %3, v183, v146\n\t" \
    "v_add_f32_dpp v145, v145, v145 row_half_mirror row_mask:0xf bank_mask:0xf bound_ctrl:1\n\t" \
    "v_add_f32 v152, v152, v146\n\t" \
    "s_nop 0\n\t" \
    "v_add_f32_dpp v145, v145, v145 row_mirror row_mask:0xf bank_mask:0xf bound_ctrl:1\n\t" \
    "v_fma_f32 v137, -v145, v190, v137\n\t" \
    "v_fma_f32 v138, -v145, v191, v138\n\t" \
    "v_fma_f32 v139, -v145, v192, v139\n\t" \
    "v_fma_f32 v140, -v145, v193, v140\n\t" \
    "v_fma_f32 %0, %0, v194, v137\n\t" \
    "v_fma_f32 %1, %1, v195, v138\n\t" \
    "v_fma_f32 %2, %2, v196, v139\n\t" \
    "v_fma_f32 %3, %3, v197, v140\n\t" \
    "v_mul_f32 v137, v228, v220\n\t" \
    "v_mul_f32 v138, v228, v221\n\t" \
    "v_mul_f32 v139, v228, v222\n\t" \
    "v_mul_f32 v140, v228, v223\n\t" \
    "v_mul_f32 v145, %0, v208\n\t" \
    "v_mul_f32 v146, %1, v209\n\t" \
    "v_fma_f32 v145, %2, v210, v145\n\t" \
    "v_fma_f32 v146, %3, v211, v146\n\t" \
    "v_add_f32 v145, v145, v146\n\t" \
    "ds_read_b128 v[164:167], %6 offset:36864\n\t" \
    "ds_read_b128 v[168:171], %6 offset:37120\n\t" \
    "ds_read_b128 v[172:175], %6 offset:37376\n\t" \
    "ds_read_b128 v[176:179], %6 offset:37632\n\t" \
    "ds_read_b128 v[180:183], %6 offset:37888\n\t" \
    "ds_read_b32 v184, %7 offset:36864\n\t" \
    "s_waitcnt lgkmcnt(6)\n\t" \
    "v_add_f32_dpp v145, v145, v145 quad_perm:[1,0,3,2] row_mask:0xf bank_mask:0xf bound_ctrl:1\n\t" \
    "v_mul_f32 v153, %0, v202\n\t" \
    "v_mul_f32 v146, %1, v203\n\t" \
    "v_add_f32_dpp v145, v145, v145 quad_perm:[2,3,0,1] row_mask:0xf bank_mask:0xf bound_ctrl:1\n\t" \
    "v_fma_f32 v153, %2, v204, v153\n\t" \
    "v_fma_f32 v146, %3, v205, v146\n\t" \
    "v_add_f32_dpp v145, v145, v145 row_half_mirror row_mask:0xf bank_mask:0xf bound_ctrl:1\n\t" \
    "v_add_f32 v153, v153, v146\n\t" \
    "s_nop 0\n\t" \
    "v_add_f32_dpp v145, v145, v145 row_mirror row_mask:0xf bank_mask:0xf bound_ctrl:1\n\t" \
    "v_fma_f32 v137, -v145, v212, v137\n\t" \
    "v_fma_f32 v138, -v145, v213, v138\n\t" \
    "v_fma_f32 v139, -v145, v214, v139\n\t" \
    "v_fma_f32 v140, -v145, v215, v140\n\t" \
    "v_fma_f32 %0, %0, v216, v137\n\t" \
    "v_fma_f32 %1, %1, v217, v138\n\t" \
    "v_fma_f32 %2, %2, v218, v139\n\t" \
    "v_fma_f32 %3, %3, v219, v140\n\t" \
    "v_mul_f32 v137, v250, v242\n\t" \
    "v_mul_f32 v138, v250, v243\n\t" \
    "v_mul_f32 v139, v250, v244\n\t" \
    "v_mul_f32 v140, v250, v245\n\t" \
    "v_mul_f32 v145, %0, v230\n\t" \
    "v_mul_f32 v146, %1, v231\n\t" \
    "v_fma_f32 v145, %2, v232, v145\n\t" \
    "v_fma_f32 v146, %3, v233, v146\n\t" \
    "v_add_f32 v145, v145, v146\n\t" \
    "ds_read_b128 v[186:189], %6 offset:38400\n\t" \
    "ds_read_b128 v[190:193], %6 offset:38656\n\t" \
    "ds_read_b128 v[194:197], %6 offset:38912\n\t" \
    "ds_read_b128 v[198:201], %6 offset:39168\n\t" \
    "ds_read_b128 v[202:205], %6 offset:39424\n\t" \
    "ds_read_b32 v206, %7 offset:38400\n\t" \
    "s_waitcnt lgkmcnt(6)\n\t" \
    "v_add_f32_dpp v145, v145, v145 quad_perm:[1,0,3,2] row_mask:0xf bank_mask:0xf bound_ctrl:1\n\t" \
    "v_mul_f32 v154, %0, v224\n\t" \
    "v_mul_f32 v146, %1, v225\n\t" \
    "v_add_f32_dpp v145, v145, v145 quad_perm:[2,3,0,1] row_mask:0xf bank_mask:0xf bound_ctrl:1\n\t" \
    "v_fma_f32 v154, %2, v226, v154\n\t" \
    "v_fma_f32 v146, %3, v227, v146\n\t" \
    "v_add_f32_dpp v145, v145, v145 row_half_mirror row_mask:0xf bank_mask:0xf bound_ctrl:1\n\t" \
    "v_add_f32 v154, v154, v146\n\t" \
    "s_nop 0\n\t" \
    "v_add_f32_dpp v145, v145, v145 row_mirror row_mask:0xf bank_mask:0xf bound_ctrl:1\n\t" \
    "v_fma_f32 v137, -v145, v234, v137\n\t" \
    "v_fma_f32 v138, -v145, v235, v138\n\t" \
    "v_fma_f32 v139, -v145, v236, v139\n\t" \
    "v_fma_f32 v140, -v145, v237, v140\n\t" \
    "v_fma_f32 %0, %0, v238, v137\n\t" \
    "v_fma_f32 %1, %1, v239, v138\n\t" \
    "v_fma_f32 %2, %2, v240, v139\n\t" \
    "v_fma_f32 %3, %3, v241, v140\n\t" \
    "v_mul_f32 v137, v184, v176\n\t" \
    "v_mul_f32 v138, v184, v177\n\t" \
    "v_mul_f32 v139, v184, v178\n\t" \
    "v_mul_f32 v140, v184, v179\n\t" \
    "v_mul_f32 v145, %0, v164\n\t" \
    "v_mul_f32 v146, %1, v165\n\t" \
    "v_fma_f32 v145, %2, v166, v145\n\t" \
    "v_fma_f32 v146, %3, v167, v146\n\t" \
    "v_add_f32 v145, v145, v146\n\t" \
    "ds_read_b128 v[208:211], %6 offset:39936\n\t" \
    "ds_read_b128 v[212:215], %6 offset:40192\n\t" \
    "ds_read_b128 v[216:219], %6 offset:40448\n\t" \
    "ds_read_b128 v[220:223], %6 offset:40704\n\t" \
    "ds_read_b128 v[224:227], %6 offset:40960\n\t" \
    "ds_read_b32 v228, %7 offset:39936\n\t" \
    "s_waitcnt lgkmcnt(6)\n\t" \
    "v_add_f32_dpp v145, v145, v145 quad_perm:[1,0,3,2] row_mask:0xf bank_mask:0xf bound_ctrl:1\n\t" \
    "v_mul_f32 v155, %0, v246\n\t" \
    "v_mul_f32 v146, %1, v247\n\t" \
    "v_add_f32_dpp v145, v145, v145 quad_perm:[2,3,0,1] row_mask:0xf bank_mask:0xf bound_ctrl:1\n\t" \
    "v_fma_f32 v155, %2, v248, v155\n\t" \
    "v_fma_f32 v146, %3, v249, v146\n\t" \
    "v_add_f32_dpp v145, v145, v145 row_half_mirror row_mask:0xf bank_mask:0xf bound_ctrl:1\n\t" \
    "v_add_f32 v155, v155, v146\n\t" \
    "s_nop 0\n\t" \
    "v_add_f32_dpp v145, v145, v145 row_mirror row_mask:0xf bank_mask:0xf bound_ctrl:1\n\t" \
    "v_fma_f32 v137, -v145, v168, v137\n\t" \
    "v_fma_f32 v138, -v145, v169, v138\n\t" \
    "v_fma_f32 v139, -v145, v170, v139\n\t" \
    "v_fma_f32 v140, -v145, v171, v140\n\t" \
    "v_fma_f32 %0, %0, v172, v137\n\t" \
    "v_fma_f32 %1, %1, v173, v138\n\t" \
    "v_fma_f32 %2, %2, v174, v139\n\t" \
    "v_fma_f32 %3, %3, v175, v140\n\t" \
    "v_mul_f32 v137, v206, v198\n\t" \
    "v_mul_f32 v138, v206, v199\n\t" \
    "v_mul_f32 v139, v206, v200\n\t" \
    "v_mul_f32 v140, v206, v201\n\t" \
    "v_mul_f32 v145, %0, v186\n\t" \
    "v_mul_f32 v146, %1, v187\n\t" \
    "v_fma_f32 v145, %2, v188, v145\n\t" \
    "v_fma_f32 v146, %3, v189, v146\n\t" \
    "v_add_f32 v145, v145, v146\n\t" \
    "ds_read_b128 v[230:233], %6 offset:41472\n\t" \
    "ds_read_b128 v[234:237], %6 offset:41728\n\t" \
    "ds_read_b128 v[238:241], %6 offset:41984\n\t" \
    "ds_read_b128 v[242:245], %6 offset:42240\n\t" \
    "ds_read_b128 v[246:249], %6 offset:42496\n\t" \
    "ds_read_b32 v250, %7 offset:41472\n\t" \
    "s_waitcnt lgkmcnt(6)\n\t" \
    "v_add_f32_dpp v145, v145, v145 quad_perm:[1,0,3,2] row_mask:0xf bank_mask:0xf bound_ctrl:1\n\t" \
    "v_mul_f32 v156, %0, v180\n\t" \
    "v_mul_f32 v146, %1, v181\n\t" \
    "v_add_f32_dpp v145, v145, v145 quad_perm:[2,3,0,1] row_mask:0xf bank_mask:0xf bound_ctrl:1\n\t" \
    "v_fma_f32 v156, %2, v182, v156\n\t" \
    "v_fma_f32 v146, %3, v183, v146\n\t" \
    "v_add_f32_dpp v145, v145, v145 row_half_mirror row_mask:0xf bank_mask:0xf bound_ctrl:1\n\t" \
    "v_add_f32 v156, v156, v146\n\t" \
    "s_nop 0\n\t" \
    "v_add_f32_dpp v145, v145, v145 row_mirror row_mask:0xf bank_mask:0xf bound_ctrl:1\n\t" \
    "v_fma_f32 v137, -v145, v190, v137\n\t" \
    "v_fma_f32 v138, -v145, v191, v138\n\t" \
    "v_fma_f32 v139, -v145, v192, v139\n\t" \
    "v_fma_f32 v140, -v145, v193, v140\n\t" \
    "v_fma_f32 %0, %0, v194, v137\n\t" \
    "v_fma_f32 %1, %1, v195, v138\n\t" \
    "v_fma_f32 %2, %2, v196, v139\n\t" \
    "v_fma_f32 %3, %3, v197, v140\n\t" \
    "v_mul_f32 v137, v228, v220\n\t" \
    "v_mul_f32 v138, v228, v221\n\t" \
    "v_mul_f32 v139, v228, v222\n\t" \
    "v_mul_f32 v140, v228, v223\n\t" \
    "v_mul_f32 v145, %0, v208\n\t" \
    "v_mul_f32 v146, %1, v209\n\t" \
    "v_fma_f32 v145, %2, v210, v145\n\t" \
    "v_fma_f32 v146, %3, v211, v146\n\t" \
    "v_add_f32 v145, v145, v146\n\t" \
    "ds_read_b128 v[164:167], %6 offset:43008\n\t" \
    "ds_read_b128 v[168:171], %6 offset:43264\n\t" \
    "ds_read_b128 v[172:175], %6 offset:43520\n\t" \
    "ds_read_b128 v[176:179], %6 offset:43776\n\t" \
    "ds_read_b128 v[180:183], %6 offset:44032\n\t" \
    "ds_read_b32 v184, %7 offset:43008\n\t" \
    "s_waitcnt lgkmcnt(6)\n\t" \
    "v_add_f32_dpp v145, v145, v145 quad_perm:[1,0,3,2] row_mask:0xf bank_mask:0xf bound_ctrl:1\n\t" \
    "v_mul_f32 v157, %0, v202\n\t" \
    "v_mul_f32 v146, %1, v203\n\t" \
    "v_add_f32_dpp v145, v145, v145 quad_perm:[2,3,0,1] row_mask:0xf bank_mask:0xf bound_ctrl:1\n\t" \
    "v_fma_f32 v157, %2, v204, v157\n\t" \
    "v_fma_f32 v146, %3, v205, v146\n\t" \
    "v_add_f32_dpp v145, v145, v145 row_half_mirror row_mask:0xf bank_mask:0xf bound_ctrl:1\n\t" \
    "v_add_f32 v157, v157, v146\n\t" \
    "s_nop 0\n\t" \
    "v_add_f32_dpp v145, v145, v145 row_mirror row_mask:0xf bank_mask:0xf bound_ctrl:1\n\t" \
    "v_fma_f32 v137, -v145, v212, v137\n\t" \
    "v_fma_f32 v138, -v145, v213, v138\n\t" \
    "v_fma_f32 v139, -v145, v214, v139\n\t" \
    "v_fma_f32 v140, -v145, v215, v140\n\t" \
    "v_fma_f32 %0, %0, v216, v137\n\t" \
    "v_fma_f32 %1, %1, v217, v138\n\t" \
    "v_fma_f32 %2, %2, v218, v139\n\t" \
    "v_fma_f32 %3, %3, v219, v140\n\t" \
    "v_mul_f32 v137, v250, v242\n\t" \
    "v_mul_f32 v138, v250, v243\n\t" \
    "v_mul_f32 v139, v250, v244\n\t" \
    "v_mul_f32 v140, v250, v245\n\t" \
    "v_mul_f32 v145, %0, v230\n\t" \
    "v_mul_f32 v146, %1, v231\n\t" \
    "v_fma_f32 v145, %2, v232, v145\n\t" \
    "v_fma_f32 v146, %3, v233, v146\n\t" \
    "v_add_f32 v145, v145, v146\n\t" \
    "ds_read_b128 v[186:189], %6 offset:44544\n\t" \
    "ds_read_b128 v[190:193], %6 offset:44800\n\t" \
    "ds_read_b128 v[194:197], %6 offset:45056\n\t" \
    "ds_read_b128 v[198:201], %6 offset:45312\n\t" \
    "ds_read_b128 v[202:205], %6 offset:45568\n\t" \
    "ds_read_b32 v206, %7 offset:44544\n\t" \
    "s_waitcnt lgkmcnt(6)\n\t" \
    "v_add_f32_dpp v145, v145, v145 quad_perm:[1,0,3,2] row_mask:0xf bank_mask:0xf bound_ctrl:1\n\t" \
    "v_mul_f32 v158, %0, v224\n\t" \
    "v_mul_f32 v146, %1, v225\n\t" \
    "v_add_f32_dpp v145, v145, v145 quad_perm:[2,3,0,1] row_mask:0xf bank_mask:0xf bound_ctrl:1\n\t" \
    "v_fma_f32 v158, %2, v226, v158\n\t" \
    "v_fma_f32 v146, %3, v227, v146\n\t" \
    "v_add_f32_dpp v145, v145, v145 row_half_mirror row_mask:0xf bank_mask:0xf bound_ctrl:1\n\t" \
    "v_add_f32 v158, v158, v146\n\t" \
    "s_nop 0\n\t" \
    "v_add_f32_dpp v145, v145, v145 row_mirror row_mask:0xf bank_mask:0xf bound_ctrl:1\n\t" \
    "v_fma_f32 v137, -v145, v234, v137\n\t" \
    "v_fma_f32 v138, -v145, v235, v138\n\t" \
    "v_fma_f32 v139, -v145, v236, v139\n\t" \
    "v_fma_f32 v140, -v145, v237, v140\n\t" \
    "v_fma_f32 %0, %0, v238, v137\n\t" \
    "v_fma_f32 %1, %1, v239, v138\n\t" \
    "v_fma_f32 %2, %2, v240, v139\n\t" \
    "v_fma_f32 %3, %3, v241, v140\n\t" \
    "v_mul_f32 v137, v184, v176\n\t" \
    "v_mul_f32 v138, v184, v177\n\t" \
    "v_mul_f32 v139, v184, v178\n\t" \
    "v_mul_f32 v140, v184, v179\n\t" \
    "v_mul_f32 v145, %0, v164\n\t" \
    "v_mul_f32 v146, %1, v165\n\t" \
    "v_fma_f32 v145, %2, v166, v145\n\t" \
    "v_fma_f32 v146, %3, v167, v146\n\t" \
    "v_add_f32 v145, v145, v146\n\t" \
    "ds_read_b128 v[208:211], %6 offset:46080\n\t" \
    "ds_read_b128 v[212:215], %6 offset:46336\n\t" \
    "ds_read_b128 v[216:219], %6 offset:46592\n\t" \
    "ds_read_b128 v[220:223], %6 offset:46848\n\t" \
    "ds_read_b128 v[224:227], %6 offset:47104\n\t" \
    "ds_read_b32 v228, %7 offset:46080\n\t" \
    "s_waitcnt lgkmcnt(6)\n\t" \
    "v_add_f32_dpp v145, v145, v145 quad_perm:[1,0,3,2] row_mask:0xf bank_mask:0xf bound_ctrl:1\n\t" \
    "v_mul_f32 v159, %0, v246\n\t" \
    "v_mul_f32 v146, %1, v247\n\t" \
    "v_add_f32_dpp v145, v145, v145 quad_perm:[2,3,0,1] row_mask:0xf bank_mask:0xf bound_ctrl:1\n\t" \
    "v_fma_f32 v159, %2, v248, v159\n\t" \
    "v_fma_f32 v146, %3, v249, v146\n\t" \
    "v_add_f32_dpp v145, v145, v145 row_half_mirror row_mask:0xf bank_mask:0xf bound_ctrl:1\n\t" \
    "v_add_f32 v159, v159, v146\n\t" \
    "s_nop 0\n\t" \
    "v_add_f32_dpp v145, v145, v145 row_mirror row_mask:0xf bank_mask:0xf bound_ctrl:1\n\t" \
    "v_fma_f32 v137, -v145, v168, v137\n\t" \
    "v_fma_f32 v138, -v145, v169, v138\n\t" \
    "v_fma_f32 v139, -v145, v170, v139\n\t" \
    "v_fma_f32 v140, -v145, v171, v140\n\t" \
    "v_fma_f32 %0, %0, v172, v137\n\t" \
    "v_fma_f32 %1, %1, v173, v138\n\t" \
    "v_fma_f32 %2, %2, v174, v139\n\t" \
    "v_fma_f32 %3, %3, v175, v140\n\t" \
    "v_mul_f32 v137, v206, v198\n\t" \
    "v_mul_f32 v138, v206, v199\n\t" \
    "v_mul_f32 v139, v206, v200\n\t" \
    "v_mul_f32 v140, v206, v201\n\t" \
    "v_mul_f32 v145, %0, v186\n\t" \
    "v_mul_f32 v146, %1, v187\n\t" \
    "v_fma_f32 v145, %2, v188, v145\n\t" \
    "v_fma_f32 v146, %3, v189, v146\n\t" \
    "v_add_f32 v145, v145, v146\n\t" \
    "ds_read_b128 v[230:233], %6 offset:47616\n\t" \
    "ds_read_b128 v[234:237], %6 offset:47872\n\t" \
    "ds_read_b128 v[238:241], %6 offset:48128\n\t" \
    "ds_read_b128 v[242:245], %6 offset:48384\n\t" \
    "ds_read_b128 v[246:249], %6 offset:48640\n\t" \
    "ds_read_b32 v250, %7 offset:47616\n\t" \
    "s_waitcnt lgkmcnt(6)\n\t" \
    "v_add_f32_dpp v145, v145, v145 quad_perm:[1,0,3,2] row_mask:0xf bank_mask:0xf bound_ctrl:1\n\t" \
    "v_mul_f32 v160, %0, v180\n\t" \
    "v_mul_f32 v146, %1, v181\n\t" \
    "v_add_f32_dpp v145, v145, v145 quad_perm:[2,3,0,1] row_mask:0xf bank_mask:0xf bound_ctrl:1\n\t" \
    "v_fma_f32 v160, %2, v182, v160\n\t" \
    "v_fma_f32 v146, %3, v183, v146\n\t" \
    "v_add_f32_dpp v145, v145, v145 row_half_mirror row_mask:0xf bank_mask:0xf bound_ctrl:1\n\t" \
    "v_add_f32 v160, v160, v146\n\t" \
    "s_nop 0\n\t" \
    "v_add_f32_dpp v145, v145, v145 row_mirror row_mask:0xf bank_mask:0xf bound_ctrl:1\n\t" \
    "v_fma_f32 v137, -v145, v190, v137\n\t" \
    "v_fma_f32 v138, -v145, v191, v138\n\t" \
    "v_fma_f32 v139, -v145, v192, v139\n\t" \
    "v_fma_f32 v140, -v145, v193, v140\n\t" \
    "v_fma_f32 %0, %0, v194, v137\n\t" \
    "v_fma_f32 %1, %1, v195, v138\n\t" \
    "v_fma_f32 %2, %2, v196, v139\n\t" \
    "v_fma_f32 %3, %3, v197, v140\n\t" \
    "v_mul_f32 v137, v228, v220\n\t" \
    "v_mul_f32 v138, v228, v221\n\t" \
    "v_mul_f32 v139, v228, v222\n\t" \
    "v_mul_f32 v140, v228, v223\n\t" \
    "v_mul_f32 v145, %0, v208\n\t" \
    "v_mul_f32 v146, %1, v209\n\t" \
    "v_fma_f32 v145, %2, v210, v145\n\t" \
    "v_fma_f32 v146, %3, v211, v146\n\t" \
    "v_add_f32 v145, v145, v146\n\t" \
    "s_waitcnt lgkmcnt(0)\n\t" \
    "s_nop 1\n\t" \
    "v_add_f32_dpp v145, v145, v145 quad_perm:[1,0,3,2] row_mask:0xf bank_mask:0xf bound_ctrl:1\n\t" \
    "v_mul_f32 v161, %0, v202\n\t" \
    "v_mul_f32 v146, %1, v203\n\t" \
    "v_add_f32_dpp v145, v145, v145 quad_perm:[2,3,0,1] row_mask:0xf bank_mask:0xf bound_ctrl:1\n\t" \
    "v_fma_f32 v161, %2, v204, v161\n\t" \
    "v_fma_f32 v146, %3, v205, v146\n\t" \
    "v_add_f32_dpp v145, v145, v145 row_half_mirror row_mask:0xf bank_mask:0xf bound_ctrl:1\n\t" \
    "v_add_f32 v161, v161, v146\n\t" \
    "s_nop 0\n\t" \
    "v_add_f32_dpp v145, v145, v145 row_mirror row_mask:0xf bank_mask:0xf bound_ctrl:1\n\t" \
    "v_fma_f32 v137, -v145, v212, v137\n\t" \
    "v_fma_f32 v138, -v145, v213, v138\n\t" \
    "v_fma_f32 v139, -v145, v214, v139\n\t" \
    "v_fma_f32 v140, -v145, v215, v140\n\t" \
    "v_fma_f32 %0, %0, v216, v137\n\t" \
    "v_fma_f32 %1, %1, v217, v138\n\t" \
    "v_fma_f32 %2, %2, v218, v139\n\t" \
    "v_fma_f32 %3, %3, v219, v140\n\t" \
    "v_mul_f32 v137, v250, v242\n\t" \
    "v_mul_f32 v138, v250, v243\n\t" \
    "v_mul_f32 v139, v250, v244\n\t" \
    "v_mul_f32 v140, v250, v245\n\t" \
    "v_mul_f32 v145, %0, v230\n\t" \
    "v_mul_f32 v146, %1, v231\n\t" \
    "v_fma_f32 v145, %2, v232, v145\n\t" \
    "v_fma_f32 v146, %3, v233, v146\n\t" \
    "v_add_f32 v145, v145, v146\n\t" \
    "s_nop 1\n\t" \
    "v_add_f32_dpp v145, v145, v145 quad_perm:[1,0,3,2] row_mask:0xf bank_mask:0xf bound_ctrl:1\n\t" \
    "v_mul_f32 v162, %0, v224\n\t" \
    "v_mul_f32 v146, %1, v225\n\t" \
    "v_add_f32_dpp v145, v145, v145 quad_perm:[2,3,0,1] row_mask:0xf bank_mask:0xf bound_ctrl:1\n\t" \
    "v_fma_f32 v162, %2, v226, v162\n\t" \
    "v_fma_f32 v146, %3, v227, v146\n\t" \
    "v_add_f32_dpp v145, v145, v145 row_half_mirror row_mask:0xf bank_mask:0xf bound_ctrl:1\n\t" \
    "v_add_f32 v162, v162, v146\n\t" \
    "s_nop 0\n\t" \
    "v_add_f32_dpp v145, v145, v145 row_mirror row_mask:0xf bank_mask:0xf bound_ctrl:1\n\t" \
    "v_fma_f32 v137, -v145, v234, v137\n\t" \
    "v_fma_f32 v138, -v145, v235, v138\n\t" \
    "v_fma_f32 v139, -v145, v236, v139\n\t" \
    "v_fma_f32 v140, -v145, v237, v140\n\t" \
    "v_fma_f32 %0, %0, v238, v137\n\t" \
    "v_fma_f32 %1, %1, v239, v138\n\t" \
    "v_fma_f32 %2, %2, v240, v139\n\t" \
    "v_fma_f32 %3, %3, v241, v140\n\t" \
    "v_mul_f32 v163, %0, v246\n\t" \
    "v_mul_f32 v146, %1, v247\n\t" \
    "v_fma_f32 v163, %2, v248, v163\n\t" \
    "v_fma_f32 v146, %3, v249, v146\n\t" \
    "v_add_f32 v163, v163, v146\n\t" \
    "s_nop 0\n\t" \
    "v_and_b32 v244, 8, %8\n\t" \
    "v_cmp_ne_u32 vcc, 0, v244\n\t" \
    "v_cndmask_b32 v244, v156, v148, vcc\n\t" \
    "v_cndmask_b32 v245, v157, v149, vcc\n\t" \
    "v_cndmask_b32 v246, v158, v150, vcc\n\t" \
    "v_cndmask_b32 v247, v159, v151, vcc\n\t" \
    "v_cndmask_b32 v230, v148, v156, vcc\n\t" \
    "v_cndmask_b32 v231, v149, v157, vcc\n\t" \
    "v_cndmask_b32 v232, v150, v158, vcc\n\t" \
    "v_cndmask_b32 v233, v151, v159, vcc\n\t" \
    "v_add_f32_dpp v230, v244, v230 row_mirror row_mask:0xf bank_mask:0xf bound_ctrl:1\n\t" \
    "v_add_f32_dpp v231, v245, v231 row_mirror row_mask:0xf bank_mask:0xf bound_ctrl:1\n\t" \
    "v_add_f32_dpp v232, v246, v232 row_mirror row_mask:0xf bank_mask:0xf bound_ctrl:1\n\t" \
    "v_add_f32_dpp v233, v247, v233 row_mirror row_mask:0xf bank_mask:0xf bound_ctrl:1\n\t" \
    "v_cndmask_b32 v244, v160, v152, vcc\n\t" \
    "v_cndmask_b32 v245, v161, v153, vcc\n\t" \
    "v_cndmask_b32 v246, v162, v154, vcc\n\t" \
    "v_cndmask_b32 v247, v163, v155, vcc\n\t" \
    "v_cndmask_b32 v234, v152, v160, vcc\n\t" \
    "v_cndmask_b32 v235, v153, v161, vcc\n\t" \
    "v_cndmask_b32 v236, v154, v162, vcc\n\t" \
    "v_cndmask_b32 v237, v155, v163, vcc\n\t" \
    "v_add_f32_dpp v234, v244, v234 row_mirror row_mask:0xf bank_mask:0xf bound_ctrl:1\n\t" \
    "v_add_f32_dpp v235, v245, v235 row_mirror row_mask:0xf bank_mask:0xf bound_ctrl:1\n\t" \
    "v_add_f32_dpp v236, v246, v236 row_mirror row_mask:0xf bank_mask:0xf bound_ctrl:1\n\t" \
    "v_add_f32_dpp v237, v247, v237 row_mirror row_mask:0xf bank_mask:0xf bound_ctrl:1\n\t" \
    "v_and_b32 v244, 4, %8\n\t" \
    "v_cmp_ne_u32 vcc, 0, v244\n\t" \
    "v_cndmask_b32 v244, v234, v230, vcc\n\t" \
    "v_cndmask_b32 v245, v235, v231, vcc\n\t" \
    "v_cndmask_b32 v246, v236, v232, vcc\n\t" \
    "v_cndmask_b32 v247, v237, v233, vcc\n\t" \
    "v_cndmask_b32 v238, v230, v234, vcc\n\t" \
    "v_cndmask_b32 v239, v231, v235, vcc\n\t" \
    "v_cndmask_b32 v240, v232, v236, vcc\n\t" \
    "v_cndmask_b32 v241, v233, v237, vcc\n\t" \
    "v_add_f32_dpp v238, v244, v238 row_half_mirror row_mask:0xf bank_mask:0xf bound_ctrl:1\n\t" \
    "v_add_f32_dpp v239, v245, v239 row_half_mirror row_mask:0xf bank_mask:0xf bound_ctrl:1\n\t" \
    "v_add_f32_dpp v240, v246, v240 row_half_mirror row_mask:0xf bank_mask:0xf bound_ctrl:1\n\t" \
    "v_add_f32_dpp v241, v247, v241 row_half_mirror row_mask:0xf bank_mask:0xf bound_ctrl:1\n\t" \
    "v_and_b32 v244, 2, %8\n\t" \
    "v_cmp_ne_u32 vcc, 0, v244\n\t" \
    "v_cndmask_b32 v244, v240, v238, vcc\n\t" \
    "v_cndmask_b32 v245, v241, v239, vcc\n\t" \
    "v_cndmask_b32 v242, v238, v240, vcc\n\t" \
    "v_cndmask_b32 v243, v239, v241, vcc\n\t" \
    "v_add_f32_dpp v242, v244, v242 quad_perm:[2,3,0,1] row_mask:0xf bank_mask:0xf bound_ctrl:1\n\t" \
    "v_add_f32_dpp v243, v245, v243 quad_perm:[2,3,0,1] row_mask:0xf bank_mask:0xf bound_ctrl:1\n\t" \
    "v_and_b32 v244, 1, %8\n\t" \
    "v_cmp_ne_u32 vcc, 0, v244\n\t" \
    "v_cndmask_b32 v244, v243, v242, vcc\n\t" \
    "v_cndmask_b32 v245, v242, v243, vcc\n\t" \
    "s_nop 0\n\t" \
    "v_add_f32_dpp %5, v244, v245 quad_perm:[1,0,3,2] row_mask:0xf bank_mask:0xf bound_ctrl:1\n\t" \

#define SCAN_CHUNK_CLOBBERS "v137", "v138", "v139", "v140", "v145", "v146", "v148", "v149", "v150", "v151", "v152", "v153", "v154", "v155", "v156", "v157", "v158", "v159", "v160", "v161", "v162", "v163", "v164", "v165", "v166", "v167", "v168", "v169", "v170", "v171", "v172", "v173", "v174", "v175", "v176", "v177", "v178", "v179", "v180", "v181", "v182", "v183", "v184", "v186", "v187", "v188", "v189", "v190", "v191", "v192", "v193", "v194", "v195", "v196", "v197", "v198", "v199", "v200", "v201", "v202", "v203", "v204", "v205", "v206", "v208", "v209", "v210", "v211", "v212", "v213", "v214", "v215", "v216", "v217", "v218", "v219", "v220", "v221", "v222", "v223", "v224", "v225", "v226", "v227", "v228", "v230", "v231", "v232", "v233", "v234", "v235", "v236", "v237", "v238", "v239", "v240", "v241", "v242", "v243", "v244", "v245", "v246", "v247", "v248", "v249", "v250", "vcc"

__device__ __forceinline__ float a_mul(float a, float b) { float d; asm("v_mul_f32 %0, %1, %2" : "=v"(d) : "v"(a), "v"(b)); return d; }
__device__ __forceinline__ float a_fma(float a, float b, float c) { float d; asm("v_fma_f32 %0, %1, %2, %3" : "=v"(d) : "v"(a), "v"(b), "v"(c)); return d; }
__device__ __forceinline__ float a_nfma(float a, float b, float c) { float d; asm("v_fma_f32 %0, -%1, %2, %3" : "=v"(d) : "v"(a), "v"(b), "v"(c)); return d; }
__device__ __forceinline__ float a_add_nop(float a, float b) { float d; asm("v_add_f32 %0, %1, %2\n\ts_nop 1" : "=v"(d) : "v"(a), "v"(b)); return d; }
#define SCAN_BAR() asm volatile("s_barrier" ::: "memory")
__device__ __forceinline__ void scan_unit(const Ctx& C0, const float* scn, int T, int quarter, const float* S0, float* Sout, unsigned char* obase, int mode) {
    Ctx C = C0; C.tid = threadIdx.x; asm volatile("" : "+v"(C.tid)); asm volatile("" : "+s"(C.G), "+s"(C.bid)); C.lane = C.tid & 63; C.wave = __builtin_amdgcn_readfirstlane(C.tid >> 6);
    constexpr int SLOT_B = 32 * 1536;
    const bool comp = C.wave < 4;
    const int q = C.lane & 15, rr = C.lane >> 4, rl = (C.wave & 3) * 4 + rr, irow = quarter * 16 + rl;
    const int nch = T / 32;
    __syncthreads();
    if (!comp) {
        const int lw = C.wave - 4;
        unsigned goff[12];
#pragma unroll
        for (int i = 0; i < 12; ++i) { const int x = (lw * 12 + i) * 1024 + C.lane * 16; goff[i] = (unsigned)((x / 1536) * 12288 + (x % 1536)); }
        const unsigned char* sb = (const unsigned char*)scn;
#define SCAN_ISSUE(ch) do { const int _c = (ch) < nch ? (ch) : nch - 1; const unsigned char* _g = sb + (size_t)_c * (32 * 12288); const int _slot = (ch) & 1; \
        _Pragma("unroll") for (int _i = 0; _i < 12; ++_i) __builtin_amdgcn_global_load_lds((const unsigned*)(_g + goff[_i]), (LAS unsigned*)(C.lds + _slot * SLOT_B + (lw * 12 + _i) * 1024), 16, 0, 0); } while (0)
        if (mode != 1) SCAN_ISSUE(0);
        asm volatile("s_waitcnt vmcnt(0)" ::: "memory");
        SCAN_BAR();
        for (int k = 0; k < nch; ++k) {
            if (mode != 1) SCAN_ISSUE(k + 1);
            asm volatile("s_waitcnt vmcnt(0)" ::: "memory");
            SCAN_BAR();
        }
#undef SCAN_ISSUE
    } else {
        float S0x = 0.f, S1x = 0.f, S2x = 0.f, S3x = 0.f;
        if (S0) { const f32x4 t = *(const f32x4*)(S0 + irow * 64 + 4 * q); S0x = t.x; S1x = t.y; S2x = t.z; S3x = t.w; }
        SCAN_BAR();
        for (int k = 0; k < nch; ++k) {
            const unsigned aq = (unsigned)(size_t)(C.lds + (k & 1) * SLOT_B) + 16u * (unsigned)q, av = (unsigned)(size_t)(C.lds + (k & 1) * SLOT_B) + (320u + (unsigned)irow) * 4u;
            float osel0, osel1;
            asm volatile(SCAN_CHUNK_ASM : "+v"(S0x), "+v"(S1x), "+v"(S2x), "+v"(S3x), "=&v"(osel0), "=&v"(osel1) : "v"(aq), "v"(av), "v"(q) : SCAN_CHUNK_CLOBBERS, "memory");
            if (mode == 0) { *(float*)(obase + (size_t)(k * 32 + q) * UPITCH_B + rl * 4) = osel0; *(float*)(obase + (size_t)(k * 32 + 16 + q) * UPITCH_B + rl * 4) = osel1; }
            SCAN_BAR();
        }
        if (mode == 0) *(f32x4*)(Sout + irow * 64 + 4 * q) = (f32x4){S0x, S1x, S2x, S3x};
    }
    __syncthreads();
}

struct AttnU { int qrow0, nq, krow0, krow1, krow2, g; const float* ck; const float* cv; unsigned vmask; };
__device__ __forceinline__ void attn_unit(const Args& A, const Ctx& C0, int l, int u_qrow0, int u_nq, int u_krow0, int u_krow1, int u_krow2, int u_g, const float* u_ck, const float* u_cv, unsigned u_vmask) {
    Ctx C = C0; C.tid = threadIdx.x; asm volatile("" : "+v"(C.tid)); asm volatile("" : "+s"(C.G), "+s"(C.bid)); C.lane = C.tid & 63; C.wave = __builtin_amdgcn_readfirstlane(C.tid >> 6);
    WSB_DECL;
    AttnU u; u.qrow0 = u_qrow0; u.nq = u_nq; u.krow0 = u_krow0; u.krow1 = u_krow1; u.krow2 = u_krow2; u.g = u_g; u.ck = u_ck; u.cv = u_cv; u.vmask = u_vmask;
    constexpr int KP = 72, VP = 196;
    LAS bf16* Ks = (LAS bf16*)C.lds;
    LAS bf16* Vt = (LAS bf16*)(C.lds + 192 * KP * 2);
    LAS float* biasL = (LAS float*)(C.lds + 192 * KP * 2 + 64 * VP * 2);
    const bf16* U = WS_PTR(const bf16, WS_U); bf16* MIX = WS_PTR(bf16, WS_XN);
    const int hq = u.g * 8 + C.wave;
    for (int idx = C.lane; idx < 255; idx += 64) biasL[C.wave * 256 + idx] = WS_PTR(const float, WS_BIAS)[idx * 16 + hq];
    const int li = C.lane & 31, h = C.lane >> 5;
    bf16x8 qfa[2][4]; v2u gxa[2][2][4];
#pragma unroll
    for (int qt = 0; qt < 2; ++qt) { const int qi = (qt * 32 < u.nq ? qt * 32 : 0) + li; const size_t row = (size_t)(u.qrow0 + qi);
#pragma unroll
        for (int ks = 0; ks < 4; ++ks) qfa[qt][ks] = *(const bf16x8*)(U + row * DIN + C_Q + hq * 64 + ks * 16 + 8 * h);
#pragma unroll
        for (int dt = 0; dt < 2; ++dt)
#pragma unroll
            for (int rq = 0; rq < 4; ++rq) gxa[qt][dt][rq] = *(const v2u*)(U + row * DIN + C_GA + hq * 64 + dt * 32 + 8 * rq + 4 * h); }
    {
        v4u kx[3], vx[3];
#pragma unroll
        for (int it = 0; it < 3; ++it) { const int idx = C.tid + 512 * it; const int j = idx >> 3, part = idx & 7;
            kx[it] = (v4u){0u, 0u, 0u, 0u}; vx[it] = kx[it];
            if ((u.vmask >> (j >> 5)) & 1u) {
                if (u.ck && j < 128) { const float* pk = u.ck + (size_t)j * 128 + part * 8; const float* pv = u.cv + (size_t)j * 128 + part * 8;
                    const f32x4 a0 = *(const f32x4*)pk, a1 = *(const f32x4*)(pk + 4), b0 = *(const f32x4*)pv, b1 = *(const f32x4*)(pv + 4);
                    kx[it] = (v4u){pk2(a0.x, a0.y), pk2(a0.z, a0.w), pk2(a1.x, a1.y), pk2(a1.z, a1.w)}; vx[it] = (v4u){pk2(b0.x, b0.y), pk2(b0.z, b0.w), pk2(b1.x, b1.y), pk2(b1.z, b1.w)}; }
                else { const int ch = j >> 6; const int kr = (ch == 0 ? u.krow0 : (ch == 1 ? u.krow1 : u.krow2)) + (j & 63);
                    kx[it] = *(const v4u*)(U + (size_t)kr * DIN + C_K + u.g * 64 + part * 8); vx[it] = *(const v4u*)(U + (size_t)kr * DIN + C_V + u.g * 64 + part * 8); }
            } }
#pragma unroll
        for (int it = 0; it < 3; ++it) { const int idx = C.tid + 512 * it; const int j = idx >> 3, part = idx & 7;
            *(LAS v4u*)(Ks + j * KP + part * 8) = kx[it];
            LAS bf16* vd = Vt + (part * 8) * VP + j; const v4u v = vx[it];
            vd[0 * VP] = (bf16)(v.x & 0xffffu); vd[1 * VP] = (bf16)(v.x >> 16); vd[2 * VP] = (bf16)(v.y & 0xffffu); vd[3 * VP] = (bf16)(v.y >> 16);
            vd[4 * VP] = (bf16)(v.z & 0xffffu); vd[5 * VP] = (bf16)(v.z >> 16); vd[6 * VP] = (bf16)(v.w & 0xffffu); vd[7 * VP] = (bf16)(v.w >> 16); }
    }
    __syncthreads();
    const float sink = A.in[I_SINKS][l * 16 + hq];
    const LAS float* bL = biasL + C.wave * 256;
#pragma unroll
    for (int qt = 0; qt < 2; ++qt) { if (qt * 32 < u.nq) {
        const int qi = qt * 32 + li;
        bf16x8 qf[4];
#pragma unroll
        for (int ks = 0; ks < 4; ++ks) qf[ks] = qfa[qt][ks];
        f32x16 sacc[6];
#pragma unroll
        for (int kt = 0; kt < 6; ++kt) {
#pragma unroll
            for (int r = 0; r < 16; ++r) sacc[kt][r] = 0.f;
#pragma unroll
            for (int ks = 0; ks < 4; ++ks) { const bf16x8 kf = *(const LAS bf16x8*)(Ks + (kt * 32 + li) * KP + ks * 16 + 8 * h);
                sacc[kt] = __builtin_amdgcn_mfma_f32_32x32x16_bf16(kf, qf[ks], sacc[kt], 0, 0, 0); }
            asm volatile("" ::: "memory");
        }
        float mx = sink;
#pragma unroll
        for (int kt = 0; kt < 6; ++kt) { const bool valid = (u.vmask >> kt) & 1u;
#pragma unroll
            for (int r = 0; r < 16; ++r) { const int j = kt * 32 + (r & 3) + 8 * (r >> 2) + 4 * h;
                const float lg = valid ? sacc[kt][r] * 0.125f + bL[j - qi + 63] : -1e30f; sacc[kt][r] = lg; mx = fmaxf(mx, lg); }
            asm volatile("" ::: "memory"); }
        mx = fmaxf(mx, shflx(mx, 32, C.lane));
        float sum = 0.f;
#pragma unroll
        for (int kt = 0; kt < 6; ++kt)
#pragma unroll
            for (int r = 0; r < 16; ++r) { const float e = __expf(sacc[kt][r] - mx); sacc[kt][r] = e; sum += e; }
        sum += shflx(sum, 32, C.lane); sum += __expf(sink - mx);
        const float inv = 1.f / sum;
        f32x16 oacc[2];
#pragma unroll
        for (int dt = 0; dt < 2; ++dt)
#pragma unroll
            for (int r = 0; r < 16; ++r) oacc[dt][r] = 0.f;
#pragma unroll
        for (int kt = 0; kt < 6; ++kt) {
            if ((u.vmask >> kt) & 1u) {
#pragma unroll
                for (int s = 0; s < 2; ++s) {
                    union { bf16x8 v; unsigned w[4]; } pf;
#pragma unroll
                    for (int e = 0; e < 4; ++e) pf.w[e] = pk2(sacc[kt][8 * s + 2 * e] * inv, sacc[kt][8 * s + 2 * e + 1] * inv);
#pragma unroll
                    for (int dt = 0; dt < 2; ++dt) { const LAS bf16* vp = Vt + (dt * 32 + li) * VP + kt * 32 + 16 * s + 4 * h;
                        union { bf16x8 v; v2u w[2]; } vf; vf.w[0] = *(const LAS v2u*)vp; vf.w[1] = *(const LAS v2u*)(vp + 8);
                        oacc[dt] = __builtin_amdgcn_mfma_f32_32x32x16_bf16(vf.v, pf.v, oacc[dt], 0, 0, 0); }
                }
            }
            asm volatile("" ::: "memory");
        }
        const size_t row = (size_t)(u.qrow0 + qi);
#pragma unroll
        for (int dt = 0; dt < 2; ++dt)
#pragma unroll
            for (int rq = 0; rq < 4; ++rq) { const int d = dt * 32 + 8 * rq + 4 * h;
                const v2u gx = gxa[qt][dt][rq];
                const float o0 = oacc[dt][4 * rq] * silu(bflo(gx.x)), o1 = oacc[dt][4 * rq + 1] * silu(bfhi(gx.x)), o2 = oacc[dt][4 * rq + 2] * silu(bflo(gx.y)), o3 = oacc[dt][4 * rq + 3] * silu(bfhi(gx.y));
                v2u o; o.x = pk2(o0, o1); o.y = pk2(o2, o3);
                *(v2u*)(MIX + row * D + 512 + hq * 64 + d) = o; }
    } }
    __syncthreads();
}

__device__ __forceinline__ void pool_item(const Args& A, const Ctx& C0, int l, int row0, int t0, int pos0, const float* hist, float* outpool) {
    Ctx C = C0; C.tid = threadIdx.x; asm volatile("" : "+v"(C.tid)); asm volatile("" : "+s"(C.G), "+s"(C.bid)); C.lane = C.tid & 63; C.wave = __builtin_amdgcn_readfirstlane(C.tid >> 6);
    WSB_DECL;
    constexpr int PP = 520;
    LAS bf16* P = (LAS bf16*)C.lds;
    const bf16* U = WS_PTR(const bf16, WS_U); bf16* MIX = WS_PTR(bf16, WS_XN);
    {
        v4u xs[6];
#pragma unroll
        for (int it = 0; it < 6; ++it) { const int idx = C.tid + 512 * it; const int rr = idx >> 6, v = idx & 63;
            xs[it] = (v4u){0u, 0u, 0u, 0u};
            if (idx < 47 * 64) {
                if (rr < 15 && t0 == 0) { if (hist) { const f32x4 a0 = *(const f32x4*)(hist + rr * 512 + v * 8), a1 = *(const f32x4*)(hist + rr * 512 + v * 8 + 4);
                        xs[it] = (v4u){pk2(a0.x, a0.y), pk2(a0.z, a0.w), pk2(a1.x, a1.y), pk2(a1.z, a1.w)}; } }
                else xs[it] = *(const v4u*)(U + (size_t)(row0 - 15 + rr) * DIN + C_P + v * 8); } }
#pragma unroll
        for (int it = 0; it < 6; ++it) { const int idx = C.tid + 512 * it; const int rr = idx >> 6, v = idx & 63; if (idx < 47 * 64) *(LAS v4u*)(P + rr * PP + v * 8) = xs[it]; }
    }
    __syncthreads();
    LAS bf16* Dm = P + 47 * PP;
    { const int c = C.tid, gc = c >> 7, wdc = 2 << gc;
      float s = 0.f;
      for (int i = 0; i < wdc; ++i) s += bf1(P[(15 - i) * PP + c]);
#pragma unroll 4
      for (int t = 0; t < 32; ++t) { const int pos = pos0 + t; const float inv = 1.f / (float)((pos + 1) < wdc ? (pos + 1) : wdc);
          const float cur = bf1(P[(15 + t) * PP + c]);
          Dm[t * PP + c] = (bf16)f2bf(s * inv - cur);
          s += bf1(P[(16 + t) * PP + c]) - bf1(P[(16 + t - wdc) * PP + c]); } }
    __syncthreads();
    const int g = C.wave & 3, ddh = C.wave >> 2, tk = C.lane & 31, h = C.lane >> 5;
    const bf16* PW = WS_PTR(const bf16, WS_PWT) + (size_t)(l * 4 + g) * 128 * 128;
    f32x16 acc[2];
#pragma unroll
    for (int dt = 0; dt < 2; ++dt)
#pragma unroll
        for (int r = 0; r < 16; ++r) acc[dt][r] = 0.f;
#pragma unroll
    for (int ks = 0; ks < 8; ++ks) { const bf16x8 df = *(const LAS bf16x8*)(Dm + tk * PP + g * 128 + ks * 16 + 8 * h);
#pragma unroll
        for (int dt = 0; dt < 2; ++dt) { const bf16x8 af = *(const bf16x8*)(PW + (size_t)(ddh * 64 + dt * 32 + tk) * 128 + ks * 16 + 8 * h);
            acc[dt] = __builtin_amdgcn_mfma_f32_32x32x16_bf16(af, df, acc[dt], 0, 0, 0); }
    }
    const size_t row = (size_t)(row0 + tk);
    const float* psc = A.in[I_POOLS] + l * 512;
#pragma unroll
    for (int dt = 0; dt < 2; ++dt)
#pragma unroll
        for (int rq = 0; rq < 4; ++rq) { const int cc = g * 128 + ddh * 64 + dt * 32 + 8 * rq + 4 * h;
            const v2u gx = *(const v2u*)(U + row * DIN + C_GP + cc); const f32x4 sc = *(const f32x4*)(psc + cc);
            const float o0 = acc[dt][4 * rq] * sc.x * silu(bflo(gx.x)), o1 = acc[dt][4 * rq + 1] * sc.y * silu(bfhi(gx.x)), o2 = acc[dt][4 * rq + 2] * sc.z * silu(bflo(gx.y)), o3 = acc[dt][4 * rq + 3] * sc.w * silu(bfhi(gx.y));
            v2u o; o.x = pk2(o0, o1); o.y = pk2(o2, o3);
            *(v2u*)(MIX + row * D + cc) = o; }
    if (outpool) for (int idx = C.tid; idx < 15 * 512; idx += 512) { const int rr = idx >> 9, cc = idx & 511; outpool[idx] = bf1(P[(32 + rr) * PP + cc]); }
    __syncthreads();
}

#ifndef UN_MASK
#define UN_MASK 7
#endif
__device__ __forceinline__ void mixer_item(const Args& A, const Ctx& C, int l, int it, int unmask) {
    WSB_DECL;
    const float* SCN = WS_PTR(const float, WS_SCN); unsigned char* Ub = A.ws + WS_U;
    constexpr int N_PSCAN = BATCH * 8 * 4, N_SSCAN = DECB * 8 * 4, N_PATT = BATCH * (SEQ / 64) * 2, N_SATT = DECB * 2, N_PPOOL = MP / 32, N_SPOOL = DECB;
    if (it < N_PSCAN + N_SSCAN) {
        const bool smp = it >= N_PSCAN; const int i2 = smp ? it - N_PSCAN : it;
        int b, hd, qd;
        if (smp) { b = i2 >> 5; hd = (i2 >> 2) & 7; qd = i2 & 3; }
        else { const int xg = i2 & 7, idx = i2 >> 3, pair = xg * 4 + (idx >> 2); qd = idx & 3; b = pair >> 3; hd = pair & 7; }
        const size_t row0 = smp ? (size_t)MP + b * DECS : (size_t)b * SEQ;
        const float* S0 = smp ? A.in[I_SWKV] + ((size_t)(l * DECB + b) * 8 + hd) * 4096 : nullptr;
        float* So = smp ? A.out + O_WKVS + ((size_t)(l * DECB + b) * 8 + hd) * 4096 : A.out + O_WKVP + ((size_t)(l * BATCH + b) * 8 + hd) * 4096;
        if (unmask & UN_MASK & 1) scan_unit(C, SCN + row0 * 3072 + hd * 384, smp ? DECS : SEQ, qd, S0, So, Ub + row0 * UPITCH_B + UXC_B + (hd * 64 + qd * 16) * 4, (unmask >> 4) & 3);
        return; }
    it -= N_PSCAN + N_SSCAN;
    if (it < N_PATT + N_SATT) { int qrow0, nq, krow0, krow1, g; const float* ck; const float* cv; unsigned vmask;
        if (it < N_PATT) { const int c = (it >> 1) & 127, b = it >> 8; g = it & 1; nq = 64; qrow0 = b * SEQ + c * 64; ck = nullptr; cv = nullptr;
            krow0 = b * SEQ + (c - 2) * 64; krow1 = b * SEQ + (c - 1) * 64; vmask = (c >= 2 ? 3u : 0u) | (c >= 1 ? 12u : 0u) | 48u; }
        else { const int i2 = it - N_PATT; const int b = i2 >> 1; g = i2 & 1; nq = 32; qrow0 = MP + b * DECS; krow0 = 0; krow1 = 0; vmask = 31u;
            ck = A.in[I_CK] + ((size_t)(l * DECB + b) * 128) * 128 + g * 64; cv = A.in[I_CV] + ((size_t)(l * DECB + b) * 128) * 128 + g * 64; }
        if (unmask & UN_MASK & 2) attn_unit(A, C, l, qrow0, nq, krow0, krow1, qrow0, g, ck, cv, vmask);
        return; }
    it -= N_PATT + N_SATT;
    { int row0, t0, pos0; const float* hist; float* outp;
      if (it < N_PPOOL) { row0 = it * 32; t0 = row0 % SEQ; pos0 = t0; hist = nullptr; outp = (t0 == SEQ - 32) ? A.out + O_POOLP + (size_t)(l * BATCH + row0 / SEQ) * 15 * 512 : nullptr; }
      else { const int b = it - N_PPOOL; row0 = MP + b * DECS; t0 = 0; pos0 = 1024; hist = A.in[I_SPOOL] + (size_t)(l * DECB + b) * 15 * 512; outp = A.out + O_POOLS + (size_t)(l * DECB + b) * 15 * 512; }
      if (unmask & UN_MASK & 4) pool_item(A, C, l, row0, t0, pos0, hist, outp); }
}
__device__ __forceinline__ void sub_barrier(unsigned* cnt, unsigned n) {
    asm volatile("s_waitcnt vmcnt(0)" ::: "memory");
    __syncthreads();
    if (threadIdx.x == 0) {
        __builtin_amdgcn_fence(__ATOMIC_RELEASE, "agent");
        asm volatile("s_waitcnt vmcnt(0)" ::: "memory");
        __hip_atomic_fetch_add(cnt, 1u, __ATOMIC_RELAXED, __HIP_MEMORY_SCOPE_AGENT);
        unsigned sp = 0;
        while (__hip_atomic_load(cnt, __ATOMIC_RELAXED, __HIP_MEMORY_SCOPE_AGENT) < n) { __builtin_amdgcn_s_sleep(2); if (++sp > (1u << 24)) break; }
        __builtin_amdgcn_fence(__ATOMIC_ACQUIRE, "agent");
        asm volatile("s_waitcnt vmcnt(0)" ::: "memory");
    }
    __syncthreads();
}
__device__ __forceinline__ bool phase_mixers(const Args& A, const Ctx& C0, int l, int unmask) {
    Ctx C = C0; C.tid = threadIdx.x; asm volatile("" : "+v"(C.tid)); asm volatile("" : "+s"(C.G), "+s"(C.bid)); C.lane = C.tid & 63; C.wave = __builtin_amdgcn_readfirstlane(C.tid >> 6);
    WSB_DECL;
    constexpr int N_PSCAN = BATCH * 8 * 4;
    constexpr int NI = N_PSCAN + DECB * 8 * 4 + BATCH * (SEQ / 64) * 2 + DECB * 2 + MP / 32 + DECB;
    if (C.G >= N_PSCAN + 64) {
        if (C.bid < N_PSCAN) mixer_item(A, C, l, C.bid, unmask);
        else {
            const int no = C.G - N_PSCAN;
            for (int it = N_PSCAN + (C.bid - N_PSCAN); it < NI; it += no) mixer_item(A, C, l, it, unmask);
            if (unmask == 7) { sub_barrier((unsigned*)(A.ws + WS_CTL) + CW_SUB + 64 * l, (unsigned)no); return true; }
        }
    } else {
        for (int it = C.bid; it < NI; it += C.G) mixer_item(A, C, l, it, unmask);
    }
    return false;
}

__device__ __forceinline__ void phase_post(const Args& A, const Ctx& C0, int l, int nskip) {
    Ctx C = C0; C.tid = threadIdx.x; asm volatile("" : "+v"(C.tid)); asm volatile("" : "+s"(C.G), "+s"(C.bid)); C.lane = C.tid & 63; C.wave = __builtin_amdgcn_readfirstlane(C.tid >> 6);
    WSB_DECL;
    const bf16* U = WS_PTR(const bf16, WS_U); bf16* MIX = WS_PTR(bf16, WS_XN); const unsigned char* Ub = A.ws + WS_U;
    const float* SCN = WS_PTR(const float, WS_SCN); const float* RKB = WS_PTR(const float, WS_RK);
    const int hd = C.wave, c = hd * 64 + C.lane;
    const float lw = A.in[I_LNXW][l * 512 + c], lb = A.in[I_LNXB][l * 512 + c];
    if (C.bid >= nskip)
    for (int row0 = (C.bid - nskip) * 8; row0 < M; row0 += (C.G - nskip) * 8) {
        float o[8], v[8], gr[8], rk[8];
#pragma unroll
        for (int i = 0; i < 8; ++i) { const size_t row = (size_t)(row0 + i);
            o[i] = ((const float*)(Ub + row * UPITCH_B + UXC_B))[c]; v[i] = SCN[row * 3072 + hd * 384 + 320 + C.lane];
            gr[i] = bf1(U[row * DIN + C_GR + c]); rk[i] = RKB[row * 8 + hd]; }
#pragma unroll
        for (int i = 0; i < 8; ++i) { const size_t row = (size_t)(row0 + i);
            const float mean = wave_sum_l(o[i], C.lane) * (1.f / 64.f); const float dd = o[i] - mean; const float var = wave_sum_l(dd * dd, C.lane) * (1.f / 64.f);
            const float y = dd * (1.f / sqrtf(var + LNX_EPS)) * lw + lb + rk[i] * v[i];
            MIX[row * D + 1536 + c] = (bf16)f2bf(y * silu(gr[i])); }
    }
}
__device__ __forceinline__ void phase_norm(const Args& A, const Ctx& C0, int l) {
    Ctx C = C0; C.tid = threadIdx.x; asm volatile("" : "+v"(C.tid)); asm volatile("" : "+s"(C.G), "+s"(C.bid)); C.lane = C.tid & 63; C.wave = __builtin_amdgcn_readfirstlane(C.tid >> 6);
    WSB_DECL;
    const int gw = C.bid * NWAVES + C.wave, NGW = C.G * NWAVES;
    if (l + 1 < DEPTH) { for (int m = gw; m < M; m += NGW) norm_row(A.out + (size_t)m * D, A.in[I_NORMW] + (size_t)(l + 1) * D, WS_PTR(bf16, WS_XN) + (size_t)m * D, nullptr, nullptr, C.lane); }
    else {
        const f32x4* wr = (const f32x4*)A.in[I_FNW] + C.lane;
        for (int m = gw; m < M; m += 4 * NGW) {
            f32x4* p[4]; f32x4 v[4][8]; float s[4]; bool ok[4];
#pragma unroll
            for (int r = 0; r < 4; ++r) { const int mr = m + r * NGW; ok[r] = mr < M; p[r] = (f32x4*)(A.out + (size_t)(ok[r] ? mr : m) * D) + C.lane; }
#pragma unroll
            for (int r = 0; r < 4; ++r)
#pragma unroll
                for (int j = 0; j < 8; ++j) v[r][j] = p[r][64 * j];
#pragma unroll
            for (int r = 0; r < 4; ++r) { float t = 0.f;
#pragma unroll
                for (int j = 0; j < 8; ++j) t += (v[r][j].x * v[r][j].x + v[r][j].y * v[r][j].y) + (v[r][j].z * v[r][j].z + v[r][j].w * v[r][j].w);
                s[r] = 1.f / sqrtf(wave_sum_l(t, C.lane) * (1.f / D) + NORM_EPS); }
#pragma unroll
            for (int j = 0; j < 8; ++j) { const f32x4 ww = wr[64 * j];
#pragma unroll
                for (int r = 0; r < 4; ++r) if (ok[r]) p[r][64 * j] = v[r][j] * s[r] * ww; } } }
}

constexpr int N_PHASES = 1 + 6 * DEPTH;
#ifndef EN_MASK
#define EN_MASK 0x7f
#endif
#define EN(k) ((EN_MASK >> (k)) & 1)
#ifndef G1_ALIGN
#define G1_ALIGN true
#endif
#ifndef G1_SP2
#define G1_SP2 true
#endif
#ifndef G2_ALIGN
#define G2_ALIGN true
#endif
#ifndef DUP_UN
#define DUP_UN 7
#endif
#ifndef DUP_MASK
#define DUP_MASK 0
#endif
__global__ void __launch_bounds__(NWAVES * 64, 2) hybrid_fwd(Args A) {
    extern __shared__ __attribute__((aligned(16))) unsigned char lds_raw[];
    Ctx C; C.lds = (LAS unsigned char*)lds_raw; C.tid = threadIdx.x; C.lane = C.tid & 63; C.wave = __builtin_amdgcn_readfirstlane(C.tid >> 6); C.G = gridDim.x; C.bid = blockIdx.x;
    for (int u = C.tid; u < (LDS_BYTES - LDSCTL_OFF) / 4; u += NWAVES * 64) ((LAS unsigned*)(C.lds + LDSCTL_OFF))[u] = 0u;
    __syncthreads();
    gu32* ctl = (gu32*)(A.ws + WS_CTL);
    XcdBarrier bar; bar.bar = (unsigned*)(ctl + CW_BAR); bar.x = 0; bar.st = nullptr;
    if (A.coop) bar = xcd_barrier_post((unsigned*)(ctl + CW_BAR), (volatile LAS unsigned*)(C.lds + MISC_OFF) + 8);
    const int lo = A.ph_lo, hi = A.ph_hi;
    for (int ph = lo; ph < hi; ++ph) {
      const int l = (ph - 1) / 6, s = (ph == 0) ? -1 : (ph - 1) % 6;
      WSB_DECL;
      const int reps = ((ph > 0 && ((DUP_MASK >> s) & 1) && !(s == 5 && l == DEPTH - 1)) || (ph == 0 && (DUP_MASK & 64))) ? 2 : 1;
      for (int rep = 0; rep < reps; ++rep) {
        if (rep) { if (ph == 0) cg::this_grid().sync(); else xcd_barrier(bar); }
        if (ph == 0) { if (EN(0)) phase_prologue(A, C); }
        else {
            if (s == 0 && EN(1)) { pg8::Gemm g{WS_PTR(const bf16, WS_HB), WS_PTR(const bf16, WS_WINT) + (size_t)l * DINP * D, M, DINP, D, D}; pg8::StaticOrder S; S.init(M, DINP, C.G, C.bid);
                pg8::EpiU E{WS_PTR(bf16, WS_U), WS_PTR(const float, WS_SS) + (size_t)l * M};
                pg8::gemm_phase<pg8::EpiU, pg8::StaticOrder, G1_ALIGN, G1_SP2>(C.lds, g, S, E); }
            else if (s == 1 && EN(2)) phase_prep(A, C, l);
            else if ((s == 2 && EN(3)) || (s == 3 && EN(4)) || (s == 4 && EN(5))) {
                const bool split = C.G >= 192; bool go = (s == 4); int k0 = split ? KSPLIT : 0, kl = D - k0, gg = C.G, cc = C.bid, mrows = M; size_t roff = 0;
                if (s == 2) { go = phase_mixers(A, C, l, rep ? DUP_UN : 7); k0 = 0; kl = KSPLIT; gg = C.G - 128; cc = C.bid - 128; mrows = MP; }
                if (s == 3) { phase_post(A, C, l, split ? 8 : 0); go = split && C.bid < 8 && !rep; k0 = 0; kl = KSPLIT; gg = 8; cc = C.bid; mrows = MS; roff = (size_t)MP * D; }
                if (go) { pg8::Gemm g{WS_PTR(const bf16, WS_XN) + roff + k0, WS_PTR(const bf16, WS_WOUTT) + (size_t)l * D * D + k0, mrows, D, kl, D}; pg8::StaticOrder S; S.init(mrows, D, gg, cc);
                    const bool first = (l == 0) && (s != 4 || !split);
                    float* Hout = ((rep && s == 4) ? WS_PTR(float, WS_U) : A.out) + roff;
                    pg8::EpiResN E{Hout, first ? (s == 3 ? A.in[I_XS] : A.in[I_XP]) : Hout, first ? A.in[I_XS] - (size_t)MP * D : Hout, WS_PTR(bf16, WS_HB), WS_PTR(float, WS_SS) + (size_t)(l + 1) * M, s == 4 && !rep};
                    pg8::gemm_phase<pg8::EpiResN, pg8::StaticOrder, G2_ALIGN, true>(C.lds, g, S, E); }
            }
            else if (s == 5 && EN(6) && l == DEPTH - 1) phase_norm(A, C, l);
        }
      }
        if (ph + 1 < hi && !(s == 5 && l < DEPTH - 1)) {
            if (A.coop == 2) cg::this_grid().sync();
            else xcd_barrier(bar);
        }
    }
}

#ifndef MK_MULTI
#define MK_MULTI 0
#endif
extern "C" void kernel_launch(void* const* d_in, const int* in_sizes, int n_in, void* d_out, int out_size, void* d_ws, size_t ws_size, hipStream_t stream) {
    static int grid = 0;
    if (grid == 0) {
        if (n_in != 25 || (size_t)out_size != O_END || ws_size < WS_END) { fprintf(stderr, "kernel_launch: unexpected sizes: n_in %d out %d ws %zu (need %zu)\n", n_in, out_size, ws_size, (size_t)WS_END); grid = -1; return; }
        int dev = 0, cus = 0, per_cu = 0;
        if (hipGetDevice(&dev) != hipSuccess || hipDeviceGetAttribute(&cus, hipDeviceAttributeMultiprocessorCount, dev) != hipSuccess) { grid = -1; return; }
        if (hipFuncSetAttribute((const void*)hybrid_fwd, hipFuncAttributeMaxDynamicSharedMemorySize, LDS_BYTES) != hipSuccess) { fprintf(stderr, "kernel_launch: hipFuncSetAttribute failed\n"); grid = -1; return; }
        if (hipOccupancyMaxActiveBlocksPerMultiprocessor(&per_cu, (const void*)hybrid_fwd, NWAVES * 64, LDS_BYTES) != hipSuccess || per_cu < 1) { fprintf(stderr, "kernel_launch: occupancy query gives %d\n", per_cu); per_cu = 1; }
        (void)hipGetLastError();
        grid = cus;
    }
    if (grid < 0) return;
    (void)hipMemsetAsync((char*)d_ws + WS_CTL, 0, CTL_ZERO_BYTES, stream);
    Args a{};
    for (int i = 0; i < 25; ++i) a.in[i] = (const float*)d_in[i];
    a.out = (float*)d_out; a.ws = (unsigned char*)d_ws;
#if MK_MULTI
    for (int ph = 0; ph < N_PHASES; ++ph) { a.ph_lo = ph; a.ph_hi = ph + 1; a.coop = 0;
        hipLaunchKernelGGL(hybrid_fwd, dim3(grid), dim3(NWAVES * 64), LDS_BYTES, stream, a); }
#else
    a.ph_lo = 0; a.ph_hi = N_PHASES; a.coop = 1;
    void* args[] = {&a};
    hipError_t e = hipLaunchCooperativeKernel((const void*)hybrid_fwd, dim3(grid), dim3(NWAVES * 64), args, LDS_BYTES, stream);
    if (e != hipSuccess) fprintf(stderr, "kernel_launch: cooperative launch failed: %s (grid %d)\n", hipGetErrorString(e), grid);
#endif
}
```
